# Optimizing an MI355X kernel written in HIP

```python
import jax, jax.numpy as jnp
from jax import lax
import numpy as np

D_MODEL = 1024
BATCH = 8
SEQ = 4096
DEPTH = 1
DEC_BATCH = 8
DEC_SEQ = 32
PAST_LEN = 4096

CHUNK = 64
HEAD_DIM = 64
A_HEADS = 8
A_WIDTH = A_HEADS * HEAD_DIM
Q_LORA = 256
KV_LORA = 128
NOPE_DIM = HEAD_DIM
ROPE_DIM = 32
ROPE_BASE = 10000.0
MLA_SCALE = (NOPE_DIM + ROPE_DIM) ** -0.5
B_HEADS = 8
B_WIDTH = B_HEADS * HEAD_DIM
BAND_CHUNKS = 8
MAX_REL = 128
N_REL = 2 * MAX_REL + 1
B_SCALE = HEAD_DIM ** -0.5
MIX_WIDTH = A_WIDTH + B_WIDTH
Q_BLOCK = 128
EPS = 1e-6
NEG = -1e30

OFF_CQ = 0
OFF_CKV = OFF_CQ + Q_LORA
OFF_KR = OFF_CKV + KV_LORA
OFF_GA = OFF_KR + ROPE_DIM
OFF_QB = OFF_GA + A_WIDTH
OFF_KB = OFF_QB + B_WIDTH
OFF_VB = OFF_KB + B_WIDTH
OFF_GB = OFF_VB + B_WIDTH
IN_WIDTH = OFF_GB + B_WIDTH

kernel_name = "hybrid_mla_chunkband_stream_step"


def rmsnorm(x, g):
    x32 = x.astype(jnp.float32)
    r = x32 * lax.rsqrt(jnp.mean(x32 * x32, axis=-1, keepdims=True) + EPS)
    return (r * g.astype(jnp.float32)).astype(x.dtype)


def rope(x, pos):
    half = ROPE_DIM // 2
    inv = ROPE_BASE ** (-jnp.arange(half, dtype=jnp.float32) / half)
    ang = pos.astype(jnp.float32)[:, None] * inv
    ang = ang.reshape(ang.shape[0], *([1] * (x.ndim - 3)), half)
    cos, sin = jnp.cos(ang), jnp.sin(ang)
    x1 = x[..., :half].astype(jnp.float32)
    x2 = x[..., half:].astype(jnp.float32)
    return jnp.concatenate([x1 * cos - x2 * sin, x1 * sin + x2 * cos], axis=-1).astype(x.dtype)


def mixer_inputs(xn, pos, w_in, g_cq, w_uq, g_ckv, w_uk):
    b, s, _ = xn.shape
    z = xn @ w_in
    c_q = rmsnorm(z[..., OFF_CQ:OFF_CKV], g_cq)
    q = jnp.einsum('bsr,rhd->bshd', c_q, w_uq)
    q_lat = jnp.einsum('bshd,chd->bshc', q[..., :NOPE_DIM], w_uk)
    q_pe = rope(q[..., NOPE_DIM:], pos)
    ckv = rmsnorm(z[..., OFF_CKV:OFF_KR], g_ckv)
    kpe = rope(z[..., OFF_KR:OFF_GA], pos)
    g_a = z[..., OFF_GA:OFF_QB]
    qb = z[..., OFF_QB:OFF_KB].reshape(b, s, B_HEADS, HEAD_DIM)
    kb = z[..., OFF_KB:OFF_VB].reshape(b, s, B_HEADS, HEAD_DIM)
    vb = z[..., OFF_VB:OFF_GB].reshape(b, s, B_HEADS, HEAD_DIM)
    g_b = z[..., OFF_GB:]
    return q_lat, q_pe, ckv, kpe, g_a, qb, kb, vb, g_b


def mla_attend(q_lat, q_pe, ckv, kpe, mask):
    sc = (jnp.einsum('bqhc,bkc->bhqk', q_lat, ckv)
          + jnp.einsum('bqhr,bkr->bhqk', q_pe, kpe)).astype(jnp.float32) * MLA_SCALE
    if mask is not None:
        sc = jnp.where(mask, sc, NEG)
    p = jax.nn.softmax(sc, axis=-1).astype(ckv.dtype)
    return jnp.einsum('bhqk,bkc->bqhc', p, ckv)


def mla_prompt(q_lat, q_pe, ckv, kpe):
    b, s = q_lat.shape[:2]
    nqb = s // Q_BLOCK
    kchunk = jnp.arange(s) // CHUNK

    def blk(args):
        ql, qp, i = args
        qchunk = (i * Q_BLOCK + jnp.arange(Q_BLOCK)) // CHUNK
        mask = kchunk[None, :] <= qchunk[:, None]
        return mla_attend(ql, qp, ckv, kpe, mask)

    qlb = q_lat.reshape(b, nqb, Q_BLOCK, *q_lat.shape[2:]).swapaxes(0, 1)
    qpb = q_pe.reshape(b, nqb, Q_BLOCK, *q_pe.shape[2:]).swapaxes(0, 1)
    out = lax.map(blk, (qlb, qpb, jnp.arange(nqb)))
    return out.swapaxes(0, 1).reshape(b, s, *out.shape[3:])


def rel_bias_lookup(rel_bias, dist):
    idx = jnp.clip(dist, -MAX_REL, MAX_REL) + MAX_REL
    return rel_bias[:, idx].astype(jnp.float32)


def band_prompt(q, k, v, rel_bias):
    b, s, h, d = q.shape
    nc = s // CHUNK
    w = (BAND_CHUNKS + 1) * CHUNK
    qc = q.reshape(b, nc, CHUNK, h, d)
    pad = ((0, 0), (BAND_CHUNKS, 0), (0, 0), (0, 0), (0, 0))
    kp = jnp.pad(k.reshape(b, nc, CHUNK, h, d), pad)
    vp = jnp.pad(v.reshape(b, nc, CHUNK, h, d), pad)
    kband = jnp.concatenate([kp[:, o:o + nc] for o in range(BAND_CHUNKS + 1)], axis=2)
    vband = jnp.concatenate([vp[:, o:o + nc] for o in range(BAND_CHUNKS + 1)], axis=2)
    sc = jnp.einsum('bnqhd,bnkhd->bnhqk', qc, kband).astype(jnp.float32) * B_SCALE
    a = jnp.arange(CHUNK)[:, None]
    kk = jnp.arange(w)[None, :]
    dist = (BAND_CHUNKS - kk // CHUNK) * CHUNK + a - kk % CHUNK
    sc = sc + rel_bias_lookup(rel_bias, dist)[None, None]
    valid = (jnp.arange(nc)[:, None] - BAND_CHUNKS + (jnp.arange(w) // CHUNK)[None, :]) >= 0
    sc = jnp.where(valid[None, :, None, None, :], sc, NEG)
    p = jax.nn.softmax(sc, axis=-1).astype(v.dtype)
    o = jnp.einsum('bnhqk,bnkhd->bnqhd', p, vband)
    return o.reshape(b, s, h, d)


def band_sample(q, k_new, v_new, kc, vc, rel_bias, past):
    t = q.shape[1]
    kl = kc.shape[1]
    k = jnp.concatenate([kc, k_new], axis=1)
    v = jnp.concatenate([vc, v_new], axis=1)
    qpos = past + jnp.arange(t)
    kpos = jnp.concatenate([past - kl + jnp.arange(kl), past + jnp.arange(t)])
    dist = qpos[:, None] - kpos[None, :]
    sc = jnp.einsum('bqhd,bkhd->bhqk', q, k).astype(jnp.float32) * B_SCALE
    sc = sc + rel_bias_lookup(rel_bias, dist)[None]
    p = jax.nn.softmax(sc, axis=-1).astype(v.dtype)
    return jnp.einsum('bhqk,bkhd->bqhd', p, v)


def merge_heads(o_lat, w_uv, g_a, o_b, g_b, w_out):
    b, s = o_b.shape[:2]
    o_a = jnp.einsum('bshc,chd->bshd', o_lat, w_uv).reshape(b, s, A_WIDTH)
    y = jnp.concatenate([o_a * jax.nn.silu(g_a), o_b.reshape(b, s, B_WIDTH) * jax.nn.silu(g_b)], axis=-1)
    return y @ w_out


def setup_inputs(seed: int = 0) -> dict:
    key = jax.random.key(seed)
    ks = jax.random.split(key, 16)
    kb_len = min(BAND_CHUNKS * CHUNK, PAST_LEN)
    f32 = jnp.float32
    n = lambda k, shape, s=1.0: (jax.random.normal(k, shape, f32) * s)
    return {
        "x_prompt": n(ks[0], (BATCH, SEQ, D_MODEL)),
        "x_sample": n(ks[1], (DEC_BATCH, DEC_SEQ, D_MODEL)),
        "cache_ckv": n(ks[2], (DEPTH, DEC_BATCH, PAST_LEN, KV_LORA)),
        "cache_kpe": n(ks[3], (DEPTH, DEC_BATCH, PAST_LEN, ROPE_DIM)),
        "cache_kb": n(ks[4], (DEPTH, DEC_BATCH, kb_len, B_HEADS, HEAD_DIM)),
        "cache_vb": n(ks[5], (DEPTH, DEC_BATCH, kb_len, B_HEADS, HEAD_DIM)),
        "w_in": n(ks[6], (DEPTH, D_MODEL, IN_WIDTH), D_MODEL ** -0.5),
        "g_mix": 1.0 + n(ks[7], (DEPTH, D_MODEL), 0.02),
        "g_cq": 1.0 + n(ks[8], (DEPTH, Q_LORA), 0.02),
        "w_uq": n(ks[9], (DEPTH, Q_LORA, A_HEADS, NOPE_DIM + ROPE_DIM), Q_LORA ** -0.5),
        "g_ckv": 1.0 + n(ks[10], (DEPTH, KV_LORA), 0.02),
        "w_uk": n(ks[11], (DEPTH, KV_LORA, A_HEADS, NOPE_DIM), KV_LORA ** -0.5),
        "w_uv": n(ks[12], (DEPTH, KV_LORA, A_HEADS, HEAD_DIM), KV_LORA ** -0.5),
        "rel_bias": n(ks[13], (DEPTH, B_HEADS, N_REL), 0.5),
        "w_out": n(ks[14], (DEPTH, MIX_WIDTH, D_MODEL), MIX_WIDTH ** -0.5),
        "g_final": 1.0 + n(ks[15], (D_MODEL,), 0.02),
    }


def reference(x_prompt, x_sample, cache_ckv, cache_kpe, cache_kb, cache_vb,
              w_in, g_mix, g_cq, w_uq, g_ckv, w_uk, w_uv, rel_bias, w_out, g_final):
    s = x_prompt.shape[1]
    t = x_sample.shape[1]
    past = cache_ckv.shape[2]
    kbp = min(BAND_CHUNKS * CHUNK, s)
    pos_p = jnp.arange(s)
    pos_s = past + jnp.arange(t)
    xp, xs = x_prompt, x_sample
    ckv_p, kpe_p, kb_p, vb_p = [], [], [], []
    ckv_s, kpe_s, kb_s, vb_s = [], [], [], []
    for l in range(DEPTH):
        q_lat, q_pe, ckv, kpe, g_a, qb, kb, vb, g_b = mixer_inputs(
            rmsnorm(xp, g_mix[l]), pos_p, w_in[l], g_cq[l], w_uq[l], g_ckv[l], w_uk[l])
        o_lat = mla_prompt(q_lat, q_pe, ckv, kpe)
        o_b = band_prompt(qb, kb, vb, rel_bias[l])
        xp = xp + merge_heads(o_lat, w_uv[l], g_a, o_b, g_b, w_out[l])
        ckv_p.append(ckv); kpe_p.append(kpe)
        kb_p.append(kb[:, s - kbp:]); vb_p.append(vb[:, s - kbp:])
        q_lat, q_pe, ckv, kpe, g_a, qb, kb, vb, g_b = mixer_inputs(
            rmsnorm(xs, g_mix[l]), pos_s, w_in[l], g_cq[l], w_uq[l], g_ckv[l], w_uk[l])
        ckv_all = jnp.concatenate([cache_ckv[l], ckv], axis=1)
        kpe_all = jnp.concatenate([cache_kpe[l], kpe], axis=1)
        o_lat = mla_attend(q_lat, q_pe, ckv_all, kpe_all, None)
        o_b = band_sample(qb, kb, vb, cache_kb[l], cache_vb[l], rel_bias[l], past)
        xs = xs + merge_heads(o_lat, w_uv[l], g_a, o_b, g_b, w_out[l])
        ckv_s.append(ckv); kpe_s.append(kpe); kb_s.append(kb); vb_s.append(vb)
    y_prompt = rmsnorm(xp, g_final)
    y_sample = rmsnorm(xs, g_final)
    return (y_prompt, y_sample,
            jnp.stack(ckv_p), jnp.stack(kpe_p), jnp.stack(kb_p), jnp.stack(vb_p),
            jnp.stack(ckv_s), jnp.stack(kpe_s), jnp.stack(kb_s), jnp.stack(vb_s))
```

```cpp
#include <hip/hip_runtime.h>
#include <hip/hip_bf16.h>
#include <hip/hip_cooperative_groups.h>
#include <cstdio>
#include <cstdint>
#include <type_traits>
namespace cg = cooperative_groups;
#ifndef MK_COOP
#define MK_COOP 1
#endif

namespace pg8 {
#define PG8_LAS __attribute__((address_space(3)))
typedef unsigned short bf16_t;
typedef short bf16x8 __attribute__((ext_vector_type(8)));
typedef float f32x4 __attribute__((ext_vector_type(4)));
typedef unsigned u32x4 __attribute__((ext_vector_type(4)));
constexpr int BM = 256, BK = 64, HALF = 128, HTB = HALF * BK * 2  , STAGE_BYTES = 8 * HTB, NXCD = 8, WGM = 8;

__host__ __device__ __forceinline__ int lds_byte(int r, int c) { const int st = (r >> 4) * 2 + (c >> 5), rr = r & 15, cc = c & 31, ob = rr * 64 + cc * 2; return st * 1024 + (ob ^ (((ob >> 9) & 1) << 5)); }
__host__ __device__ __forceinline__ void stage_rc(int b, int& R, int& C) { const int st = b / 1024, sb = b % 1024, swz = sb ^ (((sb >> 9) & 1) << 5); R = (st >> 1) * 16 + swz / 64; C = (st & 1) * 32 + (swz % 64) / 2; }
__host__ __device__ __forceinline__ int perm32(int rho) { const int n = rho >> 4, i = rho & 15; return 8 * (i >> 2) + 4 * n + (i & 3); }

struct Unit { int pm, pn; };
struct Gemm { const bf16_t* A; const bf16_t* Bt; int M, N, K; };

struct StaticOrder {
    int nM, nN, nwg, G, c;
    __host__ __device__ void init(int M, int N, int G_, int c_) { nM = M / BM; nN = N / BM; nwg = nM * nN; G = G_; c = c_; }
    __host__ __device__ bool next(int i, Unit& u) const {
        const long L = (long)i * G + c; if (L >= nwg) return false;
        int wgid = (int)L; { const int q = nwg / NXCD, r = nwg % NXCD, xcd = wgid % NXCD, off = wgid / NXCD; wgid = (xcd < r ? xcd * (q + 1) : r * (q + 1) + (xcd - r) * q) + off; }
        const int nig = WGM * nN, gid = wgid / nig, fm = gid * WGM, gsz = (nM - fm) < WGM ? (nM - fm) : WGM;
        u.pm = fm + ((wgid % nig) % gsz); u.pn = (wgid % nig) / gsz; return true;
    }
    __device__ __forceinline__ void a_ready(const Unit&) const {}
    __device__ __forceinline__ void done(const Unit&) const {}
};

__device__ __forceinline__ unsigned cvt_pk_bf16(float lo, float hi) { unsigned r; asm volatile("v_cvt_pk_bf16_f32 %0, %1, %2" : "=v"(r) : "v"(lo), "v"(hi)); return r; }
typedef float f32x2 __attribute__((ext_vector_type(2)));
template <class Epi, class Sched, bool ALIGN_EPI = false, bool SP2 = false>
__device__ __forceinline__ void gemm_phase(PG8_LAS unsigned char* lds, const Gemm g, const Sched& S, const Epi& E) {
    int tid_l = threadIdx.x; asm volatile("" : "+v"(tid_l));
    const int tid = tid_l, wid = __builtin_amdgcn_readfirstlane(tid >> 6), lane = tid & 63, wr = wid >> 2, wc = wid & 3, fr = lane & 15, fq = lane >> 4;
    int K_l = g.K; asm volatile("" : "+s"(K_l));
    const int K = K_l, nt = K / BK;
    unsigned voffA[2], voffB[2];
#pragma unroll
    for (int i = 0; i < 2; ++i) { int R, C; stage_rc(tid * 16 + i * 8192, R, C); const int Rb = Epi::PERM ? ((R & ~31) + perm32(R & 31)) : R;
        voffA[i] = (unsigned)(R * K + C) * 2u; voffB[i] = (unsigned)(Rb * K + C) * 2u; }
    const size_t kstep = (size_t)(BK * 2);
    const size_t hstep = (size_t)HALF * K * 2;
    const size_t tstep = 2 * hstep;
    const unsigned ldsw = (unsigned)wid * 1024u;
    const int aoff = lds_byte(wr * 64 + fr, fq * 8), boff = lds_byte(wc * 32 + fr, fq * 8);
#define PG8_SA(b, h) (((b) * 2 + (h)) * HTB)
#define PG8_SB(b, h) ((4 + (b) * 2 + (h)) * HTB)
#define PG8_STAGE(bufoff, gbase, voff) do { _Pragma("unroll") for (int _i = 0; _i < 2; ++_i) \
        __builtin_amdgcn_global_load_lds((const unsigned*)((const char*)(gbase) + (voff)[_i]), (PG8_LAS unsigned*)(lds + (bufoff) + ldsw + _i * 8192), 16, 0, 0); } while (0)
#define PG8_LDA(dst, b, h) do { _Pragma("unroll") for (int m = 0; m < 4; ++m) _Pragma("unroll") for (int k = 0; k < 2; ++k) dst[m][k] = *(const PG8_LAS bf16x8*)(lds + PG8_SA(b, h) + aoff + m * 2048 + k * 1024); } while (0)
#define PG8_LDB(dst, b, h) do { _Pragma("unroll") for (int n = 0; n < 2; ++n) _Pragma("unroll") for (int k = 0; k < 2; ++k) dst[n][k] = *(const PG8_LAS bf16x8*)(lds + PG8_SB(b, h) + boff + n * 2048 + k * 1024); } while (0)
#define PG8_MMA(ai, bj, At, Bt) do { __builtin_amdgcn_s_setprio(1); _Pragma("unroll") for (int m = 0; m < 4; ++m) _Pragma("unroll") for (int n = 0; n < 2; ++n) _Pragma("unroll") for (int k = 0; k < 2; ++k) \
        acc[ai][bj][m][n] = __builtin_amdgcn_mfma_f32_16x16x32_bf16(Bt[n][k], At[m][k], acc[ai][bj][m][n], 0, 0, 0); __builtin_amdgcn_s_setprio(0); } while (0)
#define PG8_WAIT_V(n) asm volatile("s_waitcnt vmcnt(" #n ")" ::: "memory")
#define PG8_WAIT_L(n) asm volatile("s_waitcnt lgkmcnt(" #n ")" ::: "memory")
#define PG8_BAR __builtin_amdgcn_s_barrier()
#define PG8_SCHED __builtin_amdgcn_sched_barrier(0)
    Unit cur, nxt; int ui = 0;
    if (!S.next(0, cur)) return;
    f32x4 acc[2][2][4][2];
#pragma unroll
    for (int a = 0; a < 2; ++a)
#pragma unroll
        for (int b = 0; b < 2; ++b)
#pragma unroll
            for (int m = 0; m < 4; ++m)
#pragma unroll
                for (int n = 0; n < 2; ++n) acc[a][b][m][n] = (f32x4){0.f, 0.f, 0.f, 0.f};
    bf16x8 At[4][2], B0[2][2], B1[2][2];
    const char* cA = (const char*)g.A + (size_t)cur.pm * tstep; const char* cB = (const char*)g.Bt + (size_t)cur.pn * tstep;
    S.a_ready(cur);
    if constexpr (SP2) {
        PG8_STAGE(PG8_SB(0, 0), cB, voffB); PG8_STAGE(PG8_SB(0, 1), cB + hstep, voffB); PG8_STAGE(PG8_SA(0, 0), cA, voffA); PG8_STAGE(PG8_SA(0, 1), cA + hstep, voffA);
        if (wr == 1) PG8_BAR;
        PG8_WAIT_V(2); PG8_BAR;
        PG8_STAGE(PG8_SB(1, 0), cB + kstep, voffB); PG8_STAGE(PG8_SA(1, 0), cA + kstep, voffA); PG8_STAGE(PG8_SB(1, 1), cB + hstep + kstep, voffB);
        PG8_WAIT_V(6); PG8_BAR;
    } else {
        PG8_STAGE(PG8_SB(0, 0), cB, voffB); PG8_STAGE(PG8_SA(0, 0), cA, voffA); PG8_STAGE(PG8_SB(0, 1), cB + hstep, voffB); PG8_STAGE(PG8_SA(0, 1), cA + hstep, voffA);
        if (wr == 1) PG8_BAR;
        PG8_WAIT_V(4); PG8_BAR;
        PG8_STAGE(PG8_SB(1, 0), cB + kstep, voffB); PG8_STAGE(PG8_SA(1, 0), cA + kstep, voffA); PG8_STAGE(PG8_SB(1, 1), cB + hstep + kstep, voffB);
        PG8_WAIT_V(6); PG8_BAR;
    }
    for (;;) {
        const bool has_next = S.next(ui + 1, nxt);
        const char* nA = has_next ? (const char*)g.A + (size_t)nxt.pm * tstep : cA; const char* nB = has_next ? (const char*)g.Bt + (size_t)nxt.pn * tstep : cB;
        for (int t = 0; t < nt; t += 2) {
            const bool last = (t == nt - 2);
            const char* a1 = cA + (size_t)(t + 1) * kstep;
            const char* a2 = last ? nA : cA + (size_t)(t + 2) * kstep; const char* b2 = last ? nB : cB + (size_t)(t + 2) * kstep;
            const char* a3 = a2 + kstep; const char* b3 = b2 + kstep;
            if (last && has_next) S.a_ready(nxt);
            if constexpr (SP2) {
            PG8_LDB(B0, 0, 0); PG8_LDB(B1, 0, 1); PG8_SCHED; PG8_LDA(At, 0, 0); PG8_STAGE(PG8_SA(1, 1), a1 + hstep, voffA);
            PG8_WAIT_V(8); PG8_WAIT_L(0); PG8_BAR; PG8_MMA(0, 0, At, B0); PG8_MMA(0, 1, At, B1); PG8_BAR; PG8_SCHED;
            PG8_LDA(At, 0, 1); PG8_STAGE(PG8_SB(0, 0), b2, voffB); PG8_STAGE(PG8_SB(0, 1), b2 + hstep, voffB); PG8_STAGE(PG8_SA(0, 0), a2, voffA);
            PG8_WAIT_V(8); PG8_WAIT_L(0); PG8_BAR; PG8_MMA(1, 0, At, B0); PG8_MMA(1, 1, At, B1); PG8_BAR; PG8_SCHED;
            PG8_LDB(B0, 1, 0); PG8_LDB(B1, 1, 1); PG8_SCHED; PG8_LDA(At, 1, 0); PG8_STAGE(PG8_SA(0, 1), a2 + hstep, voffA);
            PG8_WAIT_V(8); PG8_WAIT_L(0); PG8_BAR; PG8_MMA(0, 0, At, B0); PG8_MMA(0, 1, At, B1); PG8_BAR; PG8_SCHED;
            PG8_LDA(At, 1, 1); PG8_STAGE(PG8_SB(1, 0), b3, voffB); PG8_STAGE(PG8_SB(1, 1), b3 + hstep, voffB); PG8_STAGE(PG8_SA(1, 0), a3, voffA);
            PG8_WAIT_V(8); PG8_WAIT_L(0); PG8_BAR; PG8_MMA(1, 0, At, B0); PG8_MMA(1, 1, At, B1); PG8_BAR; PG8_SCHED;
            } else {
            PG8_LDB(B0, 0, 0); PG8_SCHED; PG8_LDA(At, 0, 0); PG8_STAGE(PG8_SA(1, 1), a1 + hstep, voffA);
            PG8_WAIT_L(8); PG8_BAR; PG8_WAIT_L(0); PG8_MMA(0, 0, At, B0); PG8_BAR; PG8_SCHED;
            PG8_LDB(B1, 0, 1); PG8_STAGE(PG8_SB(0, 0), b2, voffB);
            PG8_BAR; PG8_WAIT_L(0); PG8_MMA(0, 1, At, B1); PG8_BAR;
            PG8_LDA(At, 0, 1); PG8_STAGE(PG8_SA(0, 0), a2, voffA);
            PG8_BAR; PG8_WAIT_L(0); PG8_MMA(1, 0, At, B0); PG8_BAR; PG8_SCHED;
            PG8_STAGE(PG8_SB(0, 1), b2 + hstep, voffB);
            PG8_WAIT_V(6); PG8_BAR; PG8_MMA(1, 1, At, B1); PG8_BAR;
            PG8_LDB(B0, 1, 0); PG8_SCHED; PG8_LDA(At, 1, 0); PG8_STAGE(PG8_SA(0, 1), a2 + hstep, voffA);
            PG8_WAIT_L(8); PG8_BAR; PG8_WAIT_L(0); PG8_MMA(0, 0, At, B0); PG8_BAR; PG8_SCHED;
            PG8_LDB(B1, 1, 1); PG8_STAGE(PG8_SB(1, 0), b3, voffB);
            PG8_BAR; PG8_WAIT_L(0); PG8_MMA(0, 1, At, B1); PG8_BAR;
            PG8_LDA(At, 1, 1); PG8_STAGE(PG8_SA(1, 0), a3, voffA);
            PG8_BAR; PG8_WAIT_L(0); PG8_MMA(1, 0, At, B0); PG8_BAR; PG8_SCHED;
            PG8_STAGE(PG8_SB(1, 1), b3 + hstep, voffB);
            PG8_WAIT_V(6); PG8_BAR; PG8_MMA(1, 1, At, B1); PG8_BAR;
            }
        }
        if constexpr (ALIGN_EPI) { if (wr == 0) PG8_BAR; }
        if constexpr (!Epi::AFTER_DRAIN) { E(acc, cur, wr, wc, fr, fq); S.done(cur); }
        if (!has_next) break;
#pragma unroll
        for (int a = 0; a < 2; ++a)
#pragma unroll
            for (int b = 0; b < 2; ++b)
#pragma unroll
                for (int m = 0; m < 4; ++m)
#pragma unroll
                    for (int n = 0; n < 2; ++n) acc[a][b][m][n] = (f32x4){0.f, 0.f, 0.f, 0.f};
        cur = nxt; cA = nA; cB = nB; ++ui;
        if constexpr (ALIGN_EPI) { if (wr == 1) PG8_BAR; }
    }
    PG8_WAIT_V(0);
    if constexpr (!ALIGN_EPI) { if (wr == 0) PG8_BAR; }
    PG8_BAR;
    if constexpr (Epi::AFTER_DRAIN) { E.fused(acc, cur, wr, wc, fr, fq, lds, wid, lane); S.done(cur); }
#undef PG8_SA
#undef PG8_SB
#undef PG8_STAGE
#undef PG8_LDA
#undef PG8_LDB
#undef PG8_MMA
#undef PG8_WAIT_V
#undef PG8_WAIT_L
#undef PG8_BAR
#undef PG8_SCHED
}
}

#define LAS __attribute__((address_space(3)))
typedef unsigned short bf16_t;
typedef short bf16x8 __attribute__((ext_vector_type(8)));
typedef short s16x4 __attribute__((ext_vector_type(4)));
typedef float f32x4 __attribute__((ext_vector_type(4)));
typedef float f32x2 __attribute__((ext_vector_type(2)));
typedef float f32x16 __attribute__((ext_vector_type(16)));
typedef unsigned u32x4 __attribute__((ext_vector_type(4)));
typedef unsigned u32x2 __attribute__((ext_vector_type(2)));

constexpr int DM = 1024, SEQ = 4096, NB = 8, TS = 32, PAST = 4096;
constexpr int MP = NB * SEQ, MS = NB * TS, M1 = MP + MS;
constexpr int KVS = PAST + 64, KVR = MP + NB * KVS;
constexpr int BVS = 512 + 64, BVR = MP + NB * BVS;
constexpr int NIN = 3072;
constexpr float EPS = 1e-6f, LOG2E = 1.4426950408889634f;
constexpr float QS_MLA = 0.10206207261596575f * LOG2E;
constexpr float QS_B = 0.125f * LOG2E;
constexpr int OFF_CQ = 0, OFF_CKV = 256, OFF_KR = 384, OFF_GA = 416, OFF_QB = 928, OFF_KB = 1440, OFF_VB = 1952, OFF_GB = 2464, IN_W = 2976;
constexpr size_t O_YP = 0, O_YS = O_YP + (size_t)MP * DM, O_CKVP = O_YS + (size_t)MS * DM, O_KPEP = O_CKVP + (size_t)MP * 128,
                 O_KBP = O_KPEP + (size_t)MP * 32, O_VBP = O_KBP + (size_t)NB * 512 * 512, O_CKVS = O_VBP + (size_t)NB * 512 * 512,
                 O_KPES = O_CKVS + (size_t)MS * 128, O_KBS = O_KPES + (size_t)MS * 32, O_VBS = O_KBS + (size_t)MS * 512, O_END = O_VBS + (size_t)MS * 512;
constexpr size_t al256(size_t x) { return (x + 255) & ~(size_t)255; }
constexpr size_t WS_CTL = 0, WS_ROPE = 32768, WS_WIN = al256(WS_ROPE + (size_t)(PAST + TS) * 32 * 4), WS_WUQ = WS_WIN + (size_t)NIN * 1024 * 2,
                 WS_WUKV = WS_WUQ + (size_t)768 * 256 * 2, WS_WOUT = WS_WUKV + (size_t)1024 * 128 * 2, WS_XN = WS_WOUT + (size_t)1024 * 1024 * 2,
                 WS_CQ = WS_XN + (size_t)M1 * 1024 * 2, WS_CKV = WS_CQ + (size_t)M1 * 256 * 2, WS_KPE = WS_CKV + (size_t)KVR * 128 * 2,
                 WS_SG = WS_KPE + (size_t)KVR * 32 * 2, WS_QB = WS_SG + (size_t)M1 * 1024 * 2, WS_KVB = WS_QB + (size_t)M1 * 512 * 2,
                 WS_QM = WS_KVB + (size_t)BVR * 1024 * 2, WS_KVM = WS_QM + (size_t)M1 * 768 * 2, WS_END = WS_KVM + (size_t)KVR * 1024 * 2;
constexpr size_t WS_Y = WS_XN;
constexpr size_t WS_ZCQ = WS_QM, WS_ZCKV = WS_QM + (size_t)M1 * 256 * 2;
static_assert(WS_ZCKV + (size_t)M1 * 128 * 4 <= WS_KVM, "overlay");
constexpr size_t WS_X1 = WS_KVM, WS_SSQ = WS_QM;

constexpr int LDS_RING = 131072, LDS_TOTAL = LDS_RING + 1024;

__device__ __forceinline__ unsigned pk_bf16(float lo, float hi) { f32x2 v = {lo, hi}; typedef __bf16 bf2 __attribute__((ext_vector_type(2))); bf2 b = __builtin_convertvector(v, bf2); return __builtin_bit_cast(unsigned, b); }
__device__ __forceinline__ float bf_lo(unsigned w) { return __builtin_bit_cast(float, w << 16); }
__device__ __forceinline__ float bf_hi(unsigned w) { return __builtin_bit_cast(float, w & 0xffff0000u); }
__device__ __forceinline__ u32x4 pk8(const f32x4 a, const f32x4 b) { u32x4 w; w.x = pk_bf16(a[0], a[1]); w.y = pk_bf16(a[2], a[3]); w.z = pk_bf16(b[0], b[1]); w.w = pk_bf16(b[2], b[3]); return w; }
__device__ __forceinline__ float wave_sum(float v) {
#pragma unroll
    for (int o = 1; o < 64; o <<= 1) v += __shfl_xor(v, o);
    return v;
}
__device__ __forceinline__ int kvrow_m(int row) { if (row < MP) return row; const int r = row - MP; return MP + (r >> 5) * KVS + PAST + (r & 31); }
__device__ __forceinline__ int kvrow_b(int row) { if (row < MP) return row; const int r = row - MP; return MP + (r >> 5) * BVS + 512 + (r & 31); }
__device__ __forceinline__ int pos_of(int row) { if (row < MP) return row & (SEQ - 1); return PAST + ((row - MP) & 31); }

__device__ __forceinline__ void rope8(f32x4& v0, f32x4& v1, const float* rp  , int fq) {
    const int i0 = 8 * (fq & 1);
    const f32x4 c0 = *(const f32x4*)(rp + i0), c1 = *(const f32x4*)(rp + i0 + 4), s0 = *(const f32x4*)(rp + 16 + i0), s1 = *(const f32x4*)(rp + 16 + i0 + 4);
    f32x4 p0, p1;
#pragma unroll
    for (int j = 0; j < 4; ++j) { p0[j] = __shfl_xor(v0[j], 32); p1[j] = __shfl_xor(v1[j], 32); }
    if (fq < 2) { v0 = v0 * c0 - p0 * s0; v1 = v1 * c1 - p1 * s1; }
    else        { v0 = p0 * s0 + v0 * c0; v1 = p1 * s1 + v1 * c1; }
}
__device__ __forceinline__ float silu_f(float g) { return g * __builtin_amdgcn_rcpf(1.0f + __builtin_amdgcn_exp2f(-g * LOG2E)); }

struct EpiG1 {
    static constexpr bool PERM = true, AFTER_DRAIN = false;
    bf16_t *zcq, *kpe, *sg, *qb, *kvb; float* zckv; float* out; const float* rope;
    __device__ __forceinline__ void operator()(const f32x4 (&acc)[2][2][4][2], const pg8::Unit& u, int wr, int wc, int fr, int fq) const {
        const int pn = u.pn, row0 = u.pm * 256 + wr * 64 + fr, cl = wc * 32 + 8 * fq;
        if (pn == 0) {
#pragma unroll
            for (int ai = 0; ai < 2; ++ai)
#pragma unroll
                for (int m = 0; m < 4; ++m) { const int row = row0 + ai * 128 + m * 16;
#pragma unroll
                    for (int bj = 0; bj < 2; ++bj) *(u32x4*)(zcq + (size_t)row * 256 + bj * 128 + cl) = pk8(acc[ai][bj][m][0], acc[ai][bj][m][1]); }
        } else if (pn == 1) {
#pragma unroll
            for (int ai = 0; ai < 2; ++ai)
#pragma unroll
                for (int m = 0; m < 4; ++m) { const int row = row0 + ai * 128 + m * 16; float* p = zckv + (size_t)row * 128 + cl;
                    *(f32x4*)p = acc[ai][0][m][0]; *(f32x4*)(p + 4) = acc[ai][0][m][1]; }
            if (wc == 0) {
#pragma unroll
                for (int ai = 0; ai < 2; ++ai)
#pragma unroll
                    for (int m = 0; m < 4; ++m) { const int row = row0 + ai * 128 + m * 16; f32x4 v0 = acc[ai][1][m][0], v1 = acc[ai][1][m][1];
                        rope8(v0, v1, rope + (size_t)pos_of(row) * 32, fq);
                        float* po = (row < MP) ? out + O_KPEP + (size_t)row * 32 + 8 * fq : out + O_KPES + (size_t)(row - MP) * 32 + 8 * fq;
                        *(f32x4*)po = v0; *(f32x4*)(po + 4) = v1;
                        *(u32x4*)(kpe + (size_t)kvrow_m(row) * 32 + 8 * fq) = pk8(v0, v1); asm volatile("" ::: "memory"); }
            }
        } else if (pn < 6) {
            const int cb = (pn - 2) * 256 + cl;
#pragma unroll
            for (int ai = 0; ai < 2; ++ai)
#pragma unroll
                for (int m = 0; m < 4; ++m) { const int row = row0 + ai * 128 + m * 16;
#pragma unroll
                    for (int bj = 0; bj < 2; ++bj) { f32x4 a = acc[ai][bj][m][0], b = acc[ai][bj][m][1];
#pragma unroll
                        for (int j = 0; j < 4; ++j) { a[j] = silu_f(a[j]); b[j] = silu_f(b[j]); }
                        *(u32x4*)(sg + (size_t)row * 1024 + cb + bj * 128) = pk8(a, b); } }
        } else if (pn < 8) {
            const int cb = (pn - 6) * 256 + cl;
#pragma unroll
            for (int ai = 0; ai < 2; ++ai)
#pragma unroll
                for (int m = 0; m < 4; ++m) { const int row = row0 + ai * 128 + m * 16;
#pragma unroll
                    for (int bj = 0; bj < 2; ++bj) *(u32x4*)(qb + (size_t)row * 512 + cb + bj * 128) = pk8(acc[ai][bj][m][0] * QS_B, acc[ai][bj][m][1] * QS_B); }
        } else if (pn < 12) {
            const int cb = (pn - 8) * 256 + cl;
            const bool isv = pn >= 10; const int co = cb - (isv ? 512 : 0);
#pragma unroll
            for (int ai = 0; ai < 2; ++ai)
#pragma unroll
                for (int m = 0; m < 4; ++m) { const int row = row0 + ai * 128 + m * 16;
                    float* po = nullptr;
                    if (row < MP) { const int s = row & (SEQ - 1); if (s >= SEQ - 512) po = out + (isv ? O_VBP : O_KBP) + ((size_t)(row >> 12) * 512 + (s - (SEQ - 512))) * 512 + co; }
                    else po = out + (isv ? O_VBS : O_KBS) + (size_t)(row - MP) * 512 + co;
                    bf16_t* pk = kvb + (size_t)kvrow_b(row) * 1024 + cb;
#pragma unroll
                    for (int bj = 0; bj < 2; ++bj) { *(u32x4*)(pk + bj * 128) = pk8(acc[ai][bj][m][0], acc[ai][bj][m][1]);
                        if (po) { *(f32x4*)(po + bj * 128) = acc[ai][bj][m][0]; *(f32x4*)(po + bj * 128 + 4) = acc[ai][bj][m][1]; } } }
        }
    }
};
__device__ __forceinline__ void rope8t(f32x4& v0, f32x4& v1, const f32x4 c0, const f32x4 c1, const f32x4 s0, const f32x4 s1, int fq) {
    f32x4 p0, p1;
#pragma unroll
    for (int j = 0; j < 4; ++j) { p0[j] = __shfl_xor(v0[j], 32); p1[j] = __shfl_xor(v1[j], 32); }
    if (fq < 2) { v0 = v0 * c0 - p0 * s0; v1 = v1 * c1 - p1 * s1; }
    else        { v0 = p0 * s0 + v0 * c0; v1 = p1 * s1 + v1 * c1; }
}
struct EpiG2 {
    static constexpr bool PERM = true, AFTER_DRAIN = false;
    bf16_t* qm; const float* rope;
    __device__ __forceinline__ void operator()(const f32x4 (&acc)[2][2][4][2], const pg8::Unit& u, int wr, int wc, int fr, int fq) const {
        const int pn = u.pn, row0 = u.pm * 256 + wr * 64 + fr;
        if (pn < 2) {
#pragma unroll
            for (int ai = 0; ai < 2; ++ai)
#pragma unroll
                for (int m = 0; m < 4; ++m) { const int row = row0 + ai * 128 + m * 16;
#pragma unroll
                    for (int bj = 0; bj < 2; ++bj) { const int n = pn * 256 + bj * 128 + wc * 32 + 8 * fq; const int dc = (n >> 6) * 96 + (n & 63);
                        *(u32x4*)(qm + (size_t)row * 768 + dc) = pk8(acc[ai][bj][m][0] * QS_MLA, acc[ai][bj][m][1] * QS_MLA); } }
        } else {
            const int i0 = 8 * (fq & 1);
#pragma unroll
            for (int ai = 0; ai < 2; ++ai)
#pragma unroll
                for (int mp = 0; mp < 4; mp += 2) {
                    f32x4 c0[2], c1[2], s0[2], s1[2];
#pragma unroll
                    for (int q = 0; q < 2; ++q) { const float* rp = rope + (size_t)pos_of(row0 + ai * 128 + (mp + q) * 16) * 32 + i0;
                        c0[q] = *(const f32x4*)rp; c1[q] = *(const f32x4*)(rp + 4); s0[q] = *(const f32x4*)(rp + 16); s1[q] = *(const f32x4*)(rp + 20); }
#pragma unroll
                    for (int q = 0; q < 2; ++q) { const int m = mp + q, row = row0 + ai * 128 + m * 16;
#pragma unroll
                        for (int bj = 0; bj < 2; ++bj) { f32x4 v0 = acc[ai][bj][m][0], v1 = acc[ai][bj][m][1];
                            rope8t(v0, v1, c0[q], c1[q], s0[q], s1[q], fq);
                            *(u32x4*)(qm + (size_t)row * 768 + (bj * 4 + wc) * 96 + 64 + 8 * fq) = pk8(v0 * QS_MLA, v1 * QS_MLA); } }
                    asm volatile("" ::: "memory");
                }
        }
    }
};
struct EpiPlain {
    static constexpr bool PERM = true, AFTER_DRAIN = false;
    bf16_t* O; int ldc;
    __device__ __forceinline__ void operator()(const f32x4 (&acc)[2][2][4][2], const pg8::Unit& u, int wr, int wc, int fr, int fq) const {
        const int row0 = u.pm * 256 + wr * 64 + fr, col0 = u.pn * 256 + wc * 32 + 8 * fq;
#pragma unroll
        for (int ai = 0; ai < 2; ++ai)
#pragma unroll
            for (int m = 0; m < 4; ++m) { bf16_t* p = O + (size_t)(row0 + ai * 128 + m * 16) * ldc + col0;
#pragma unroll
                for (int bj = 0; bj < 2; ++bj) *(u32x4*)(p + bj * 128) = pk8(acc[ai][bj][m][0], acc[ai][bj][m][1]); }
    }
};
struct EpiG4 {
    static constexpr bool PERM = true, AFTER_DRAIN = false;
    const float *xp, *xs; float* out; bf16_t* x1; float* ssq;
    __device__ __forceinline__ void operator()(const f32x4 (&acc)[2][2][4][2], const pg8::Unit& u, int wr, int wc, int fr, int fq) const {
        const int row0 = u.pm * 256 + wr * 64 + fr, col0 = u.pn * 256 + wc * 32 + 8 * fq;
        if (u.pm < MP / 256) {
#pragma unroll
            for (int ai = 0; ai < 2; ++ai) {
                f32x4 xr[4][2][2];
#pragma unroll
                for (int m = 0; m < 4; ++m) { const float* px = xp + (size_t)(row0 + ai * 128 + m * 16) * 1024 + col0;
#pragma unroll
                    for (int bj = 0; bj < 2; ++bj) { xr[m][bj][0] = __builtin_nontemporal_load((const f32x4*)(px + bj * 128)); xr[m][bj][1] = __builtin_nontemporal_load((const f32x4*)(px + bj * 128 + 4)); } }
#pragma unroll
                for (int m = 0; m < 4; ++m) { const int row = row0 + ai * 128 + m * 16; bf16_t* po = x1 + (size_t)row * 1024 + col0; float s = 0.f;
#pragma unroll
                    for (int bj = 0; bj < 2; ++bj) { const f32x4 a = xr[m][bj][0] + acc[ai][bj][m][0], b = xr[m][bj][1] + acc[ai][bj][m][1];
                        s += (a[0] * a[0] + a[1] * a[1]) + (a[2] * a[2] + a[3] * a[3]) + (b[0] * b[0] + b[1] * b[1]) + (b[2] * b[2] + b[3] * b[3]);
                        *(u32x4*)(po + bj * 128) = pk8(a, b); }
                    s += __shfl_xor(s, 16); s += __shfl_xor(s, 32);
                    if (fq == 0) ssq[(size_t)row * 16 + u.pn * 4 + wc] = s; }
                asm volatile("" ::: "memory");
            }
        } else {
#pragma unroll
            for (int ai = 0; ai < 2; ++ai)
#pragma unroll
                for (int m = 0; m < 4; ++m) { const int row = row0 + ai * 128 + m * 16;
                    const float* px = xs + (size_t)(row - MP) * 1024 + col0; float* po = out + (size_t)row * 1024 + col0;
#pragma unroll
                    for (int bj = 0; bj < 2; ++bj) { const f32x4 a = *(const f32x4*)(px + bj * 128), b = *(const f32x4*)(px + bj * 128 + 4);
                        *(f32x4*)(po + bj * 128) = a + acc[ai][bj][m][0]; *(f32x4*)(po + bj * 128 + 4) = b + acc[ai][bj][m][1]; } }
        }
    }
};

struct SkewOrder {
    int nM, nN, nwg, G, c, base_rounds, c0;
    __device__ void init(int M, int N, int G_, int c_, int br, int c0_) { nM = M / 256; nN = N / 256; nwg = nM * nN; G = G_; c = c_; base_rounds = br; c0 = c0_; }
    __device__ bool next(int i, pg8::Unit& u) const {
        long L;
        if (i < base_rounds) L = (long)i * G + c;
        else { if (c < c0) return false; L = (long)base_rounds * G + (long)(i - base_rounds) * (G - c0) + (c - c0); }
        if (L >= nwg) return false;
        int wgid = (int)L; { const int q = nwg / 8, r = nwg % 8, xcd = wgid % 8, off = wgid / 8; wgid = (xcd < r ? xcd * (q + 1) : r * (q + 1) + (xcd - r) * q) + off; }
        const int nig = 8 * nN, gid = wgid / nig, fm = gid * 8, gsz = (nM - fm) < 8 ? (nM - fm) : 8;
        u.pm = fm + ((wgid % nig) % gsz); u.pn = (wgid % nig) / gsz; return true;
    }
    __device__ __forceinline__ void a_ready(const pg8::Unit&) const {}
    __device__ __forceinline__ void done(const pg8::Unit&) const {}
};
struct OneUnit {
    int pm, pn;
    __device__ __forceinline__ bool next(int i, pg8::Unit& u) const { if (i > 0) return false; u.pm = pm; u.pn = pn; return true; }
    __device__ __forceinline__ void a_ready(const pg8::Unit&) const {}
    __device__ __forceinline__ void done(const pg8::Unit&) const {}
};
#ifndef MK_E1
#define MK_E1 0
#endif
#ifndef MK_E2
#define MK_E2 0
#endif
#ifndef MK_GRP_ODD
#define MK_GRP_ODD 0
#endif
namespace at {
constexpr int KSLOT = 12288, VSLOT = 8192;
constexpr int L_K = 0, L_V = 4 * KSLOT, L_WS = L_V + 4 * VSLOT, L_OST = L_WS + 8 * 256, L_TAB = L_OST + 8 * 4096, L_IDX = L_TAB + 1296, L_END = L_IDX + 16;
static_assert(L_END <= LDS_RING, "attention LDS");
__device__ __forceinline__ int crow(int r, int hi) { return (r & 3) + 8 * (r >> 2) + 4 * hi; }
__device__ __forceinline__ void glds16(const void* gsrc, unsigned lds_dst) { unsigned keep;
    asm volatile("s_mov_b32 %0, m0\n\ts_mov_b32 m0, %2\n\ts_nop 0\n\tglobal_load_lds_dwordx4 %1, off\n\ts_mov_b32 m0, %0" : "=&s"(keep) : "v"(gsrc), "s"(lds_dst) : "memory"); }
#define AT_WAITBAR() asm volatile("s_waitcnt vmcnt(0) lgkmcnt(0)\n\ts_barrier" ::: "memory")
#define AT_BAR() asm volatile("s_waitcnt lgkmcnt(0)\n\ts_barrier" ::: "memory")
#define AT_MFMA(a, b, c) __builtin_amdgcn_mfma_f32_32x32x16_bf16(a, b, c, 0, 0, 0)

template <int NQ> __device__ __forceinline__ void kload(bf16x8* kf, LAS const char* kslot, int r32, int hi) {
    LAS const char* kb = kslot + hi * 1024 + r32 * 16;
#pragma unroll
    for (int d0 = 0; d0 < NQ; ++d0) { kf[2 * d0] = *(LAS const bf16x8*)(kb + d0 * 2048); kf[2 * d0 + 1] = *(LAS const bf16x8*)(kb + d0 * 2048 + 512); }
}
template <int NQ> __device__ __forceinline__ void qkmm(f32x16& p0, f32x16& p1, const bf16x8* kf, const bf16x8* qr, const f32x16& cinit) {
#pragma unroll
    for (int d0 = 0; d0 < NQ; ++d0) {
        if (d0 == 0) { p0 = AT_MFMA(kf[0], qr[0], cinit); p1 = AT_MFMA(kf[1], qr[0], cinit); }
        else { p0 = AT_MFMA(kf[2 * d0], qr[d0], p0); p1 = AT_MFMA(kf[2 * d0 + 1], qr[d0], p1); }
    }
}
__device__ __forceinline__ float max3f(float a, float b, float c) { float r; asm("v_max3_f32 %0, %1, %2, %3" : "=v"(r) : "v"(a), "v"(b), "v"(c)); return r; }
__device__ __forceinline__ float max2f(float a, float b) { float r; asm("v_max_f32_e32 %0, %1, %2" : "=v"(r) : "v"(a), "v"(b)); return r; }
__device__ __forceinline__ float rowmax3(const f32x16& p0, const f32x16& p1) {
    float a = max3f(p0[0], p0[1], p1[0]), b = max3f(p0[2], p0[3], p1[1]); a = max3f(a, p1[2], p1[3]);
#pragma unroll
    for (int r = 4; r < 16; r += 4) { a = max3f(a, p0[r], p0[r + 1]); b = max3f(b, p0[r + 2], p0[r + 3]); a = max3f(a, p1[r], p1[r + 1]); b = max3f(b, p1[r + 2], p1[r + 3]); }
    const float m = max2f(a, b);
    auto rr = __builtin_amdgcn_permlane32_swap(__float_as_uint(m), __float_as_uint(m), false, false);
    return max2f(__uint_as_float(rr[0]), __uint_as_float(rr[1]));
}
__device__ __forceinline__ float rowmax(const f32x16& p0, const f32x16& p1) {
    float a = fmaxf(p0[0], p1[0]);
#pragma unroll
    for (int r = 1; r < 16; ++r) a = fmaxf(a, fmaxf(p0[r], p1[r]));
    auto rr = __builtin_amdgcn_permlane32_swap(__float_as_uint(a), __float_as_uint(a), false, false);
    return fmaxf(__uint_as_float(rr[0]), __uint_as_float(rr[1]));
}
typedef short v4i16_t __attribute__((ext_vector_type(4)));
__device__ __forceinline__ s16x4 vtr(LAS const char* p) { return __builtin_bit_cast(s16x4, __builtin_amdgcn_ds_read_tr16_b64_v4i16((LAS v4i16_t*)p)); }
__device__ __forceinline__ void vload(s16x4* vf, LAS const char* vp) {
#pragma unroll
    for (int d0 = 0; d0 < 2; ++d0)
#pragma unroll
        for (int ks = 0; ks < 4; ++ks) { vf[d0 * 8 + 2 * ks] = vtr(vp + d0 * 4096 + ks * 1024); vf[d0 * 8 + 2 * ks + 1] = vtr(vp + d0 * 4096 + ks * 1024 + 512); }
}
__device__ __forceinline__ void pvm(f32x16* o, const s16x4* vf, bf16x8 pa0, bf16x8 pa1, bf16x8 pa2, bf16x8 pa3) {
#define AT_PK(d, k) (bf16x8){vf[d * 8 + 2 * k][0], vf[d * 8 + 2 * k][1], vf[d * 8 + 2 * k][2], vf[d * 8 + 2 * k][3], vf[d * 8 + 2 * k + 1][0], vf[d * 8 + 2 * k + 1][1], vf[d * 8 + 2 * k + 1][2], vf[d * 8 + 2 * k + 1][3]}
    o[0] = AT_MFMA(pa0, AT_PK(0, 0), o[0]); o[1] = AT_MFMA(pa0, AT_PK(1, 0), o[1]);
    o[0] = AT_MFMA(pa1, AT_PK(0, 1), o[0]); o[1] = AT_MFMA(pa1, AT_PK(1, 1), o[1]);
    o[0] = AT_MFMA(pa2, AT_PK(0, 2), o[0]); o[1] = AT_MFMA(pa2, AT_PK(1, 2), o[1]);
    o[0] = AT_MFMA(pa3, AT_PK(0, 3), o[0]); o[1] = AT_MFMA(pa3, AT_PK(1, 3), o[1]);
#undef AT_PK
}

struct Tens { const bf16_t *qm, *qb, *kvm, *kvb, *kpe, *sg; bf16_t* y; const float* relb; };

template <int KIND> __device__ __forceinline__ void unit(const Tens& T, int seq, int h, int u, LAS unsigned char* lds) {
    constexpr int NQ = KIND == 0 ? 6 : 4;
    int tid_l = threadIdx.x; asm volatile("" : "+v"(tid_l));
    const int tid = tid_l, lane = tid & 63, r32 = lane & 31, hi = lane >> 5; const int wid = __builtin_amdgcn_readfirstlane(tid >> 6);
    const bool samp = seq >= NB; const int b = seq & 7;
    const unsigned lds0 = (unsigned)(uintptr_t)lds;
    int qrow, T0, T1, vlo, vhi, cq; size_t kvbase; bool active = true;
    if (KIND == 0) {
        if (!samp) { qrow = b * SEQ + 256 * u + 32 * wid; kvbase = (size_t)b * SEQ; T0 = 0; T1 = 4 * u + 4; vlo = 0; vhi = 4 * u + (wid >> 1); cq = vhi; }
        else { qrow = MP + b * TS; kvbase = (size_t)MP + (size_t)b * KVS; T0 = 0; T1 = 65; vlo = 0; vhi = 64; cq = 64; active = (wid == 0); }
    } else {
        if (!samp) { qrow = b * SEQ + 256 * u + 32 * wid; kvbase = (size_t)b * SEQ; T0 = 4 * u - 8 < 0 ? 0 : 4 * u - 8; T1 = 4 * u + 4; cq = 4 * u + (wid >> 1); vlo = cq - 8 < 0 ? 0 : cq - 8; vhi = cq; }
        else { qrow = MP + b * TS; kvbase = (size_t)MP + (size_t)b * BVS; T0 = 0; T1 = 9; vlo = 0; vhi = 8; cq = 8; active = (wid == 0); }
    }
    const bf16_t* KV = (KIND == 0 ? T.kvm : T.kvb) + kvbase * 1024 + h * 64;
    const bf16_t* ksrc = KV + (size_t)lane * 1024 + wid * 8;
    const bf16_t* k2src = T.kpe + (kvbase + lane) * 32 + (wid & 3) * 8;
    const bf16_t* vsrc = KV + 512 + (size_t)(16 * (wid & 3) + (lane >> 2)) * 1024 + (wid >> 2) * 32 + (lane & 3) * 8;
    const unsigned kdst = lds0 + L_K + wid * 1024, k2dst = lds0 + L_K + (8 + (wid & 3)) * 1024, vdst = lds0 + L_V + wid * 1024;
#define AT_DMA(t, s) do { AT_DMA1(t, s); if (MK_E1) AT_DMA1(t, s); } while (0)
#define AT_DMA1(t, s) do { glds16(ksrc + (size_t)(t) * 64 * 1024, (unsigned)__builtin_amdgcn_readfirstlane(kdst + (s) * KSLOT)); \
        if (KIND == 0 && wid < 4) glds16(k2src + (size_t)(t) * 64 * 32, (unsigned)__builtin_amdgcn_readfirstlane(k2dst + (s) * KSLOT)); \
        glds16(vsrc + (size_t)(t) * 64 * 1024, (unsigned)__builtin_amdgcn_readfirstlane(vdst + (s) * VSLOT)); } while (0)
    const int grp = (MK_GRP_ODD) ? (wid & 1) : (wid >> 2);
#define AT_DMA_K(t, s) glds16(ksrc + (size_t)(t) * 64 * 1024, (unsigned)__builtin_amdgcn_readfirstlane(kdst + (s) * KSLOT))
#define AT_DMA_K2(t, s) do { if (KIND == 0 && wid < 4) glds16(k2src + (size_t)(t) * 64 * 32, (unsigned)__builtin_amdgcn_readfirstlane(k2dst + (s) * KSLOT)); } while (0)
#define AT_DMA_V(t, s) glds16(vsrc + (size_t)(t) * 64 * 1024, (unsigned)__builtin_amdgcn_readfirstlane(vdst + (s) * VSLOT))
    AT_DMA(T0, 0);
    LAS float* tab = (LAS float*)(lds + L_TAB);
    if (KIND == 1) { if (tid < 320) tab[tid] = T.relb[h * 257 + (tid > 256 ? 256 : tid)] * LOG2E; }
    bf16x8 qr[NQ];
    {   const bf16_t* Qw = (KIND == 0 ? T.qm + (size_t)qrow * 768 + h * 96 : T.qb + (size_t)qrow * 512 + h * 64) + (size_t)r32 * (KIND == 0 ? 768 : 512) + hi * 8;
#pragma unroll
        for (int d0 = 0; d0 < NQ; ++d0) qr[d0] = active ? *(const bf16x8*)(Qw + d0 * 16) : (bf16x8){0, 0, 0, 0, 0, 0, 0, 0}; }
#pragma unroll
    for (int d0 = 0; d0 < NQ; ++d0) asm volatile("" : "+v"(qr[d0]));
    AT_DMA(T0 + 1, 1); AT_DMA(T0 + 2, 2);
#define AT_WAIT_TILES(n) do { if ((n) == 2) asm volatile("s_waitcnt vmcnt(4)" ::: "memory"); else if ((n) == 1) asm volatile("s_waitcnt vmcnt(2)" ::: "memory"); else asm volatile("s_waitcnt vmcnt(0)" ::: "memory"); } while (0)
    AT_WAIT_TILES(2);
    AT_BAR();
    LAS float* wsf = (LAS float*)(lds + L_WS) + wid * 64;
    const int vboff = ((lane >> 4) & 1) * 32 + (lane & 3) * 8 + (4 * hi + ((lane & 15) >> 2)) * 64;
    float m_ref = 0.f, l_run = 0.f; bool first = true; f32x16 o[2]; o[0] = f32x16{}; o[1] = f32x16{};
    const float cbfar = (KIND == 1) ? tab[256] : 0.f;
    f32x16 negn = f32x16{}, negf;
#pragma unroll
    for (int r = 0; r < 16; ++r) negf[r] = cbfar;
    const int aq = 32 * (wid & 1) + r32;
    bf16x8 kf[2 * NQ]; s16x4 vf[16];
    f32x16 p0, p1;
    if (grp == 1) { AT_WAIT_TILES(1); AT_DMA(T0 + 3, 3); }
    if (active && T0 >= vlo) kload<NQ>(kf, (LAS const char*)(lds + L_K), r32, hi);
    if (grp == 1) AT_BAR();
    for (int j = T0; j < T1; ++j) {
        const int sc = (j - T0) & 3;
        const bool vis = active && j >= vlo && j <= vhi;
        const bool visn = active && j + 1 >= vlo && j + 1 <= vhi && j + 1 < T1;
        const bool issA = (grp == 0) && (j + 3 < T1), issB = (grp == 1) && (j + 4 < T1);
        if (grp == 0) { if (j + 2 < T1) AT_WAIT_TILES(1); else AT_WAIT_TILES(0); if (issA && !vis) AT_DMA(j + 3, (sc + 3) & 3); }
        if (vis) {
            const int jd = cq - j;
            vload(vf, (LAS const char*)(lds + L_V + sc * VSLOT) + vboff);
            __builtin_amdgcn_sched_barrier(0);
            if (KIND == 1 && jd >= 3) { p0 = AT_MFMA(kf[0], qr[0], negf); p1 = AT_MFMA(kf[1], qr[0], negf); asm volatile("" ::: "memory"); }
            else { p0 = AT_MFMA(kf[0], qr[0], negn); p1 = AT_MFMA(kf[1], qr[0], negn); asm volatile("" ::: "memory"); }
            __builtin_amdgcn_sched_barrier(0); if (issA) AT_DMA_K(j + 3, (sc + 3) & 3); __builtin_amdgcn_sched_barrier(0);
            p0 = AT_MFMA(kf[2], qr[1], p0); p1 = AT_MFMA(kf[3], qr[1], p1);
            __builtin_amdgcn_sched_barrier(0); if (issA) AT_DMA_V(j + 3, (sc + 3) & 3); __builtin_amdgcn_sched_barrier(0);
            p0 = AT_MFMA(kf[4], qr[2], p0); p1 = AT_MFMA(kf[5], qr[2], p1);
            __builtin_amdgcn_sched_barrier(0); if (issA) AT_DMA_K2(j + 3, (sc + 3) & 3); __builtin_amdgcn_sched_barrier(0);
#pragma unroll
            for (int d0 = 3; d0 < NQ; ++d0) { p0 = AT_MFMA(kf[2 * d0], qr[d0], p0); p1 = AT_MFMA(kf[2 * d0 + 1], qr[d0], p1); }
            if (KIND == 1 && jd < 3) { LAS const float* tb = tab + (64 * jd + aq + 128 - 4 * hi - 27 - 32);
#pragma unroll
                for (int r = 0; r < 16; ++r) { const int c = 27 - ((r & 3) + 8 * (r >> 2)); p0[r] += tb[32 + c]; p1[r] += tb[c]; } }
            if (samp && j == T1 - 1) {
#pragma unroll
                for (int r = 0; r < 16; ++r) p1[r] = -INFINITY;
                asm volatile("" : "+v"(p1)); }
            asm volatile("s_nop 15\n\ts_nop 7" : "+v"(p0), "+v"(p1));
            const float rm = rowmax3(p0, p1);
            if (first || __any(rm > 8.0f)) {
                const float dl = first ? rm : fmaxf(rm, 0.f);
                m_ref += dl;
#pragma unroll
                for (int r = 0; r < 16; ++r) { p0[r] -= dl; p1[r] -= dl; }
#pragma unroll
                for (int r = 0; r < 16; ++r) { negn[r] = -m_ref; negf[r] = cbfar - m_ref; }
                asm volatile("" : "+v"(negn), "+v"(negf));
                if (!first) {
                    const float alpha = __builtin_amdgcn_exp2f(-dl); l_run *= alpha;
                    if (hi == 0) wsf[r32] = alpha;
#pragma unroll
                    for (int r = 0; r < 16; ++r) { const float a = wsf[crow(r, hi)]; o[0][r] *= a; o[1][r] *= a; }
                }
                first = false;
            }
        }
        AT_BAR();
        if (grp == 1) { if (j + 3 < T1) AT_WAIT_TILES(1); else AT_WAIT_TILES(0); if (issB && !vis) AT_DMA(j + 4, sc); }
        if (visn) kload<NQ>(kf, (LAS const char*)(lds + L_K + ((sc + 1) & 3) * KSLOT), r32, hi);
        __builtin_amdgcn_sched_barrier(0);
        if (vis) {
            float sacc = 0.f;
#pragma unroll
            for (int r = 0; r < 16; ++r) { p0[r] = __builtin_amdgcn_exp2f(p0[r]); p1[r] = __builtin_amdgcn_exp2f(p1[r]); sacc += p0[r] + p1[r]; }
            l_run += sacc;
            u32x4 w0, w1, w2, w3;
            w0 = (u32x4){pk_bf16(p0[0], p0[1]), pk_bf16(p0[2], p0[3]), pk_bf16(p0[4], p0[5]), pk_bf16(p0[6], p0[7])};
            w1 = (u32x4){pk_bf16(p0[8], p0[9]), pk_bf16(p0[10], p0[11]), pk_bf16(p0[12], p0[13]), pk_bf16(p0[14], p0[15])};
            w2 = (u32x4){pk_bf16(p1[0], p1[1]), pk_bf16(p1[2], p1[3]), pk_bf16(p1[4], p1[5]), pk_bf16(p1[6], p1[7])};
            w3 = (u32x4){pk_bf16(p1[8], p1[9]), pk_bf16(p1[10], p1[11]), pk_bf16(p1[12], p1[13]), pk_bf16(p1[14], p1[15])};
            __builtin_amdgcn_sched_barrier(0);
            {   const bf16x8 pa0 = __builtin_bit_cast(bf16x8, w0), pa1 = __builtin_bit_cast(bf16x8, w1), pa2 = __builtin_bit_cast(bf16x8, w2), pa3 = __builtin_bit_cast(bf16x8, w3);
#define AT_PK(d, k) (bf16x8){vf[d * 8 + 2 * k][0], vf[d * 8 + 2 * k][1], vf[d * 8 + 2 * k][2], vf[d * 8 + 2 * k][3], vf[d * 8 + 2 * k + 1][0], vf[d * 8 + 2 * k + 1][1], vf[d * 8 + 2 * k + 1][2], vf[d * 8 + 2 * k + 1][3]}
                o[0] = AT_MFMA(pa0, AT_PK(0, 0), o[0]); o[1] = AT_MFMA(pa0, AT_PK(1, 0), o[1]);
                __builtin_amdgcn_sched_barrier(0); if (issB) AT_DMA_K(j + 4, sc); __builtin_amdgcn_sched_barrier(0);
                o[0] = AT_MFMA(pa1, AT_PK(0, 1), o[0]); o[1] = AT_MFMA(pa1, AT_PK(1, 1), o[1]);
                __builtin_amdgcn_sched_barrier(0); if (issB) AT_DMA_V(j + 4, sc); __builtin_amdgcn_sched_barrier(0);
                o[0] = AT_MFMA(pa2, AT_PK(0, 2), o[0]); o[1] = AT_MFMA(pa2, AT_PK(1, 2), o[1]);
                __builtin_amdgcn_sched_barrier(0); if (issB) AT_DMA_K2(j + 4, sc); __builtin_amdgcn_sched_barrier(0);
                o[0] = AT_MFMA(pa3, AT_PK(0, 3), o[0]); o[1] = AT_MFMA(pa3, AT_PK(1, 3), o[1]);
#undef AT_PK
            }
        }
        AT_BAR();
    }
    const int colb = KIND * 512 + h * 64;
    u32x4 gpre[4];
    if (active) {
#pragma unroll
        for (int i = 0; i < 4; ++i) gpre[i] = __builtin_nontemporal_load((const u32x4*)(T.sg + (size_t)(qrow + i * 8 + (lane >> 3)) * 1024 + colb + (lane & 7) * 8)); }
    if (grp == 0) AT_BAR();
    if (active) {
        { auto rr = __builtin_amdgcn_permlane32_swap(__float_as_uint(l_run), __float_as_uint(l_run), false, false); l_run = __uint_as_float(rr[0]) + __uint_as_float(rr[1]); }
        if (hi == 0) wsf[32 + r32] = l_run;
        LAS bf16_t* stg = (LAS bf16_t*)(lds + L_OST) + wid * 2048;
#pragma unroll
        for (int r = 0; r < 16; ++r) { const int orow = crow(r, hi); const float rl = __builtin_amdgcn_rcpf(wsf[32 + orow]);
#pragma unroll
            for (int d0 = 0; d0 < 2; ++d0) stg[orow * 64 + d0 * 32 + r32] = (bf16_t)(pk_bf16(o[d0][r] * rl, 0.f) & 0xffffu); }
#pragma unroll
        for (int i = 0; i < 4; ++i) { const int row = i * 8 + (lane >> 3), ch = lane & 7;
            const u32x4 v = *(LAS const u32x4*)(stg + row * 64 + ch * 8);
            const size_t gi = (size_t)(qrow + row) * 1024 + colb + ch * 8;
            const u32x4 g = gpre[i]; u32x4 w;
            w.x = pk_bf16(bf_lo(v.x) * bf_lo(g.x), bf_hi(v.x) * bf_hi(g.x)); w.y = pk_bf16(bf_lo(v.y) * bf_lo(g.y), bf_hi(v.y) * bf_hi(g.y));
            w.z = pk_bf16(bf_lo(v.z) * bf_lo(g.z), bf_hi(v.z) * bf_hi(g.z)); w.w = pk_bf16(bf_lo(v.w) * bf_lo(g.w), bf_hi(v.w) * bf_hi(g.w));
            *(u32x4*)(T.y + gi) = w; }
    }
#undef AT_DMA
#undef AT_DMA_K
#undef AT_DMA_K2
#undef AT_DMA_V
#undef AT_WAIT_TILES
#undef AT_DMA1
}
constexpr int NU_MS = 64, NU_MP = 1024, NU_BP = 1024, NU_BS = 64, NU_G4S = 4, NU_TOT = NU_MS + NU_MP + NU_BP + NU_BS + NU_G4S;
constexpr int IDX_G4S = NU_MS + NU_BS + 13 * 64;
__device__ __forceinline__ void run_unit(const Tens& T, int idx, LAS unsigned char* lds) {
    int kind, seq, h, u;
    if (idx < NU_MS) { kind = 0; seq = 8 + (idx >> 3); h = idx & 7; u = 0; }
    else if (idx < NU_MS + NU_BS) { const int i = idx - NU_MS; kind = 1; seq = 8 + (i >> 3); h = i & 7; u = 0; }
    else if (idx < IDX_G4S) { const int i = idx - NU_MS - NU_BS; kind = 0; u = 15 - i / 64; seq = (i % 64) >> 3; h = i & 7; }
    else if (idx < IDX_G4S + NU_G4S + NU_BP) { const int i = idx - IDX_G4S - NU_G4S; kind = 1; u = 15 - i / 64; seq = (i % 64) >> 3; h = i & 7; }
    else { const int i = idx - IDX_G4S - NU_G4S - NU_BP; kind = 0; u = 2 - i / 64; seq = (i % 64) >> 3; h = i & 7; }
    if (kind == 0) unit<0>(T, seq, h, u, lds); else unit<1>(T, seq, h, u, lds);
}
}

__device__ __forceinline__ void tr_item(const float* W, int N, int srccol0, int K, bf16_t* WT, int destrow0, int k0, LAS float* scr, int lane) {
    float tv[32];
#pragma unroll
    for (int i = 0; i < 32; ++i) { const int kk = 2 * i + (lane >> 5); tv[i] = srccol0 >= 0 ? __builtin_nontemporal_load(W + (size_t)(k0 + kk) * N + srccol0 + (lane & 31)) : 0.f; }
#pragma unroll
    for (int i = 0; i < 32; ++i) { const int kk = 2 * i + (lane >> 5); scr[kk * 33 + (lane & 31)] = tv[i]; }
    const int c = lane & 7;
#pragma unroll
    for (int j = 0; j < 4; ++j) { const int n = (lane >> 3) + 8 * j; const LAS float* s = scr + (8 * c) * 33 + n;
        u32x4 o; o.x = pk_bf16(s[0 * 33], s[1 * 33]); o.y = pk_bf16(s[2 * 33], s[3 * 33]); o.z = pk_bf16(s[4 * 33], s[5 * 33]); o.w = pk_bf16(s[6 * 33], s[7 * 33]);
        *(u32x4*)(WT + (size_t)(destrow0 + n) * K + k0 + 8 * c) = o; }
}
__device__ __forceinline__ int win_src(int ng) {
    if (ng < 8) return OFF_CQ + 32 * ng;
    if (ng < 12) return OFF_CKV + 32 * (ng - 8);
    if (ng == 12) return OFF_KR;
    if (ng < 16) return -1;
    if (ng < 32) return OFF_GA + 32 * (ng - 16);
    if (ng < 48) return OFF_GB + 32 * (ng - 32);
    if (ng < 64) return OFF_QB + 32 * (ng - 48);
    if (ng < 80) return OFF_KB + 32 * (ng - 64);
    return OFF_VB + 32 * (ng - 80);
}
__device__ __forceinline__ void sincos_d(double a, float& s, float& c) {
    const double twopi = 6.283185307179586476925286766559;
    const double k = __builtin_rint(a / twopi); const double r = a - k * twopi; const double r2 = r * r;
    double ts = 1.0, tc = 1.0;
#pragma unroll 1
    for (int n = 29; n >= 3; n -= 2) { ts = 1.0 - ts * r2 / (double)(n * (n - 1)); tc = 1.0 - tc * r2 / (double)(n * (n + 1)); }
    s = (float)(r * ts); c = (float)(1.0 - tc * r2 * 0.5);
}


__device__ __forceinline__ void xn_rows4(int mb, const float* x_p, const float* x_s, const float* g_mix, bf16_t* XN, int lane) {
    f32x4 v[4][4]; float s[4];
#pragma unroll
    for (int q = 0; q < 4; ++q) { const int m = mb + q; const float* xr = (m < MP) ? x_p + (size_t)m * DM : x_s + (size_t)(m - MP) * DM;
#pragma unroll
        for (int j = 0; j < 4; ++j) v[q][j] = __builtin_nontemporal_load((const f32x4*)(xr + 4 * lane + 256 * j)); }
#pragma unroll
    for (int q = 0; q < 4; ++q) { s[q] = 0.f;
#pragma unroll
        for (int j = 0; j < 4; ++j) s[q] += (v[q][j][0] * v[q][j][0] + v[q][j][1] * v[q][j][1]) + (v[q][j][2] * v[q][j][2] + v[q][j][3] * v[q][j][3]);
        s[q] = 1.0f / sqrtf(wave_sum(s[q]) * (1.0f / DM) + EPS); }
#pragma unroll
    for (int j = 0; j < 4; ++j) { const f32x4 g = *(const f32x4*)(g_mix + 4 * lane + 256 * j);
#pragma unroll
        for (int q = 0; q < 4; ++q) { const f32x4 o = v[q][j] * s[q] * g; u32x2 w; w.x = pk_bf16(o[0], o[1]); w.y = pk_bf16(o[2], o[3]); *(u32x2*)(XN + (size_t)(mb + q) * DM + 4 * lane + 256 * j) = w; } }
}
__device__ __forceinline__ void rope_entry(float* rope, int pos, int f) {
    const double inv = exp2(-(double)f * (13.287712379549449 / 16.0));
    float s, c; sincos_d((double)pos * inv, s, c); rope[pos * 32 + f] = c; rope[pos * 32 + 16 + f] = s;
}

__device__ __forceinline__ void grid_bar(unsigned* cnt, unsigned target) {
    asm volatile("s_waitcnt vmcnt(0)" ::: "memory");
    __syncthreads();
    if (threadIdx.x == 0) {
        __builtin_amdgcn_fence(__ATOMIC_RELEASE, "agent");
        asm volatile("s_waitcnt vmcnt(0)" ::: "memory");
        __hip_atomic_fetch_add(cnt, 1u, __ATOMIC_RELAXED, __HIP_MEMORY_SCOPE_AGENT);
        unsigned spins = 0;
        while (__hip_atomic_load(cnt, __ATOMIC_RELAXED, __HIP_MEMORY_SCOPE_AGENT) < target) { __builtin_amdgcn_s_sleep(2); if (++spins > (1u << 22)) break; }
        __builtin_amdgcn_fence(__ATOMIC_ACQUIRE, "agent");
        asm volatile("s_waitcnt vmcnt(0)" ::: "memory");
    }
    __syncthreads();
}
#define XB_TMO      128
#define XB_XCNT(j)  (256  + 64 * (j))
#define XB_XSUB(j)  (1280 + 64 * (j))
#define XB_XGEN(j)  (2304 + 64 * (j))
#define XB_TOP      3328
#define XB_TOPGEN   3392
#define XCD_BAR_WORDS 3456
#define XB_SPIN_CAP (1u << 18)

__device__ __forceinline__ unsigned xb_ld(unsigned* p)              { return __hip_atomic_load(p, __ATOMIC_RELAXED, __HIP_MEMORY_SCOPE_AGENT); }
__device__ __forceinline__ unsigned xb_add(unsigned* p, unsigned v) { return __hip_atomic_fetch_add(p, v, __ATOMIC_RELAXED, __HIP_MEMORY_SCOPE_AGENT); }
__device__ __forceinline__ unsigned xb_xcc_id() { return (unsigned)__builtin_amdgcn_s_getreg((3 << 11) | 20) & 0xFu; }
#define XB_SPIN(cond, bar) do { unsigned _sp = 0; while (cond) { __builtin_amdgcn_s_sleep(1); \
    if ((++_sp & 255u) == 0u) { if (xb_ld(&(bar)[XB_TMO])) break; if (_sp > XB_SPIN_CAP) { atomicAdd(&(bar)[XB_TMO], 1u); break; } } } } while (0)

struct XcdBarrier {
    unsigned* bar; unsigned x;
    volatile LAS unsigned* st;
};

__device__ __forceinline__ XcdBarrier xcd_barrier_post(unsigned* bar, volatile LAS unsigned* st) {
    XcdBarrier b; b.bar = bar; b.x = xb_xcc_id(); b.st = st;
    if (threadIdx.x == 0) (void)xb_add(&bar[XB_XCNT(b.x)], 1u);
    return b;
}
__device__ __forceinline__ void xcd_barrier_complete(unsigned* bar, unsigned x, unsigned& nloc, unsigned& nx) {
    const unsigned G = gridDim.x * gridDim.y * gridDim.z;
    unsigned sum, cnt, mine, sp = 0u;
    for (;;) {
        sum = 0u; cnt = 0u; mine = 0u;
#pragma unroll
        for (unsigned j = 0; j < 16; ++j) { const unsigned c = xb_ld(&bar[XB_XCNT(j)]); sum += c; cnt += (c > 0u) ? 1u : 0u; mine = (j == x) ? c : mine; }
        if (sum == G) break;
        __builtin_amdgcn_s_sleep(1);
        if ((++sp & 255u) == 0u) { if (xb_ld(&bar[XB_TMO])) break; if (sp > XB_SPIN_CAP) { atomicAdd(&bar[XB_TMO], 1u); break; } }
    }
    nloc = mine > 0u ? mine : 1u; nx = cnt > 0u ? cnt : 1u;
}

__device__ __forceinline__ void xcd_barrier(const XcdBarrier& b) {
    asm volatile("s_waitcnt vmcnt(0)" ::: "memory");
    __syncthreads();
    if (threadIdx.x == 0) {
        unsigned* bar = b.bar;
        __builtin_amdgcn_s_waitcnt(0);
        unsigned nloc = b.st[0], nx = b.st[1];
        if (nloc == 0u) { xcd_barrier_complete(bar, b.x, nloc, nx); b.st[0] = nloc; b.st[1] = nx; }
        const unsigned old = xb_add(&bar[XB_XSUB(b.x)], 1u);
        const unsigned gen = old / nloc;
        if (old + 1u == (gen + 1u) * nloc) {
            __builtin_amdgcn_fence(__ATOMIC_RELEASE, "agent");
            asm volatile("s_waitcnt vmcnt(0)" ::: "memory");
            const unsigned og = xb_add(&bar[XB_TOP], 1u);
            const unsigned tg = og / nx;
            if (og + 1u == (tg + 1u) * nx) xb_add(&bar[XB_TOPGEN], 1u);
            else XB_SPIN(xb_ld(&bar[XB_TOPGEN]) == tg, bar);
            __builtin_amdgcn_fence(__ATOMIC_ACQUIRE, "agent");
            xb_add(&bar[XB_XGEN(b.x)], 1u);
            asm volatile("s_waitcnt vmcnt(0)" ::: "memory");
        } else {
            XB_SPIN(xb_ld(&bar[XB_XGEN(b.x)]) == gen, bar);
            __builtin_amdgcn_fence(__ATOMIC_ACQUIRE, "agent");
            asm volatile("s_waitcnt vmcnt(0)" ::: "memory");
        }
    }
    __syncthreads();
}

struct Params { const float* in[16]; float* out; unsigned char* ws; int lo, hi, coop, pad; };

__global__ void __launch_bounds__(512, 2) mk_fwd(Params P) {
    extern __shared__ __attribute__((aligned(16))) unsigned char lds_raw[];
    LAS unsigned char* lds = (LAS unsigned char*)lds_raw;
    const int G = gridDim.x, NGW = G * 8;
#define PHASE_IDS() int tid_l = threadIdx.x; asm volatile("" : "+v"(tid_l)); const int tid = tid_l, lane = tid & 63; const int wave = __builtin_amdgcn_readfirstlane(tid >> 6); const int gw = blockIdx.x * 8 + wave; (void)lane; (void)gw
    unsigned char* ws = P.ws; float* out = P.out;
    const float *x_p = P.in[0], *x_s = P.in[1], *c_ckv = P.in[2], *c_kpe = P.in[3], *c_kb = P.in[4], *c_vb = P.in[5], *w_in = P.in[6], *g_mix = P.in[7], *g_cq = P.in[8],
                *w_uq = P.in[9], *g_ckv = P.in[10], *w_uk = P.in[11], *w_uv = P.in[12], *relb = P.in[13], *w_out = P.in[14], *g_fin = P.in[15];
    unsigned* ctl = (unsigned*)(ws + WS_CTL); float* rope = (float*)(ws + WS_ROPE);
    bf16_t *Win = (bf16_t*)(ws + WS_WIN), *Wuq = (bf16_t*)(ws + WS_WUQ), *Wukv = (bf16_t*)(ws + WS_WUKV), *Wout = (bf16_t*)(ws + WS_WOUT), *XN = (bf16_t*)(ws + WS_XN),
           *ZCQ = (bf16_t*)(ws + WS_ZCQ), *CQ = (bf16_t*)(ws + WS_CQ), *CKV = (bf16_t*)(ws + WS_CKV), *KPE = (bf16_t*)(ws + WS_KPE), *SG = (bf16_t*)(ws + WS_SG),
           *QB = (bf16_t*)(ws + WS_QB), *KVB = (bf16_t*)(ws + WS_KVB), *QM = (bf16_t*)(ws + WS_QM), *KVM = (bf16_t*)(ws + WS_KVM), *Y = (bf16_t*)(ws + WS_Y);
    float* ZCKV = (float*)(ws + WS_ZCKV);
    const int lo = P.lo, hi = P.hi;
#ifndef MK_PHMASK
#define MK_PHMASK 0xff
#endif
#define PH(k) (((MK_PHMASK >> (k)) & 1) && lo <= (k) && (k) < hi)
#ifndef MK_REP
#define MK_REP -1
#endif
#define REP(k) for (int rep_ = 0; rep_ < ((MK_REP) == (k) ? 2 : 1); ++rep_)
    { volatile LAS unsigned* misc = (volatile LAS unsigned*)(lds + LDS_RING + 32); if (threadIdx.x < 2) misc[threadIdx.x] = 0u; __syncthreads(); }
    const XcdBarrier xbar = xcd_barrier_post(ctl + 1024, (volatile LAS unsigned*)(lds + LDS_RING + 32));
#define SEAM(k) do { if (PH(k) && PH((k) + 1)) { if (P.coop == 2) cg::this_grid().sync(); else xcd_barrier(xbar); } } while (0)

    if (PH(0)) REP(0) {
        PHASE_IDS();
        LAS float* scr = (LAS float*)(lds + wave * 8448);
        for (int it = gw; it < 96 * 16; it += NGW) { const int ng = it / 16, kb = it % 16; tr_item(w_in, IN_W, win_src(ng), 1024, Win, 32 * ng, 64 * kb, scr, lane); }
        for (int mb = gw * 4; mb < M1; mb += NGW * 4) xn_rows4(mb, x_p, x_s, g_mix, XN, lane);
        const int gt = blockIdx.x * 512 + tid, NGT = G * 512;
        for (int i = gt; i < (PAST + TS) * 16; i += NGT) rope_entry(rope, i >> 4, i & 15);
    }
    SEAM(0);
#ifdef MK_XSYNC
    for (int i_ = 0; i_ < MK_XSYNC; ++i_) xcd_barrier(xbar);
#endif
    if (PH(1)) REP(1) {
        pg8::Gemm g{XN, Win, M1, NIN, 1024}; pg8::StaticOrder S; S.init(M1, NIN, G, (int)blockIdx.x);
        EpiG1 E{ZCQ, KPE, SG, QB, KVB, ZCKV, out, rope};
        pg8::gemm_phase<EpiG1, pg8::StaticOrder, true, true>(lds, g, S, E);
        {   PHASE_IDS();
            const int nlast = (M1 / 256 * (NIN / 256)) % G;
            const int nsb = (nlast > 0 && nlast * 2 < G) ? nlast : 0;
            if ((int)blockIdx.x >= nsb) {
                LAS float* scr = (LAS float*)(lds + wave * 8448);
                const int gwp = ((int)blockIdx.x - nsb) * 8 + wave, NGWP = (G - nsb) * 8;
                constexpr int I_UQ = 24 * 4, I_UKV = 32 * 2, I_OUT = 32 * 16, I_TOT = I_UQ + I_UKV + I_OUT;
                for (int it = gwp; it < I_TOT; it += NGWP) {
                    int r = it;
                    if (r < I_UQ) { const int ng = r / 4, kb = r % 4; const int src = ng < 16 ? (ng >> 1) * 96 + 32 * (ng & 1) : (ng - 16) * 96 + 64; tr_item(w_uq, 768, src, 256, Wuq, 32 * ng, 64 * kb, scr, lane); continue; } r -= I_UQ;
                    if (r < I_UKV) { const int ng = r / 2, kb = r % 2; tr_item(ng < 16 ? w_uk : w_uv, 512, 32 * (ng & 15), 128, Wukv, 32 * ng, 64 * kb, scr, lane); continue; } r -= I_UKV;
                    { const int ng = r / 16, kb = r % 16; tr_item(w_out, 1024, 32 * ng, 1024, Wout, 32 * ng, 64 * kb, scr, lane); }
                }
                const int gt = ((int)blockIdx.x - nsb) * 512 + tid, NGT = (G - nsb) * 512;
#pragma unroll 4
        for (int i = gt; i < NB * PAST * 32; i += NGT) { const int r = i >> 5, c = (i & 31) * 4; const int bb = r >> 12, p = r & 4095;
            const f32x4 v = __builtin_nontemporal_load((const f32x4*)(c_ckv + (size_t)r * 128 + c)); u32x2 w; w.x = pk_bf16(v[0], v[1]); w.y = pk_bf16(v[2], v[3]);
            *(u32x2*)(CKV + (size_t)(MP + bb * KVS + p) * 128 + c) = w; }
        for (int i = gt; i < NB * PAST * 8; i += NGT) { const int r = i >> 3, c = (i & 7) * 4; const int bb = r >> 12, p = r & 4095;
            const f32x4 v = __builtin_nontemporal_load((const f32x4*)(c_kpe + (size_t)r * 32 + c)); u32x2 w; w.x = pk_bf16(v[0], v[1]); w.y = pk_bf16(v[2], v[3]);
            *(u32x2*)(KPE + (size_t)(MP + bb * KVS + p) * 32 + c) = w; }
#pragma unroll 2
        for (int i = gt; i < NB * 512 * 128; i += NGT) { const int r = i >> 7, c = (i & 127) * 4; const int bb = r >> 9, p = r & 511;
            const f32x4 kv = __builtin_nontemporal_load((const f32x4*)(c_kb + (size_t)r * 512 + c)), vv = __builtin_nontemporal_load((const f32x4*)(c_vb + (size_t)r * 512 + c));
            u32x2 w; w.x = pk_bf16(kv[0], kv[1]); w.y = pk_bf16(kv[2], kv[3]); bf16_t* d = KVB + (size_t)(MP + bb * BVS + p) * 1024 + c; *(u32x2*)d = w;
            w.x = pk_bf16(vv[0], vv[1]); w.y = pk_bf16(vv[2], vv[3]); *(u32x2*)(d + 512) = w; }
        for (int i = gt; i < NB * 32 * 32; i += NGT) { const int r = i >> 5, c = (i & 31) * 4; *(u32x2*)(CKV + (size_t)(MP + (r >> 5) * KVS + PAST + 32 + (r & 31)) * 128 + c) = (u32x2){0u, 0u}; }
        for (int i = gt; i < NB * 32 * 8; i += NGT) { const int r = i >> 3, c = (i & 7) * 4; *(u32x2*)(KPE + (size_t)(MP + (r >> 5) * KVS + PAST + 32 + (r & 31)) * 32 + c) = (u32x2){0u, 0u}; }
        for (int i = gt; i < NB * 32 * 256; i += NGT) { const int r = i >> 8, c = (i & 255) * 4; *(u32x2*)(KVB + (size_t)(MP + (r >> 5) * BVS + 512 + 32 + (r & 31)) * 1024 + c) = (u32x2){0u, 0u}; }
            }
        }
    }
    SEAM(1);
    if (PH(2)) REP(2) {
        PHASE_IDS();
        for (int mb = gw * 4; mb < M1; mb += NGW * 4) {
            u32x2 wq[4]; f32x2 vk[4];
#pragma unroll
            for (int q = 0; q < 4; ++q) { wq[q] = __builtin_nontemporal_load((const u32x2*)(ZCQ + (size_t)(mb + q) * 256 + 4 * lane)); vk[q] = __builtin_nontemporal_load((const f32x2*)(ZCKV + (size_t)(mb + q) * 128 + 2 * lane)); }
            const f32x4 gq = *(const f32x4*)(g_cq + 4 * lane); const f32x2 gk = *(const f32x2*)(g_ckv + 2 * lane);
#pragma unroll
            for (int q = 0; q < 4; ++q) { const int m = mb + q;
                f32x4 v = {bf_lo(wq[q].x), bf_hi(wq[q].x), bf_lo(wq[q].y), bf_hi(wq[q].y)};
                const float rq = 1.0f / sqrtf(wave_sum((v[0] * v[0] + v[1] * v[1]) + (v[2] * v[2] + v[3] * v[3])) * (1.0f / 256.0f) + EPS);
                v = v * rq * gq; u32x2 o; o.x = pk_bf16(v[0], v[1]); o.y = pk_bf16(v[2], v[3]); *(u32x2*)(CQ + (size_t)m * 256 + 4 * lane) = o;
                f32x2 k = vk[q];
                const float rk = 1.0f / sqrtf(wave_sum(k[0] * k[0] + k[1] * k[1]) * (1.0f / 128.0f) + EPS);
                k = k * rk * gk;
                float* po = (m < MP) ? out + O_CKVP + (size_t)m * 128 : out + O_CKVS + (size_t)(m - MP) * 128; *(f32x2*)(po + 2 * lane) = k;
                *(unsigned*)(CKV + (size_t)kvrow_m(m) * 128 + 2 * lane) = pk_bf16(k[0], k[1]); }
        }
    }
    SEAM(2);
    if (PH(3)) REP(3) {
        { pg8::Gemm g{CQ, Wuq, M1, 768, 256}; pg8::StaticOrder S; S.init(M1, 768, G, (int)blockIdx.x); EpiG2 E{QM, rope};
          pg8::gemm_phase<EpiG2, pg8::StaticOrder, true, true>(lds, g, S, E); }
    }
    if (PH(4)) REP(4) {
        { pg8::Gemm g{CKV, Wukv, KVR, 1024, 128}; SkewOrder S; S.init(KVR, 1024, G, (int)blockIdx.x, (KVR / 256 * 4) / G, (M1 / 256 * 3) % G);
          EpiPlain E{KVM, 1024};
          pg8::gemm_phase<EpiPlain, SkewOrder, true, true>(lds, g, S, E); }
    }
    SEAM(4);
    if (PH(5)) REP(5) {
        PHASE_IDS();
        const at::Tens T{QM, QB, KVM, KVB, KPE, SG, Y, relb};
        LAS volatile unsigned* sidx = (LAS volatile unsigned*)(lds + at::L_IDX);
        unsigned nxt = 0; if (tid == 0) nxt = atomicAdd(ctl + rep_, 1u);
        for (;;) {
            if (tid == 0) sidx[0] = nxt;
            __syncthreads();
            const int idx = (int)sidx[0];
            if (idx >= at::NU_TOT) break;
            if (tid == 0) nxt = atomicAdd(ctl + rep_, 1u);
            if (idx >= at::IDX_G4S && idx < at::IDX_G4S + at::NU_G4S) {
                if (tid == 0) { unsigned sp = 0; while (__hip_atomic_load(ctl + 2, __ATOMIC_RELAXED, __HIP_MEMORY_SCOPE_AGENT) < 128u) { __builtin_amdgcn_s_sleep(4); if (++sp > (1u << 22)) break; }
                    __builtin_amdgcn_fence(__ATOMIC_ACQUIRE, "agent"); asm volatile("s_waitcnt vmcnt(0)" ::: "memory"); }
                __syncthreads();
                pg8::Gemm g{Y, Wout, M1, 1024, 1024}; OneUnit S1{MP / 256, idx - at::IDX_G4S}; EpiG4 E{x_p, x_s, out, (bf16_t*)(ws + WS_X1), (float*)(ws + WS_SSQ)};
                pg8::gemm_phase<EpiG4, OneUnit, false, true>(lds, g, S1, E);
                continue;
            }
            at::run_unit(T, idx, lds);
            if (idx < at::NU_MS + at::NU_BS) {
                asm volatile("s_waitcnt vmcnt(0)" ::: "memory"); __syncthreads();
                if (tid == 0) { __builtin_amdgcn_fence(__ATOMIC_RELEASE, "agent"); asm volatile("s_waitcnt vmcnt(0)" ::: "memory"); __hip_atomic_fetch_add(ctl + 2, 1u, __ATOMIC_RELAXED, __HIP_MEMORY_SCOPE_AGENT); }
            }
        }
    }
    SEAM(5);
    if (PH(6)) REP(6) {
        pg8::Gemm g{Y, Wout, MP, 1024, 1024}; pg8::StaticOrder S; S.init(MP, 1024, G, (int)blockIdx.x); EpiG4 E{x_p, x_s, out, (bf16_t*)(ws + WS_X1), (float*)(ws + WS_SSQ)};
        pg8::gemm_phase<EpiG4, pg8::StaticOrder, true, true>(lds, g, S, E);
    }
    SEAM(6);
    if (PH(7)) {
        PHASE_IDS();
        const bf16_t* X1 = (const bf16_t*)(ws + WS_X1); const float* SSQ = (const float*)(ws + WS_SSQ);
        for (int mb = gw * 4; mb < MP; mb += NGW * 4) {
            float sp[4]; u32x4 w[4][2];
#pragma unroll
            for (int q = 0; q < 4; ++q) { sp[q] = lane < 16 ? SSQ[(size_t)(mb + q) * 16 + lane] : 0.f;
#pragma unroll
                for (int j = 0; j < 2; ++j) w[q][j] = __builtin_nontemporal_load((const u32x4*)(X1 + (size_t)(mb + q) * DM + 8 * lane + 512 * j)); }
#pragma unroll
            for (int q = 0; q < 4; ++q) sp[q] = 1.0f / sqrtf(wave_sum(sp[q]) * (1.0f / DM) + EPS);
#pragma unroll
            for (int j = 0; j < 2; ++j) { const int c = 8 * lane + 512 * j; const f32x4 g0 = *(const f32x4*)(g_fin + c), g1 = *(const f32x4*)(g_fin + c + 4);
#pragma unroll
                for (int q = 0; q < 4; ++q) { const u32x4 ww = w[q][j];
                    const f32x4 a = {bf_lo(ww.x), bf_hi(ww.x), bf_lo(ww.y), bf_hi(ww.y)}, b = {bf_lo(ww.z), bf_hi(ww.z), bf_lo(ww.w), bf_hi(ww.w)};
                    *(f32x4*)(out + (size_t)(mb + q) * DM + c) = a * sp[q] * g0; *(f32x4*)(out + (size_t)(mb + q) * DM + c + 4) = b * sp[q] * g1; } }
        }
        for (int m = MP + gw; m < M1; m += NGW) {
            float* xr = out + (size_t)m * DM; f32x4 v[4]; float s = 0.f;
#pragma unroll
            for (int j = 0; j < 4; ++j) { v[j] = *(const f32x4*)(xr + 4 * lane + 256 * j); s += (v[j][0] * v[j][0] + v[j][1] * v[j][1]) + (v[j][2] * v[j][2] + v[j][3] * v[j][3]); }
            const float rstd = 1.0f / sqrtf(wave_sum(s) * (1.0f / DM) + EPS);
#pragma unroll
            for (int j = 0; j < 4; ++j) { const f32x4 g = *(const f32x4*)(g_fin + 4 * lane + 256 * j); *(f32x4*)(xr + 4 * lane + 256 * j) = v[j] * rstd * g; }
        }
    }
#undef PH
#undef SEAM
}

constexpr int NPH = 8;
extern "C" void kernel_launch(void* const* d_in, const int* in_sizes, int n_in, void* d_out, int out_size, void* d_ws, size_t ws_size, hipStream_t stream) {
    static int grid = 0;
    if (grid == 0) {
        if (n_in != 16 || (size_t)out_size != O_END || ws_size < WS_END) { fprintf(stderr, "kernel_launch: unexpected shapes (n_in %d out %d ws %zu need %zu)\n", n_in, out_size, ws_size, (size_t)WS_END); grid = -1; return; }
        int dev = 0, cus = 0, per_cu = 0;
        hipGetDevice(&dev); hipDeviceGetAttribute(&cus, hipDeviceAttributeMultiprocessorCount, dev);
        hipFuncSetAttribute((const void*)mk_fwd, hipFuncAttributeMaxDynamicSharedMemorySize, LDS_TOTAL);
        hipOccupancyMaxActiveBlocksPerMultiprocessor(&per_cu, (const void*)mk_fwd, 512, LDS_TOTAL);
        (void)hipGetLastError();
        if (per_cu < 1) per_cu = 1;
        grid = cus * per_cu;
        if (grid > 256) grid = 256;
    }
    if (grid < 0) return;
    if (hipMemsetAsync(d_ws, 0, 32768, stream) != hipSuccess) { fprintf(stderr, "memset failed\n"); return; }
    Params p{};
    for (int i = 0; i < 16; ++i) p.in[i] = (const float*)d_in[i];
    p.out = (float*)d_out; p.ws = (unsigned char*)d_ws;
#if MK_COOP
    p.lo = 0; p.hi = NPH; p.coop = 1;
    void* args[] = {&p};
    hipError_t e = hipLaunchCooperativeKernel((const void*)mk_fwd, dim3(grid), dim3(512), args, LDS_TOTAL, stream);
    if (e != hipSuccess) fprintf(stderr, "cooperative launch failed: %s (grid %d)\n", hipGetErrorString(e), grid);
#else
    for (int ph = 0; ph < NPH; ++ph) { p.lo = ph; p.hi = ph + 1; p.coop = 0; hipLaunchKernelGGL(mk_fwd, dim3(grid), dim3(512), LDS_TOTAL, stream, p); }
#endif
}
```

```cpp
#include <hip/hip_runtime.h>
#include <hip/hip_bf16.h>
#include <hip/hip_cooperative_groups.h>
#include <cstdio>
#include <cstdint>
#include <type_traits>
namespace cg = cooperative_groups;
#ifndef MK_COOP
#define MK_COOP 1
#endif

namespace pg8 {
#define PG8_LAS __attribute__((address_space(3)))
typedef unsigned short bf16_t;
typedef short bf16x8 __attribute__((ext_vector_type(8)));
typedef float f32x4 __attribute__((ext_vector_type(4)));
typedef unsigned u32x4 __attribute__((ext_vector_type(4)));
constexpr int BM = 256, BK = 64, HALF = 128, HTB = HALF * BK * 2  , STAGE_BYTES = 8 * HTB, NXCD = 8, WGM = 8;

__host__ __device__ __forceinline__ int lds_byte(int r, int c) { const int st = (r >> 4) * 2 + (c >> 5), rr = r & 15, cc = c & 31, ob = rr * 64 + cc * 2; return st * 1024 + (ob ^ (((ob >> 9) & 1) << 5)); }
__host__ __device__ __forceinline__ void stage_rc(int b, int& R, int& C) { const int st = b / 1024, sb = b % 1024, swz = sb ^ (((sb >> 9) & 1) << 5); R = (st >> 1) * 16 + swz / 64; C = (st & 1) * 32 + (swz % 64) / 2; }
__host__ __device__ __forceinline__ int perm32(int rho) { const int n = rho >> 4, i = rho & 15; return 8 * (i >> 2) + 4 * n + (i & 3); }

struct Unit { int pm, pn; };
struct Gemm { const bf16_t* A; const bf16_t* Bt; int M, N, K; };

struct StaticOrder {
    int nM, nN, nwg, G, c;
    __host__ __device__ void init(int M, int N, int G_, int c_) { nM = M / BM; nN = N / BM; nwg = nM * nN; G = G_; c = c_; }
    __host__ __device__ bool next(int i, Unit& u) const {
        const long L = (long)i * G + c; if (L >= nwg) return false;
        int wgid = (int)L; { const int q = nwg / NXCD, r = nwg % NXCD, xcd = wgid % NXCD, off = wgid / NXCD; wgid = (xcd < r ? xcd * (q + 1) : r * (q + 1) + (xcd - r) * q) + off; }
        const int nig = WGM * nN, gid = wgid / nig, fm = gid * WGM, gsz = (nM - fm) < WGM ? (nM - fm) : WGM;
        u.pm = fm + ((wgid % nig) % gsz); u.pn = (wgid % nig) / gsz; return true;
    }
    __device__ __forceinline__ void a_ready(const Unit&) const {}
    __device__ __forceinline__ void done(const Unit&) const {}
};

__device__ __forceinline__ unsigned cvt_pk_bf16(float lo, float hi) { unsigned r; asm volatile("v_cvt_pk_bf16_f32 %0, %1, %2" : "=v"(r) : "v"(lo), "v"(hi)); return r; }
typedef float f32x2 __attribute__((ext_vector_type(2)));
template <class Epi, class Sched, bool ALIGN_EPI = false, bool SP2 = false>
__device__ __forceinline__ void gemm_phase(PG8_LAS unsigned char* lds, const Gemm g, const Sched& S, const Epi& E) {
    int tid_l = threadIdx.x; asm volatile("" : "+v"(tid_l));
    const int tid = tid_l, wid = __builtin_amdgcn_readfirstlane(tid >> 6), lane = tid & 63, wr = wid >> 2, wc = wid & 3, fr = lane & 15, fq = lane >> 4;
    int K_l = g.K; asm volatile("" : "+s"(K_l));
    const int K = K_l, nt = K / BK;
    unsigned voffA[2], voffB[2];
#pragma unroll
    for (int i = 0; i < 2; ++i) { int R, C; stage_rc(tid * 16 + i * 8192, R, C); const int Rb = Epi::PERM ? ((R & ~31) + perm32(R & 31)) : R;
        voffA[i] = (unsigned)(R * K + C) * 2u; voffB[i] = (unsigned)(Rb * K + C) * 2u; }
    const size_t kstep = (size_t)(BK * 2);
    const size_t hstep = (size_t)HALF * K * 2;
    const size_t tstep = 2 * hstep;
    const unsigned ldsw = (unsigned)wid * 1024u;
    const int aoff = lds_byte(wr * 64 + fr, fq * 8), boff = lds_byte(wc * 32 + fr, fq * 8);
#define PG8_SA(b, h) (((b) * 2 + (h)) * HTB)
#define PG8_SB(b, h) ((4 + (b) * 2 + (h)) * HTB)
#define PG8_STAGE(bufoff, gbase, voff) do { _Pragma("unroll") for (int _i = 0; _i < 2; ++_i) \
        __builtin_amdgcn_global_load_lds((const unsigned*)((const char*)(gbase) + (voff)[_i]), (PG8_LAS unsigned*)(lds + (bufoff) + ldsw + _i * 8192), 16, 0, 0); } while (0)
#define PG8_LDA(dst, b, h) do { _Pragma("unroll") for (int m = 0; m < 4; ++m) _Pragma("unroll") for (int k = 0; k < 2; ++k) dst[m][k] = *(const PG8_LAS bf16x8*)(lds + PG8_SA(b, h) + aoff + m * 2048 + k * 1024); } while (0)
#define PG8_LDB(dst, b, h) do { _Pragma("unroll") for (int n = 0; n < 2; ++n) _Pragma("unroll") for (int k = 0; k < 2; ++k) dst[n][k] = *(const PG8_LAS bf16x8*)(lds + PG8_SB(b, h) + boff + n * 2048 + k * 1024); } while (0)
#define PG8_MMA(ai, bj, At, Bt) do { __builtin_amdgcn_s_setprio(1); _Pragma("unroll") for (int m = 0; m < 4; ++m) _Pragma("unroll") for (int n = 0; n < 2; ++n) _Pragma("unroll") for (int k = 0; k < 2; ++k) \
        acc[ai][bj][m][n] = __builtin_amdgcn_mfma_f32_16x16x32_bf16(Bt[n][k], At[m][k], acc[ai][bj][m][n], 0, 0, 0); __builtin_amdgcn_s_setprio(0); } while (0)
#define PG8_WAIT_V(n) asm volatile("s_waitcnt vmcnt(" #n ")" ::: "memory")
#define PG8_WAIT_L(n) asm volatile("s_waitcnt lgkmcnt(" #n ")" ::: "memory")
#define PG8_BAR __builtin_amdgcn_s_barrier()
#define PG8_SCHED __builtin_amdgcn_sched_barrier(0)
    Unit cur, nxt; int ui = 0;
    if (!S.next(0, cur)) return;
    f32x4 acc[2][2][4][2];
#pragma unroll
    for (int a = 0; a < 2; ++a)
#pragma unroll
        for (int b = 0; b < 2; ++b)
#pragma unroll
            for (int m = 0; m < 4; ++m)
#pragma unroll
                for (int n = 0; n < 2; ++n) acc[a][b][m][n] = (f32x4){0.f, 0.f, 0.f, 0.f};
    bf16x8 At[4][2], B0[2][2], B1[2][2];
    const char* cA = (const char*)g.A + (size_t)cur.pm * tstep; const char* cB = (const char*)g.Bt + (size_t)cur.pn * tstep;
    S.a_ready(cur);
    if constexpr (SP2) {
        PG8_STAGE(PG8_SB(0, 0), cB, voffB); PG8_STAGE(PG8_SB(0, 1), cB + hstep, voffB); PG8_STAGE(PG8_SA(0, 0), cA, voffA); PG8_STAGE(PG8_SA(0, 1), cA + hstep, voffA);
        if (wr == 1) PG8_BAR;
        PG8_WAIT_V(2); PG8_BAR;
        PG8_STAGE(PG8_SB(1, 0), cB + kstep, voffB); PG8_STAGE(PG8_SA(1, 0), cA + kstep, voffA); PG8_STAGE(PG8_SB(1, 1), cB + hstep + kstep, voffB);
        PG8_WAIT_V(6); PG8_BAR;
    } else {
        PG8_STAGE(PG8_SB(0, 0), cB, voffB); PG8_STAGE(PG8_SA(0, 0), cA, voffA); PG8_STAGE(PG8_SB(0, 1), cB + hstep, voffB); PG8_STAGE(PG8_SA(0, 1), cA + hstep, voffA);
        if (wr == 1) PG8_BAR;
        PG8_WAIT_V(4); PG8_BAR;
        PG8_STAGE(PG8_SB(1, 0), cB + kstep, voffB); PG8_STAGE(PG8_SA(1, 0), cA + kstep, voffA); PG8_STAGE(PG8_SB(1, 1), cB + hstep + kstep, voffB);
        PG8_WAIT_V(6); PG8_BAR;
    }
    for (;;) {
        const bool has_next = S.next(ui + 1, nxt);
        const char* nA = has_next ? (const char*)g.A + (size_t)nxt.pm * tstep : cA; const char* nB = has_next ? (const char*)g.Bt + (size_t)nxt.pn * tstep : cB;
        for (int t = 0; t < nt; t += 2) {
            const bool last = (t == nt - 2);
            const char* a1 = cA + (size_t)(t + 1) * kstep;
            const char* a2 = last ? nA : cA + (size_t)(t + 2) * kstep; const char* b2 = last ? nB : cB + (size_t)(t + 2) * kstep;
            const char* a3 = a2 + kstep; const char* b3 = b2 + kstep;
            if (last && has_next) S.a_ready(nxt);
            if constexpr (SP2) {
            PG8_LDB(B0, 0, 0); PG8_LDB(B1, 0, 1); PG8_SCHED; PG8_LDA(At, 0, 0); PG8_STAGE(PG8_SA(1, 1), a1 + hstep, voffA);
            PG8_WAIT_V(8); PG8_WAIT_L(0); PG8_BAR; PG8_MMA(0, 0, At, B0); PG8_MMA(0, 1, At, B1); PG8_BAR; PG8_SCHED;
            PG8_LDA(At, 0, 1); PG8_STAGE(PG8_SB(0, 0), b2, voffB); PG8_STAGE(PG8_SB(0, 1), b2 + hstep, voffB); PG8_STAGE(PG8_SA(0, 0), a2, voffA);
            PG8_WAIT_V(8); PG8_WAIT_L(0); PG8_BAR; PG8_MMA(1, 0, At, B0); PG8_MMA(1, 1, At, B1); PG8_BAR; PG8_SCHED;
            PG8_LDB(B0, 1, 0); PG8_LDB(B1, 1, 1); PG8_SCHED; PG8_LDA(At, 1, 0); PG8_STAGE(PG8_SA(0, 1), a2 + hstep, voffA);
            PG8_WAIT_V(8); PG8_WAIT_L(0); PG8_BAR; PG8_MMA(0, 0, At, B0); PG8_MMA(0, 1, At, B1); PG8_BAR; PG8_SCHED;
            PG8_LDA(At, 1, 1); PG8_STAGE(PG8_SB(1, 0), b3, voffB); PG8_STAGE(PG8_SB(1, 1), b3 + hstep, voffB); PG8_STAGE(PG8_SA(1, 0), a3, voffA);
            PG8_WAIT_V(8); PG8_WAIT_L(0); PG8_BAR; PG8_MMA(1, 0, At, B0); PG8_MMA(1, 1, At, B1); PG8_BAR; PG8_SCHED;
            } else {
            PG8_LDB(B0, 0, 0); PG8_SCHED; PG8_LDA(At, 0, 0); PG8_STAGE(PG8_SA(1, 1), a1 + hstep, voffA);
            PG8_WAIT_L(8); PG8_BAR; PG8_WAIT_L(0); PG8_MMA(0, 0, At, B0); PG8_BAR; PG8_SCHED;
            PG8_LDB(B1, 0, 1); PG8_STAGE(PG8_SB(0, 0), b2, voffB);
            PG8_BAR; PG8_WAIT_L(0); PG8_MMA(0, 1, At, B1); PG8_BAR;
            PG8_LDA(At, 0, 1); PG8_STAGE(PG8_SA(0, 0), a2, voffA);
            PG8_BAR; PG8_WAIT_L(0); PG8_MMA(1, 0, At, B0); PG8_BAR; PG8_SCHED;
            PG8_STAGE(PG8_SB(0, 1), b2 + hstep, voffB);
            PG8_WAIT_V(6); PG8_BAR; PG8_MMA(1, 1, At, B1); PG8_BAR;
            PG8_LDB(B0, 1, 0); PG8_SCHED; PG8_LDA(At, 1, 0); PG8_STAGE(PG8_SA(0, 1), a2 + hstep, voffA);
            PG8_WAIT_L(8); PG8_BAR; PG8_WAIT_L(0); PG8_MMA(0, 0, At, B0); PG8_BAR; PG8_SCHED;
            PG8_LDB(B1, 1, 1); PG8_STAGE(PG8_SB(1, 0), b3, voffB);
            PG8_BAR; PG8_WAIT_L(0); PG8_MMA(0, 1, At, B1); PG8_BAR;
            PG8_LDA(At, 1, 1); PG8_STAGE(PG8_SA(1, 0), a3, voffA);
            PG8_BAR; PG8_WAIT_L(0); PG8_MMA(1, 0, At, B0); PG8_BAR; PG8_SCHED;
            PG8_STAGE(PG8_SB(1, 1), b3 + hstep, voffB);
            PG8_WAIT_V(6); PG8_BAR; PG8_MMA(1, 1, At, B1); PG8_BAR;
            }
        }
        if constexpr (ALIGN_EPI) { if (wr == 0) PG8_BAR; }
        if constexpr (!Epi::AFTER_DRAIN) { E(acc, cur, wr, wc, fr, fq); S.done(cur); }
        if (!has_next) break;
#pragma unroll
        for (int a = 0; a < 2; ++a)
#pragma unroll
            for (int b = 0; b < 2; ++b)
#pragma unroll
                for (int m = 0; m < 4; ++m)
#pragma unroll
                    for (int n = 0; n < 2; ++n) acc[a][b][m][n] = (f32x4){0.f, 0.f, 0.f, 0.f};
        cur = nxt; cA = nA; cB = nB; ++ui;
        if constexpr (ALIGN_EPI) { if (wr == 1) PG8_BAR; }
    }
    PG8_WAIT_V(0);
    if constexpr (!ALIGN_EPI) { if (wr == 0) PG8_BAR; }
    PG8_BAR;
    if constexpr (Epi::AFTER_DRAIN) { E.fused(acc, cur, wr, wc, fr, fq, lds, wid, lane); S.done(cur); }
#undef PG8_SA
#undef PG8_SB
#undef PG8_STAGE
#undef PG8_LDA
#undef PG8_LDB
#undef PG8_MMA
#undef PG8_WAIT_V
#undef PG8_WAIT_L
#undef PG8_BAR
#undef PG8_SCHED
}
}

#define LAS __attribute__((address_space(3)))
typedef unsigned short bf16_t;
typedef short bf16x8 __attribute__((ext_vector_type(8)));
typedef short s16x4 __attribute__((ext_vector_type(4)));
typedef float f32x4 __attribute__((ext_vector_type(4)));
typedef float f32x2 __attribute__((ext_vector_type(2)));
typedef float f32x16 __attribute__((ext_vector_type(16)));
typedef unsigned u32x4 __attribute__((ext_vector_type(4)));
typedef unsigned u32x2 __attribute__((ext_vector_type(2)));

constexpr int DM = 1024, SEQ = 4096, NB = 8, TS = 32, PAST = 4096;
constexpr int MP = NB * SEQ, MS = NB * TS, M1 = MP + MS;
constexpr int KVS = PAST + 64, KVR = MP + NB * KVS;
constexpr int BVS = 512 + 64, BVR = MP + NB * BVS;
constexpr int NIN = 3072;
constexpr float EPS = 1e-6f, LOG2E = 1.4426950408889634f;
constexpr float QS_MLA = 0.10206207261596575f * LOG2E;
constexpr float QS_B = 0.125f * LOG2E;
constexpr int OFF_CQ = 0, OFF_CKV = 256, OFF_KR = 384, OFF_GA = 416, OFF_QB = 928, OFF_KB = 1440, OFF_VB = 1952, OFF_GB = 2464, IN_W = 2976;
constexpr size_t O_YP = 0, O_YS = O_YP + (size_t)MP * DM, O_CKVP = O_YS + (size_t)MS * DM, O_KPEP = O_CKVP + (size_t)MP * 128,
                 O_KBP = O_KPEP + (size_t)MP * 32, O_VBP = O_KBP + (size_t)NB * 512 * 512, O_CKVS = O_VBP + (size_t)NB * 512 * 512,
                 O_KPES = O_CKVS + (size_t)MS * 128, O_KBS = O_KPES + (size_t)MS * 32, O_VBS = O_KBS + (size_t)MS * 512, O_END = O_VBS + (size_t)MS * 512;
constexpr size_t al256(size_t x) { return (x + 255) & ~(size_t)255; }
constexpr size_t WS_CTL = 0, WS_ROPE = 32768, WS_WIN = al256(WS_ROPE + (size_t)(PAST + TS) * 32 * 4), WS_WUQ = WS_WIN + (size_t)NIN * 1024 * 2,
                 WS_WUKV = WS_WUQ + (size_t)768 * 256 * 2, WS_WOUT = WS_WUKV + (size_t)1024 * 128 * 2, WS_XN = WS_WOUT + (size_t)1024 * 1024 * 2,
                 WS_CQ = WS_XN + (size_t)M1 * 1024 * 2, WS_CKV = WS_CQ + (size_t)M1 * 256 * 2, WS_KPE = WS_CKV + (size_t)KVR * 128 * 2,
                 WS_SG = WS_KPE + (size_t)KVR * 32 * 2, WS_QB = WS_SG + (size_t)M1 * 1024 * 2, WS_KVB = WS_QB + (size_t)M1 * 512 * 2,
                 WS_QM = WS_KVB + (size_t)BVR * 1024 * 2, WS_KVM = WS_QM + (size_t)M1 * 768 * 2, WS_END = WS_KVM + (size_t)KVR * 1024 * 2;
constexpr size_t WS_Y = WS_XN;
constexpr size_t WS_ZCQ = WS_QM, WS_ZCKV = WS_QM + (size_t)M1 * 256 * 2;
static_assert(WS_ZCKV + (size_t)M1 * 128 * 4 <= WS_KVM, "overlay");
constexpr size_t WS_X1 = WS_KVM, WS_SSQ = WS_QM;

constexpr int LDS_RING = 131072, LDS_TOTAL = LDS_RING + 1024;

__device__ __forceinline__ unsigned pk_bf16(float lo, float hi) { f32x2 v = {lo, hi}; typedef __bf16 bf2 __attribute__((ext_vector_type(2))); bf2 b = __builtin_convertvector(v, bf2); return __builtin_bit_cast(unsigned, b); }
__device__ __forceinline__ float bf_lo(unsigned w) { return __builtin_bit_cast(float, w << 16); }
__device__ __forceinline__ float bf_hi(unsigned w) { return __builtin_bit_cast(float, w & 0xffff0000u); }
__device__ __forceinline__ u32x4 pk8(const f32x4 a, const f32x4 b) { u32x4 w; w.x = pk_bf16(a[0], a[1]); w.y = pk_bf16(a[2], a[3]); w.z = pk_bf16(b[0], b[1]); w.w = pk_bf16(b[2], b[3]); return w; }
__device__ __forceinline__ float wave_sum(float v) {
#pragma unroll
    for (int o = 1; o < 64; o <<= 1) v += __shfl_xor(v, o);
    return v;
}
__device__ __forceinline__ int kvrow_m(int row) { if (row < MP) return row; const int r = row - MP; return MP + (r >> 5) * KVS + PAST + (r & 31); }
__device__ __forceinline__ int kvrow_b(int row) { if (row < MP) return row; const int r = row - MP; return MP + (r >> 5) * BVS + 512 + (r & 31); }
__device__ __forceinline__ int pos_of(int row) { if (row < MP) return row & (SEQ - 1); return PAST + ((row - MP) & 31); }

__device__ __forceinline__ void rope8(f32x4& v0, f32x4& v1, const float* rp  , int fq) {
    const int i0 = 8 * (fq & 1);
    const f32x4 c0 = *(const f32x4*)(rp + i0), c1 = *(const f32x4*)(rp + i0 + 4), s0 = *(const f32x4*)(rp + 16 + i0), s1 = *(const f32x4*)(rp + 16 + i0 + 4);
    f32x4 p0, p1;
#pragma unroll
    for (int j = 0; j < 4; ++j) { p0[j] = __shfl_xor(v0[j], 32); p1[j] = __shfl_xor(v1[j], 32); }
    if (fq < 2) { v0 = v0 * c0 - p0 * s0; v1 = v1 * c1 - p1 * s1; }
    else        { v0 = p0 * s0 + v0 * c0; v1 = p1 * s1 + v1 * c1; }
}
__device__ __forceinline__ float silu_f(float g) { return g * __builtin_amdgcn_rcpf(1.0f + __builtin_amdgcn_exp2f(-g * LOG2E)); }

struct EpiG1 {
    static constexpr bool PERM = true, AFTER_DRAIN = false;
    bf16_t *zcq, *kpe, *sg, *qb, *kvb; float* zckv; float* out; const float* rope;
    __device__ __forceinline__ void operator()(const f32x4 (&acc)[2][2][4][2], const pg8::Unit& u, int wr, int wc, int fr, int fq) const {
        const int pn = u.pn, row0 = u.pm * 256 + wr * 64 + fr, cl = wc * 32 + 8 * fq;
        if (pn == 0) {
#pragma unroll
            for (int ai = 0; ai < 2; ++ai)
#pragma unroll
                for (int m = 0; m < 4; ++m) { const int row = row0 + ai * 128 + m * 16;
#pragma unroll
                    for (int bj = 0; bj < 2; ++bj) *(u32x4*)(zcq + (size_t)row * 256 + bj * 128 + cl) = pk8(acc[ai][bj][m][0], acc[ai][bj][m][1]); }
        } else if (pn == 1) {
#pragma unroll
            for (int ai = 0; ai < 2; ++ai)
#pragma unroll
                for (int m = 0; m < 4; ++m) { const int row = row0 + ai * 128 + m * 16; float* p = zckv + (size_t)row * 128 + cl;
                    *(f32x4*)p = acc[ai][0][m][0]; *(f32x4*)(p + 4) = acc[ai][0][m][1]; }
            if (wc == 0) {
#pragma unroll
                for (int ai = 0; ai < 2; ++ai)
#pragma unroll
                    for (int m = 0; m < 4; ++m) { const int row = row0 + ai * 128 + m * 16; f32x4 v0 = acc[ai][1][m][0], v1 = acc[ai][1][m][1];
                        rope8(v0, v1, rope + (size_t)pos_of(row) * 32, fq);
                        float* po = (row < MP) ? out + O_KPEP + (size_t)row * 32 + 8 * fq : out + O_KPES + (size_t)(row - MP) * 32 + 8 * fq;
                        *(f32x4*)po = v0; *(f32x4*)(po + 4) = v1;
                        *(u32x4*)(kpe + (size_t)kvrow_m(row) * 32 + 8 * fq) = pk8(v0, v1); asm volatile("" ::: "memory"); }
            }
        } else if (pn < 6) {
            const int cb = (pn - 2) * 256 + cl;
#pragma unroll
            for (int ai = 0; ai < 2; ++ai)
#pragma unroll
                for (int m = 0; m < 4; ++m) { const int row = row0 + ai * 128 + m * 16;
#pragma unroll
                    for (int bj = 0; bj < 2; ++bj) { f32x4 a = acc[ai][bj][m][0], b = acc[ai][bj][m][1];
#pragma unroll
                        for (int j = 0; j < 4; ++j) { a[j] = silu_f(a[j]); b[j] = silu_f(b[j]); }
                        *(u32x4*)(sg + (size_t)row * 1024 + cb + bj * 128) = pk8(a, b); } }
        } else if (pn < 8) {
            const int cb = (pn - 6) * 256 + cl;
#pragma unroll
            for (int ai = 0; ai < 2; ++ai)
#pragma unroll
                for (int m = 0; m < 4; ++m) { const int row = row0 + ai * 128 + m * 16;
#pragma unroll
                    for (int bj = 0; bj < 2; ++bj) *(u32x4*)(qb + (size_t)row * 512 + cb + bj * 128) = pk8(acc[ai][bj][m][0] * QS_B, acc[ai][bj][m][1] * QS_B); }
        } else if (pn < 12) {
            const int cb = (pn - 8) * 256 + cl;
            const bool isv = pn >= 10; const int co = cb - (isv ? 512 : 0);
#pragma unroll
            for (int ai = 0; ai < 2; ++ai)
#pragma unroll
                for (int m = 0; m < 4; ++m) { const int row = row0 + ai * 128 + m * 16;
                    float* po = nullptr;
                    if (row < MP) { const int s = row & (SEQ - 1); if (s >= SEQ - 512) po = out + (isv ? O_VBP : O_KBP) + ((size_t)(row >> 12) * 512 + (s - (SEQ - 512))) * 512 + co; }
                    else po = out + (isv ? O_VBS : O_KBS) + (size_t)(row - MP) * 512 + co;
                    bf16_t* pk = kvb + (size_t)kvrow_b(row) * 1024 + cb;
#pragma unroll
                    for (int bj = 0; bj < 2; ++bj) { *(u32x4*)(pk + bj * 128) = pk8(acc[ai][bj][m][0], acc[ai][bj][m][1]);
                        if (po) { *(f32x4*)(po + bj * 128) = acc[ai][bj][m][0]; *(f32x4*)(po + bj * 128 + 4) = acc[ai][bj][m][1]; } } }
        }
    }
};
__device__ __forceinline__ void rope8t(f32x4& v0, f32x4& v1, const f32x4 c0, const f32x4 c1, const f32x4 s0, const f32x4 s1, int fq) {
    f32x4 p0, p1;
#pragma unroll
    for (int j = 0; j < 4; ++j) { p0[j] = __shfl_xor(v0[j], 32); p1[j] = __shfl_xor(v1[j], 32); }
    if (fq < 2) { v0 = v0 * c0 - p0 * s0; v1 = v1 * c1 - p1 * s1; }
    else        { v0 = p0 * s0 + v0 * c0; v1 = p1 * s1 + v1 * c1; }
}
struct EpiG2 {
    static constexpr bool PERM = true, AFTER_DRAIN = false;
    bf16_t* qm; const float* rope;
    __device__ __forceinline__ void operator()(const f32x4 (&acc)[2][2][4][2], const pg8::Unit& u, int wr, int wc, int fr, int fq) const {
        const int pn = u.pn, row0 = u.pm * 256 + wr * 64 + fr;
        if (pn < 2) {
#pragma unroll
            for (int ai = 0; ai < 2; ++ai)
#pragma unroll
                for (int m = 0; m < 4; ++m) { const int row = row0 + ai * 128 + m * 16;
#pragma unroll
                    for (int bj = 0; bj < 2; ++bj) { const int n = pn * 256 + bj * 128 + wc * 32 + 8 * fq; const int dc = (n >> 6) * 96 + (n & 63);
                        *(u32x4*)(qm + (size_t)row * 768 + dc) = pk8(acc[ai][bj][m][0] * QS_MLA, acc[ai][bj][m][1] * QS_MLA); } }
        } else {
            const int i0 = 8 * (fq & 1);
#pragma unroll
            for (int ai = 0; ai < 2; ++ai)
#pragma unroll
                for (int mp = 0; mp < 4; mp += 2) {
                    f32x4 c0[2], c1[2], s0[2], s1[2];
#pragma unroll
                    for (int q = 0; q < 2; ++q) { const float* rp = rope + (size_t)pos_of(row0 + ai * 128 + (mp + q) * 16) * 32 + i0;
                        c0[q] = *(const f32x4*)rp; c1[q] = *(const f32x4*)(rp + 4); s0[q] = *(const f32x4*)(rp + 16); s1[q] = *(const f32x4*)(rp + 20); }
#pragma unroll
                    for (int q = 0; q < 2; ++q) { const int m = mp + q, row = row0 + ai * 128 + m * 16;
#pragma unroll
                        for (int bj = 0; bj < 2; ++bj) { f32x4 v0 = acc[ai][bj][m][0], v1 = acc[ai][bj][m][1];
                            rope8t(v0, v1, c0[q], c1[q], s0[q], s1[q], fq);
                            *(u32x4*)(qm + (size_t)row * 768 + (bj * 4 + wc) * 96 + 64 + 8 * fq) = pk8(v0 * QS_MLA, v1 * QS_MLA); } }
                    asm volatile("" ::: "memory");
                }
        }
    }
};
struct EpiPlain {
    static constexpr bool PERM = true, AFTER_DRAIN = false;
    bf16_t* O; int ldc;
    __device__ __forceinline__ void operator()(const f32x4 (&acc)[2][2][4][2], const pg8::Unit& u, int wr, int wc, int fr, int fq) const {
        const int row0 = u.pm * 256 + wr * 64 + fr, col0 = u.pn * 256 + wc * 32 + 8 * fq;
#pragma unroll
        for (int ai = 0; ai < 2; ++ai)
#pragma unroll
            for (int m = 0; m < 4; ++m) { bf16_t* p = O + (size_t)(row0 + ai * 128 + m * 16) * ldc + col0;
#pragma unroll
                for (int bj = 0; bj < 2; ++bj) *(u32x4*)(p + bj * 128) = pk8(acc[ai][bj][m][0], acc[ai][bj][m][1]); }
    }
};
struct EpiG4 {
    static constexpr bool PERM = true, AFTER_DRAIN = false;
    const float *xp, *xs; float* out; bf16_t* x1; float* ssq;
    __device__ __forceinline__ void operator()(const f32x4 (&acc)[2][2][4][2], const pg8::Unit& u, int wr, int wc, int fr, int fq) const {
        const int row0 = u.pm * 256 + wr * 64 + fr, col0 = u.pn * 256 + wc * 32 + 8 * fq;
        if (u.pm < MP / 256) {
#pragma unroll
            for (int ai = 0; ai < 2; ++ai) {
                f32x4 xr[4][2][2];
#pragma unroll
                for (int m = 0; m < 4; ++m) { const float* px = xp + (size_t)(row0 + ai * 128 + m * 16) * 1024 + col0;
#pragma unroll
                    for (int bj = 0; bj < 2; ++bj) { xr[m][bj][0] = __builtin_nontemporal_load((const f32x4*)(px + bj * 128)); xr[m][bj][1] = __builtin_nontemporal_load((const f32x4*)(px + bj * 128 + 4)); } }
#pragma unroll
                for (int m = 0; m < 4; ++m) { const int row = row0 + ai * 128 + m * 16; bf16_t* po = x1 + (size_t)row * 1024 + col0; float s = 0.f;
#pragma unroll
                    for (int bj = 0; bj < 2; ++bj) { const f32x4 a = xr[m][bj][0] + acc[ai][bj][m][0], b = xr[m][bj][1] + acc[ai][bj][m][1];
                        s += (a[0] * a[0] + a[1] * a[1]) + (a[2] * a[2] + a[3] * a[3]) + (b[0] * b[0] + b[1] * b[1]) + (b[2] * b[2] + b[3] * b[3]);
                        *(u32x4*)(po + bj * 128) = pk8(a, b); }
                    s += __shfl_xor(s, 16); s += __shfl_xor(s, 32);
                    if (fq == 0) ssq[(size_t)row * 16 + u.pn * 4 + wc] = s; }
                asm volatile("" ::: "memory");
            }
        } else {
#pragma unroll
            for (int ai = 0; ai < 2; ++ai)
#pragma unroll
                for (int m = 0; m < 4; ++m) { const int row = row0 + ai * 128 + m * 16;
                    const float* px = xs + (size_t)(row - MP) * 1024 + col0; float* po = out + (size_t)row * 1024 + col0;
#pragma unroll
                    for (int bj = 0; bj < 2; ++bj) { const f32x4 a = *(const f32x4*)(px + bj * 128), b = *(const f32x4*)(px + bj * 128 + 4);
                        *(f32x4*)(po + bj * 128) = a + acc[ai][bj][m][0]; *(f32x4*)(po + bj * 128 + 4) = b + acc[ai][bj][m][1]; } }
        }
    }
};

struct SkewOrder {
    int nM, nN, nwg, G, c, base_rounds, c0;
    __device__ void init(int M, int N, int G_, int c_, int br, int c0_) { nM = M / 256; nN = N / 256; nwg = nM * nN; G = G_; c = c_; base_rounds = br; c0 = c0_; }
    __device__ bool next(int i, pg8::Unit& u) const {
        long L;
        if (i < base_rounds) L = (long)i * G + c;
        else { if (c < c0) return false; L = (long)base_rounds * G + (long)(i - base_rounds) * (G - c0) + (c - c0); }
        if (L >= nwg) return false;
        int wgid = (int)L; { const int q = nwg / 8, r = nwg % 8, xcd = wgid % 8, off = wgid / 8; wgid = (xcd < r ? xcd * (q + 1) : r * (q + 1) + (xcd - r) * q) + off; }
        const int nig = 8 * nN, gid = wgid / nig, fm = gid * 8, gsz = (nM - fm) < 8 ? (nM - fm) : 8;
        u.pm = fm + ((wgid % nig) % gsz); u.pn = (wgid % nig) / gsz; return true;
    }
    __device__ __forceinline__ void a_ready(const pg8::Unit&) const {}
    __device__ __forceinline__ void done(const pg8::Unit&) const {}
};
struct OneUnit {
    int pm, pn;
    __device__ __forceinline__ bool next(int i, pg8::Unit& u) const { if (i > 0) return false; u.pm = pm; u.pn = pn; return true; }
    __device__ __forceinline__ void a_ready(const pg8::Unit&) const {}
    __device__ __forceinline__ void done(const pg8::Unit&) const {}
};
#ifndef MK_E1
#define MK_E1 0
#endif
#ifndef MK_E2
#define MK_E2 0
#endif
#ifndef MK_GRP_ODD
#define MK_GRP_ODD 0
#endif
namespace at {
constexpr int KSLOT = 12288, VSLOT = 8192;
constexpr int L_K = 0, L_V = 4 * KSLOT, L_WS = L_V + 4 * VSLOT, L_OST = L_WS + 8 * 256, L_TAB = L_OST + 8 * 4096, L_IDX = L_TAB + 1296, L_END = L_IDX + 16;
static_assert(L_END <= LDS_RING, "attention LDS");
__device__ __forceinline__ int crow(int r, int hi) { return (r & 3) + 8 * (r >> 2) + 4 * hi; }
__device__ __forceinline__ void glds16(const void* gsrc, unsigned lds_dst) { unsigned keep;
    asm volatile("s_mov_b32 %0, m0\n\ts_mov_b32 m0, %2\n\ts_nop 0\n\tglobal_load_lds_dwordx4 %1, off\n\ts_mov_b32 m0, %0" : "=&s"(keep) : "v"(gsrc), "s"(lds_dst) : "memory"); }
#define AT_WAITBAR() asm volatile("s_waitcnt vmcnt(0) lgkmcnt(0)\n\ts_barrier" ::: "memory")
#define AT_BAR() asm volatile("s_waitcnt lgkmcnt(0)\n\ts_barrier" ::: "memory")
#define AT_MFMA(a, b, c) __builtin_amdgcn_mfma_f32_32x32x16_bf16(a, b, c, 0, 0, 0)

template <int NQ> __device__ __forceinline__ void kload(bf16x8* kf, LAS const char* kslot, int r32, int hi) {
    LAS const char* kb = kslot + hi * 1024 + r32 * 16;
#pragma unroll
    for (int d0 = 0; d0 < NQ; ++d0) { kf[2 * d0] = *(LAS const bf16x8*)(kb + d0 * 2048); kf[2 * d0 + 1] = *(LAS const bf16x8*)(kb + d0 * 2048 + 512); }
}
template <int NQ> __device__ __forceinline__ void qkmm(f32x16& p0, f32x16& p1, const bf16x8* kf, const bf16x8* qr, const f32x16& cinit) {
#pragma unroll
    for (int d0 = 0; d0 < NQ; ++d0) {
        if (d0 == 0) { p0 = AT_MFMA(kf[0], qr[0], cinit); p1 = AT_MFMA(kf[1], qr[0], cinit); }
        else { p0 = AT_MFMA(kf[2 * d0], qr[d0], p0); p1 = AT_MFMA(kf[2 * d0 + 1], qr[d0], p1); }
    }
}
__device__ __forceinline__ float max3f(float a, float b, float c) { float r; asm("v_max3_f32 %0, %1, %2, %3" : "=v"(r) : "v"(a), "v"(b), "v"(c)); return r; }
__device__ __forceinline__ float max2f(float a, float b) { float r; asm("v_max_f32_e32 %0, %1, %2" : "=v"(r) : "v"(a), "v"(b)); return r; }
__device__ __forceinline__ float rowmax3(const f32x16& p0, const f32x16& p1) {
    float a = max3f(p0[0], p0[1], p1[0]), b = max3f(p0[2], p0[3], p1[1]); a = max3f(a, p1[2], p1[3]);
#pragma unroll
    for (int r = 4; r < 16; r += 4) { a = max3f(a, p0[r], p0[r + 1]); b = max3f(b, p0[r + 2], p0[r + 3]); a = max3f(a, p1[r], p1[r + 1]); b = max3f(b, p1[r + 2], p1[r + 3]); }
    const float m = max2f(a, b);
    auto rr = __builtin_amdgcn_permlane32_swap(__float_as_uint(m), __float_as_uint(m), false, false);
    return max2f(__uint_as_float(rr[0]), __uint_as_float(rr[1]));
}
__device__ __forceinline__ float rowmax(const f32x16& p0, const f32x16& p1) {
    float a = fmaxf(p0[0], p1[0]);
#pragma unroll
    for (int r = 1; r < 16; ++r) a = fmaxf(a, fmaxf(p0[r], p1[r]));
    auto rr = __builtin_amdgcn_permlane32_swap(__float_as_uint(a), __float_as_uint(a), false, false);
    return fmaxf(__uint_as_float(rr[0]), __uint_as_float(rr[1]));
}
typedef short v4i16_t __attribute__((ext_vector_type(4)));
__device__ __forceinline__ s16x4 vtr(LAS const char* p) { return __builtin_bit_cast(s16x4, __builtin_amdgcn_ds_read_tr16_b64_v4i16((LAS v4i16_t*)p)); }
__device__ __forceinline__ void vload(s16x4* vf, LAS const char* vp) {
#pragma unroll
    for (int d0 = 0; d0 < 2; ++d0)
#pragma unroll
        for (int ks = 0; ks < 4; ++ks) { vf[d0 * 8 + 2 * ks] = vtr(vp + d0 * 4096 + ks * 1024); vf[d0 * 8 + 2 * ks + 1] = vtr(vp + d0 * 4096 + ks * 1024 + 512); }
}
__device__ __forceinline__ void pvm(f32x16* o, const s16x4* vf, bf16x8 pa0, bf16x8 pa1, bf16x8 pa2, bf16x8 pa3) {
#define AT_PK(d, k) (bf16x8){vf[d * 8 + 2 * k][0], vf[d * 8 + 2 * k][1], vf[d * 8 + 2 * k][2], vf[d * 8 + 2 * k][3], vf[d * 8 + 2 * k + 1][0], vf[d * 8 + 2 * k + 1][1], vf[d * 8 + 2 * k + 1][2], vf[d * 8 + 2 * k + 1][3]}
    o[0] = AT_MFMA(pa0, AT_PK(0, 0), o[0]); o[1] = AT_MFMA(pa0, AT_PK(1, 0), o[1]);
    o[0] = AT_MFMA(pa1, AT_PK(0, 1), o[0]); o[1] = AT_MFMA(pa1, AT_PK(1, 1), o[1]);
    o[0] = AT_MFMA(pa2, AT_PK(0, 2), o[0]); o[1] = AT_MFMA(pa2, AT_PK(1, 2), o[1]);
    o[0] = AT_MFMA(pa3, AT_PK(0, 3), o[0]); o[1] = AT_MFMA(pa3, AT_PK(1, 3), o[1]);
#undef AT_PK
}

struct Tens { const bf16_t *qm, *qb, *kvm, *kvb, *kpe, *sg; bf16_t* y; const float* relb; };

template <int KIND> __device__ __forceinline__ void unit(const Tens& T, int seq, int h, int u, LAS unsigned char* lds) {
    constexpr int NQ = KIND == 0 ? 6 : 4;
    int tid_l = threadIdx.x; asm volatile("" : "+v"(tid_l));
    const int tid = tid_l, lane = tid & 63, r32 = lane & 31, hi = lane >> 5; const int wid = __builtin_amdgcn_readfirstlane(tid >> 6);
    const bool samp = seq >= NB; const int b = seq & 7;
    const unsigned lds0 = (unsigned)(uintptr_t)lds;
    int qrow, T0, T1, vlo, vhi, cq; size_t kvbase; bool active = true;
    if (KIND == 0) {
        if (!samp) { qrow = b * SEQ + 256 * u + 32 * wid; kvbase = (size_t)b * SEQ; T0 = 0; T1 = 4 * u + 4; vlo = 0; vhi = 4 * u + (wid >> 1); cq = vhi; }
        else { qrow = MP + b * TS; kvbase = (size_t)MP + (size_t)b * KVS; T0 = 0; T1 = 65; vlo = 0; vhi = 64; cq = 64; active = (wid == 0); }
    } else {
        if (!samp) { qrow = b * SEQ + 256 * u + 32 * wid; kvbase = (size_t)b * SEQ; T0 = 4 * u - 8 < 0 ? 0 : 4 * u - 8; T1 = 4 * u + 4; cq = 4 * u + (wid >> 1); vlo = cq - 8 < 0 ? 0 : cq - 8; vhi = cq; }
        else { qrow = MP + b * TS; kvbase = (size_t)MP + (size_t)b * BVS; T0 = 0; T1 = 9; vlo = 0; vhi = 8; cq = 8; active = (wid == 0); }
    }
    const bf16_t* KV = (KIND == 0 ? T.kvm : T.kvb) + kvbase * 1024 + h * 64;
    const bf16_t* ksrc = KV + (size_t)lane * 1024 + wid * 8;
    const bf16_t* k2src = T.kpe + (kvbase + lane) * 32 + (wid & 3) * 8;
    const bf16_t* vsrc = KV + 512 + (size_t)(16 * (wid & 3) + (lane >> 2)) * 1024 + (wid >> 2) * 32 + (lane & 3) * 8;
    const unsigned kdst = lds0 + L_K + wid * 1024, k2dst = lds0 + L_K + (8 + (wid & 3)) * 1024, vdst = lds0 + L_V + wid * 1024;
#define AT_DMA(t, s) do { AT_DMA1(t, s); if (MK_E1) AT_DMA1(t, s); } while (0)
#define AT_DMA1(t, s) do { glds16(ksrc + (size_t)(t) * 64 * 1024, (unsigned)__builtin_amdgcn_readfirstlane(kdst + (s) * KSLOT)); \
        if (KIND == 0 && wid < 4) glds16(k2src + (size_t)(t) * 64 * 32, (unsigned)__builtin_amdgcn_readfirstlane(k2dst + (s) * KSLOT)); \
        glds16(vsrc + (size_t)(t) * 64 * 1024, (unsigned)__builtin_amdgcn_readfirstlane(vdst + (s) * VSLOT)); } while (0)
    const int grp = (MK_GRP_ODD) ? (wid & 1) : (wid >> 2);
#define AT_DMA_K(t, s) glds16(ksrc + (size_t)(t) * 64 * 1024, (unsigned)__builtin_amdgcn_readfirstlane(kdst + (s) * KSLOT))
#define AT_DMA_K2(t, s) do { if (KIND == 0 && wid < 4) glds16(k2src + (size_t)(t) * 64 * 32, (unsigned)__builtin_amdgcn_readfirstlane(k2dst + (s) * KSLOT)); } while (0)
#define AT_DMA_V(t, s) glds16(vsrc + (size_t)(t) * 64 * 1024, (unsigned)__builtin_amdgcn_readfirstlane(vdst + (s) * VSLOT))
    AT_DMA(T0, 0);
    LAS float* tab = (LAS float*)(lds + L_TAB);
    if (KIND == 1) { if (tid < 320) tab[tid] = T.relb[h * 257 + (tid > 256 ? 256 : tid)] * LOG2E; }
    bf16x8 qr[NQ];
    {   const bf16_t* Qw = (KIND == 0 ? T.qm + (size_t)qrow * 768 + h * 96 : T.qb + (size_t)qrow * 512 + h * 64) + (size_t)r32 * (KIND == 0 ? 768 : 512) + hi * 8;
#pragma unroll
        for (int d0 = 0; d0 < NQ; ++d0) qr[d0] = active ? *(const bf16x8*)(Qw + d0 * 16) : (bf16x8){0, 0, 0, 0, 0, 0, 0, 0}; }
#pragma unroll
    for (int d0 = 0; d0 < NQ; ++d0) asm volatile("" : "+v"(qr[d0]));
    AT_DMA(T0 + 1, 1); AT_DMA(T0 + 2, 2);
    const bool np3 = (KIND == 0 && wid < 4);
#define AT_WAIT_TILES(n) do { if (np3) { if ((n) == 2) asm volatile("s_waitcnt vmcnt(6)" ::: "memory"); else if ((n) == 1) asm volatile("s_waitcnt vmcnt(3)" ::: "memory"); else asm volatile("s_waitcnt vmcnt(0)" ::: "memory"); } \
        else { if ((n) == 2) asm volatile("s_waitcnt vmcnt(4)" ::: "memory"); else if ((n) == 1) asm volatile("s_waitcnt vmcnt(2)" ::: "memory"); else asm volatile("s_waitcnt vmcnt(0)" ::: "memory"); } } while (0)
    AT_WAIT_TILES(2);
    AT_BAR();
    LAS float* wsf = (LAS float*)(lds + L_WS) + wid * 64;
    const int vboff = ((lane >> 4) & 1) * 32 + (lane & 3) * 8 + (4 * hi + ((lane & 15) >> 2)) * 64;
    float m_ref = 0.f, l_run = 0.f; bool first = true; f32x16 o[2]; o[0] = f32x16{}; o[1] = f32x16{};
    const float cbfar = (KIND == 1) ? tab[256] : 0.f;
    f32x16 negn = f32x16{}, negf;
#pragma unroll
    for (int r = 0; r < 16; ++r) negf[r] = cbfar;
    const int aq = 32 * (wid & 1) + r32;
    bf16x8 kf[2 * NQ]; s16x4 vf[16];
    f32x16 p0, p1;
    if (grp == 1) { AT_WAIT_TILES(1); AT_DMA(T0 + 3, 3); }
    if (active && T0 >= vlo) kload<NQ>(kf, (LAS const char*)(lds + L_K), r32, hi);
    if (grp == 1) AT_BAR();
#define AT_PK(d, k) (bf16x8){vf[d * 8 + 2 * k][0], vf[d * 8 + 2 * k][1], vf[d * 8 + 2 * k][2], vf[d * 8 + 2 * k][3], vf[d * 8 + 2 * k + 1][0], vf[d * 8 + 2 * k + 1][1], vf[d * 8 + 2 * k + 1][2], vf[d * 8 + 2 * k + 1][3]}
#define AT_TILE(ST, j) do { \
        const int sc = (j - T0) & 3; \
        const bool vis = ST || (active && j >= vlo && j <= vhi); \
        const bool visn = ST || (active && j + 1 >= vlo && j + 1 <= vhi && j + 1 < T1); \
        const bool issA = (grp == 0) && (ST || j + 3 < T1), issB = (grp == 1) && (ST || j + 4 < T1); \
        if (grp == 0) { if (ST || j + 2 < T1) AT_WAIT_TILES(1); else AT_WAIT_TILES(0); if (issA && !vis) AT_DMA(j + 3, (sc + 3) & 3); } \
        if (vis) { \
            const int jd = cq - j; \
            vload(vf, (LAS const char*)(lds + L_V + sc * VSLOT) + vboff); \
            __builtin_amdgcn_sched_barrier(0); \
            if (KIND == 1 && (ST || jd >= 3)) { p0 = AT_MFMA(kf[0], qr[0], negf); p1 = AT_MFMA(kf[1], qr[0], negf); asm volatile("" ::: "memory"); } \
            else { p0 = AT_MFMA(kf[0], qr[0], negn); p1 = AT_MFMA(kf[1], qr[0], negn); asm volatile("" ::: "memory"); } \
            __builtin_amdgcn_sched_barrier(0); if (issA) AT_DMA_K(j + 3, (sc + 3) & 3); __builtin_amdgcn_sched_barrier(0); \
            p0 = AT_MFMA(kf[2], qr[1], p0); p1 = AT_MFMA(kf[3], qr[1], p1); \
            __builtin_amdgcn_sched_barrier(0); if (issA) AT_DMA_V(j + 3, (sc + 3) & 3); __builtin_amdgcn_sched_barrier(0); \
            p0 = AT_MFMA(kf[4], qr[2], p0); p1 = AT_MFMA(kf[5], qr[2], p1); \
            __builtin_amdgcn_sched_barrier(0); if (issA) AT_DMA_K2(j + 3, (sc + 3) & 3); __builtin_amdgcn_sched_barrier(0); \
_Pragma("unroll") \
            for (int d0 = 3; d0 < NQ; ++d0) { p0 = AT_MFMA(kf[2 * d0], qr[d0], p0); p1 = AT_MFMA(kf[2 * d0 + 1], qr[d0], p1); } \
            if (KIND == 1 && !ST && jd < 3) { LAS const float* tb = tab + (64 * jd + aq + 128 - 4 * hi - 27 - 32); \
_Pragma("unroll") \
                for (int r = 0; r < 16; ++r) { const int c = 27 - ((r & 3) + 8 * (r >> 2)); p0[r] += tb[32 + c]; p1[r] += tb[c]; } } \
            if (!ST && samp && j == T1 - 1) { \
_Pragma("unroll") \
                for (int r = 0; r < 16; ++r) p1[r] = -INFINITY; \
                asm volatile("" : "+v"(p1)); } \
            asm volatile("s_nop 15\n\ts_nop 7" : "+v"(p0), "+v"(p1)); \
            const float rm = rowmax3(p0, p1); \
            const bool fst = !ST && first; \
            if (fst || __any(rm > 8.0f)) { \
                const float dl = fst ? rm : fmaxf(rm, 0.f); \
                m_ref += dl; \
_Pragma("unroll") \
                for (int r = 0; r < 16; ++r) { p0[r] -= dl; p1[r] -= dl; } \
_Pragma("unroll") \
                for (int r = 0; r < 16; ++r) { negn[r] = -m_ref; negf[r] = cbfar - m_ref; } \
                asm volatile("" : "+v"(negn), "+v"(negf)); \
                if (!fst) { \
                    const float alpha = __builtin_amdgcn_exp2f(-dl); l_run *= alpha; \
                    if (hi == 0) wsf[r32] = alpha; \
_Pragma("unroll") \
                    for (int r = 0; r < 16; ++r) { const float a = wsf[crow(r, hi)]; o[0][r] *= a; o[1][r] *= a; } \
                } \
                first = false; \
            } \
        } \
        AT_BAR(); \
        if (grp == 1) { if (ST || j + 3 < T1) AT_WAIT_TILES(1); else AT_WAIT_TILES(0); if (issB && !vis) AT_DMA(j + 4, sc); } \
        if (visn) kload<NQ>(kf, (LAS const char*)(lds + L_K + ((sc + 1) & 3) * KSLOT), r32, hi); \
        __builtin_amdgcn_sched_barrier(0); \
        if (vis) { \
            float sacc = 0.f; \
_Pragma("unroll") \
            for (int r = 0; r < 16; ++r) { p0[r] = __builtin_amdgcn_exp2f(p0[r]); p1[r] = __builtin_amdgcn_exp2f(p1[r]); sacc += p0[r] + p1[r]; } \
            l_run += sacc; \
            u32x4 w0, w1, w2, w3; \
            w0 = (u32x4){pk_bf16(p0[0], p0[1]), pk_bf16(p0[2], p0[3]), pk_bf16(p0[4], p0[5]), pk_bf16(p0[6], p0[7])}; \
            w1 = (u32x4){pk_bf16(p0[8], p0[9]), pk_bf16(p0[10], p0[11]), pk_bf16(p0[12], p0[13]), pk_bf16(p0[14], p0[15])}; \
            w2 = (u32x4){pk_bf16(p1[0], p1[1]), pk_bf16(p1[2], p1[3]), pk_bf16(p1[4], p1[5]), pk_bf16(p1[6], p1[7])}; \
            w3 = (u32x4){pk_bf16(p1[8], p1[9]), pk_bf16(p1[10], p1[11]), pk_bf16(p1[12], p1[13]), pk_bf16(p1[14], p1[15])}; \
            __builtin_amdgcn_sched_barrier(0); \
            {   const bf16x8 pa0 = __builtin_bit_cast(bf16x8, w0), pa1 = __builtin_bit_cast(bf16x8, w1), pa2 = __builtin_bit_cast(bf16x8, w2), pa3 = __builtin_bit_cast(bf16x8, w3); \
                o[0] = AT_MFMA(pa0, AT_PK(0, 0), o[0]); o[1] = AT_MFMA(pa0, AT_PK(1, 0), o[1]); \
                __builtin_amdgcn_sched_barrier(0); if (issB) AT_DMA_K(j + 4, sc); __builtin_amdgcn_sched_barrier(0); \
                o[0] = AT_MFMA(pa1, AT_PK(0, 1), o[0]); o[1] = AT_MFMA(pa1, AT_PK(1, 1), o[1]); \
                __builtin_amdgcn_sched_barrier(0); if (issB) AT_DMA_V(j + 4, sc); __builtin_amdgcn_sched_barrier(0); \
                o[0] = AT_MFMA(pa2, AT_PK(0, 2), o[0]); o[1] = AT_MFMA(pa2, AT_PK(1, 2), o[1]); \
                __builtin_amdgcn_sched_barrier(0); if (issB) AT_DMA_K2(j + 4, sc); __builtin_amdgcn_sched_barrier(0); \
                o[0] = AT_MFMA(pa3, AT_PK(0, 3), o[0]); o[1] = AT_MFMA(pa3, AT_PK(1, 3), o[1]); \
            } \
        } \
        AT_BAR(); \
    } while (0)
    int js = T1, je = T1;
    if (active) { js = vlo + 1; int jl = vhi - 1; if (T1 - 5 < jl) jl = T1 - 5; if (KIND == 1 && cq - 3 < jl) jl = cq - 3; je = jl + 1; if (js > T1) js = T1; if (je < js) je = js; }
    int j = T0;
    for (; j < js; ++j) AT_TILE(false, j);
    for (; j < je; ++j) AT_TILE(true, j);
    for (; j < T1; ++j) AT_TILE(false, j);
#undef AT_TILE
#undef AT_PK
    const int colb = KIND * 512 + h * 64;
    u32x4 gpre[4];
    if (active) {
#pragma unroll
        for (int i = 0; i < 4; ++i) gpre[i] = __builtin_nontemporal_load((const u32x4*)(T.sg + (size_t)(qrow + i * 8 + (lane >> 3)) * 1024 + colb + (lane & 7) * 8)); }
    if (grp == 0) AT_BAR();
    if (active) {
        { auto rr = __builtin_amdgcn_permlane32_swap(__float_as_uint(l_run), __float_as_uint(l_run), false, false); l_run = __uint_as_float(rr[0]) + __uint_as_float(rr[1]); }
        if (hi == 0) wsf[32 + r32] = l_run;
        LAS bf16_t* stg = (LAS bf16_t*)(lds + L_OST) + wid * 2048;
#pragma unroll
        for (int r = 0; r < 16; ++r) { const int orow = crow(r, hi); const float rl = __builtin_amdgcn_rcpf(wsf[32 + orow]);
#pragma unroll
            for (int d0 = 0; d0 < 2; ++d0) stg[orow * 64 + d0 * 32 + r32] = (bf16_t)(pk_bf16(o[d0][r] * rl, 0.f) & 0xffffu); }
#pragma unroll
        for (int i = 0; i < 4; ++i) { const int row = i * 8 + (lane >> 3), ch = lane & 7;
            const u32x4 v = *(LAS const u32x4*)(stg + row * 64 + ch * 8);
            const size_t gi = (size_t)(qrow + row) * 1024 + colb + ch * 8;
            const u32x4 g = gpre[i]; u32x4 w;
            w.x = pk_bf16(bf_lo(v.x) * bf_lo(g.x), bf_hi(v.x) * bf_hi(g.x)); w.y = pk_bf16(bf_lo(v.y) * bf_lo(g.y), bf_hi(v.y) * bf_hi(g.y));
            w.z = pk_bf16(bf_lo(v.z) * bf_lo(g.z), bf_hi(v.z) * bf_hi(g.z)); w.w = pk_bf16(bf_lo(v.w) * bf_lo(g.w), bf_hi(v.w) * bf_hi(g.w));
            *(u32x4*)(T.y + gi) = w; }
    }
#undef AT_DMA
#undef AT_DMA_K
#undef AT_DMA_K2
#undef AT_DMA_V
#undef AT_WAIT_TILES
#undef AT_DMA1
}
constexpr int NU_MS = 64, NU_MP = 1024, NU_BP = 1024, NU_BS = 64, NU_G4S = 4, NU_TOT = NU_MS + NU_MP + NU_BP + NU_BS + NU_G4S;
constexpr int IDX_G4S = NU_MS + NU_BS + 13 * 64;
__device__ __forceinline__ void run_unit(const Tens& T, int idx, LAS unsigned char* lds) {
    int kind, seq, h, u;
    if (idx < NU_MS) { kind = 0; seq = 8 + (idx >> 3); h = idx & 7; u = 0; }
    else if (idx < NU_MS + NU_BS) { const int i = idx - NU_MS; kind = 1; seq = 8 + (i >> 3); h = i & 7; u = 0; }
    else if (idx < IDX_G4S) { const int i = idx - NU_MS - NU_BS; kind = 0; u = 15 - i / 64; seq = (i % 64) >> 3; h = i & 7; }
    else if (idx < IDX_G4S + NU_G4S + NU_BP) { const int i = idx - IDX_G4S - NU_G4S; kind = 1; u = 15 - i / 64; seq = (i % 64) >> 3; h = i & 7; }
    else { const int i = idx - IDX_G4S - NU_G4S - NU_BP; kind = 0; u = 2 - i / 64; seq = (i % 64) >> 3; h = i & 7; }
    if (kind == 0) unit<0>(T, seq, h, u, lds); else unit<1>(T, seq, h, u, lds);
}
}

__device__ __forceinline__ void tr_item(const float* W, int N, int srccol0, int K, bf16_t* WT, int destrow0, int k0, LAS float* scr, int lane) {
    float tv[32];
#pragma unroll
    for (int i = 0; i < 32; ++i) { const int kk = 2 * i + (lane >> 5); tv[i] = srccol0 >= 0 ? __builtin_nontemporal_load(W + (size_t)(k0 + kk) * N + srccol0 + (lane & 31)) : 0.f; }
#pragma unroll
    for (int i = 0; i < 32; ++i) { const int kk = 2 * i + (lane >> 5); scr[kk * 33 + (lane & 31)] = tv[i]; }
    const int c = lane & 7;
#pragma unroll
    for (int j = 0; j < 4; ++j) { const int n = (lane >> 3) + 8 * j; const LAS float* s = scr + (8 * c) * 33 + n;
        u32x4 o; o.x = pk_bf16(s[0 * 33], s[1 * 33]); o.y = pk_bf16(s[2 * 33], s[3 * 33]); o.z = pk_bf16(s[4 * 33], s[5 * 33]); o.w = pk_bf16(s[6 * 33], s[7 * 33]);
        *(u32x4*)(WT + (size_t)(destrow0 + n) * K + k0 + 8 * c) = o; }
}
__device__ __forceinline__ int win_src(int ng) {
    if (ng < 8) return OFF_CQ + 32 * ng;
    if (ng < 12) return OFF_CKV + 32 * (ng - 8);
    if (ng == 12) return OFF_KR;
    if (ng < 16) return -1;
    if (ng < 32) return OFF_GA + 32 * (ng - 16);
    if (ng < 48) return OFF_GB + 32 * (ng - 32);
    if (ng < 64) return OFF_QB + 32 * (ng - 48);
    if (ng < 80) return OFF_KB + 32 * (ng - 64);
    return OFF_VB + 32 * (ng - 80);
}
__device__ __forceinline__ void sincos_d(double a, float& s, float& c) {
    const double twopi = 6.283185307179586476925286766559;
    const double k = __builtin_rint(a / twopi); const double r = a - k * twopi; const double r2 = r * r;
    double ts = 1.0, tc = 1.0;
#pragma unroll 1
    for (int n = 29; n >= 3; n -= 2) { ts = 1.0 - ts * r2 / (double)(n * (n - 1)); tc = 1.0 - tc * r2 / (double)(n * (n + 1)); }
    s = (float)(r * ts); c = (float)(1.0 - tc * r2 * 0.5);
}


__device__ __forceinline__ void xn_rows4(int mb, const float* x_p, const float* x_s, const float* g_mix, bf16_t* XN, int lane) {
    f32x4 v[4][4]; float s[4];
#pragma unroll
    for (int q = 0; q < 4; ++q) { const int m = mb + q; const float* xr = (m < MP) ? x_p + (size_t)m * DM : x_s + (size_t)(m - MP) * DM;
#pragma unroll
        for (int j = 0; j < 4; ++j) v[q][j] = __builtin_nontemporal_load((const f32x4*)(xr + 4 * lane + 256 * j)); }
#pragma unroll
    for (int q = 0; q < 4; ++q) { s[q] = 0.f;
#pragma unroll
        for (int j = 0; j < 4; ++j) s[q] += (v[q][j][0] * v[q][j][0] + v[q][j][1] * v[q][j][1]) + (v[q][j][2] * v[q][j][2] + v[q][j][3] * v[q][j][3]);
        s[q] = 1.0f / sqrtf(wave_sum(s[q]) * (1.0f / DM) + EPS); }
#pragma unroll
    for (int j = 0; j < 4; ++j) { const f32x4 g = *(const f32x4*)(g_mix + 4 * lane + 256 * j);
#pragma unroll
        for (int q = 0; q < 4; ++q) { const f32x4 o = v[q][j] * s[q] * g; u32x2 w; w.x = pk_bf16(o[0], o[1]); w.y = pk_bf16(o[2], o[3]); *(u32x2*)(XN + (size_t)(mb + q) * DM + 4 * lane + 256 * j) = w; } }
}
__device__ __forceinline__ void rope_entry(float* rope, int pos, int f) {
    const double inv = exp2(-(double)f * (13.287712379549449 / 16.0));
    float s, c; sincos_d((double)pos * inv, s, c); rope[pos * 32 + f] = c; rope[pos * 32 + 16 + f] = s;
}

__device__ __forceinline__ void grid_bar(unsigned* cnt, unsigned target) {
    asm volatile("s_waitcnt vmcnt(0)" ::: "memory");
    __syncthreads();
    if (threadIdx.x == 0) {
        __builtin_amdgcn_fence(__ATOMIC_RELEASE, "agent");
        asm volatile("s_waitcnt vmcnt(0)" ::: "memory");
        __hip_atomic_fetch_add(cnt, 1u, __ATOMIC_RELAXED, __HIP_MEMORY_SCOPE_AGENT);
        unsigned spins = 0;
        while (__hip_atomic_load(cnt, __ATOMIC_RELAXED, __HIP_MEMORY_SCOPE_AGENT) < target) { __builtin_amdgcn_s_sleep(2); if (++spins > (1u << 22)) break; }
        __builtin_amdgcn_fence(__ATOMIC_ACQUIRE, "agent");
        asm volatile("s_waitcnt vmcnt(0)" ::: "memory");
    }
    __syncthreads();
}
#define XB_TMO      128
#define XB_XCNT(j)  (256  + 64 * (j))
#define XB_XSUB(j)  (1280 + 64 * (j))
#define XB_XGEN(j)  (2304 + 64 * (j))
#define XB_TOP      3328
#define XB_TOPGEN   3392
#define XCD_BAR_WORDS 3456
#define XB_SPIN_CAP (1u << 18)

__device__ __forceinline__ unsigned xb_ld(unsigned* p)              { return __hip_atomic_load(p, __ATOMIC_RELAXED, __HIP_MEMORY_SCOPE_AGENT); }
__device__ __forceinline__ unsigned xb_add(unsigned* p, unsigned v) { return __hip_atomic_fetch_add(p, v, __ATOMIC_RELAXED, __HIP_MEMORY_SCOPE_AGENT); }
__device__ __forceinline__ unsigned xb_xcc_id() { return (unsigned)__builtin_amdgcn_s_getreg((3 << 11) | 20) & 0xFu; }
#define XB_SPIN(cond, bar) do { unsigned _sp = 0; while (cond) { __builtin_amdgcn_s_sleep(1); \
    if ((++_sp & 255u) == 0u) { if (xb_ld(&(bar)[XB_TMO])) break; if (_sp > XB_SPIN_CAP) { atomicAdd(&(bar)[XB_TMO], 1u); break; } } } } while (0)

struct XcdBarrier {
    unsigned* bar; unsigned x;
    volatile LAS unsigned* st;
};

__device__ __forceinline__ XcdBarrier xcd_barrier_post(unsigned* bar, volatile LAS unsigned* st) {
    XcdBarrier b; b.bar = bar; b.x = xb_xcc_id(); b.st = st;
    if (threadIdx.x == 0) (void)xb_add(&bar[XB_XCNT(b.x)], 1u);
    return b;
}
__device__ __forceinline__ void xcd_barrier_complete(unsigned* bar, unsigned x, unsigned& nloc, unsigned& nx) {
    const unsigned G = gridDim.x * gridDim.y * gridDim.z;
    unsigned sum, cnt, mine, sp = 0u;
    for (;;) {
        sum = 0u; cnt = 0u; mine = 0u;
#pragma unroll
        for (unsigned j = 0; j < 16; ++j) { const unsigned c = xb_ld(&bar[XB_XCNT(j)]); sum += c; cnt += (c > 0u) ? 1u : 0u; mine = (j == x) ? c : mine; }
        if (sum == G) break;
        __builtin_amdgcn_s_sleep(1);
        if ((++sp & 255u) == 0u) { if (xb_ld(&bar[XB_TMO])) break; if (sp > XB_SPIN_CAP) { atomicAdd(&bar[XB_TMO], 1u); break; } }
    }
    nloc = mine > 0u ? mine : 1u; nx = cnt > 0u ? cnt : 1u;
}

__device__ __forceinline__ void xcd_barrier(const XcdBarrier& b) {
    asm volatile("s_waitcnt vmcnt(0)" ::: "memory");
    __syncthreads();
    if (threadIdx.x == 0) {
        unsigned* bar = b.bar;
        __builtin_amdgcn_s_waitcnt(0);
        unsigned nloc = b.st[0], nx = b.st[1];
        if (nloc == 0u) { xcd_barrier_complete(bar, b.x, nloc, nx); b.st[0] = nloc; b.st[1] = nx; }
        const unsigned old = xb_add(&bar[XB_XSUB(b.x)], 1u);
        const unsigned gen = old / nloc;
        if (old + 1u == (gen + 1u) * nloc) {
            __builtin_amdgcn_fence(__ATOMIC_RELEASE, "agent");
            asm volatile("s_waitcnt vmcnt(0)" ::: "memory");
            const unsigned og = xb_add(&bar[XB_TOP], 1u);
            const unsigned tg = og / nx;
            if (og + 1u == (tg + 1u) * nx) xb_add(&bar[XB_TOPGEN], 1u);
            else XB_SPIN(xb_ld(&bar[XB_TOPGEN]) == tg, bar);
            __builtin_amdgcn_fence(__ATOMIC_ACQUIRE, "agent");
            xb_add(&bar[XB_XGEN(b.x)], 1u);
            asm volatile("s_waitcnt vmcnt(0)" ::: "memory");
        } else {
            XB_SPIN(xb_ld(&bar[XB_XGEN(b.x)]) == gen, bar);
            __builtin_amdgcn_fence(__ATOMIC_ACQUIRE, "agent");
            asm volatile("s_waitcnt vmcnt(0)" ::: "memory");
        }
    }
    __syncthreads();
}

struct Params { const float* in[16]; float* out; unsigned char* ws; int lo, hi, coop, pad; };

__global__ void __launch_bounds__(512, 2) mk_fwd(Params P) {
    extern __shared__ __attribute__((aligned(16))) unsigned char lds_raw[];
    LAS unsigned char* lds = (LAS unsigned char*)lds_raw;
    const int G = gridDim.x, NGW = G * 8;
#define PHASE_IDS() int tid_l = threadIdx.x; asm volatile("" : "+v"(tid_l)); const int tid = tid_l, lane = tid & 63; const int wave = __builtin_amdgcn_readfirstlane(tid >> 6); const int gw = blockIdx.x * 8 + wave; (void)lane; (void)gw
    unsigned char* ws = P.ws; float* out = P.out;
    const float *x_p = P.in[0], *x_s = P.in[1], *c_ckv = P.in[2], *c_kpe = P.in[3], *c_kb = P.in[4], *c_vb = P.in[5], *w_in = P.in[6], *g_mix = P.in[7], *g_cq = P.in[8],
                *w_uq = P.in[9], *g_ckv = P.in[10], *w_uk = P.in[11], *w_uv = P.in[12], *relb = P.in[13], *w_out = P.in[14], *g_fin = P.in[15];
    unsigned* ctl = (unsigned*)(ws + WS_CTL); float* rope = (float*)(ws + WS_ROPE);
    bf16_t *Win = (bf16_t*)(ws + WS_WIN), *Wuq = (bf16_t*)(ws + WS_WUQ), *Wukv = (bf16_t*)(ws + WS_WUKV), *Wout = (bf16_t*)(ws + WS_WOUT), *XN = (bf16_t*)(ws + WS_XN),
           *ZCQ = (bf16_t*)(ws + WS_ZCQ), *CQ = (bf16_t*)(ws + WS_CQ), *CKV = (bf16_t*)(ws + WS_CKV), *KPE = (bf16_t*)(ws + WS_KPE), *SG = (bf16_t*)(ws + WS_SG),
           *QB = (bf16_t*)(ws + WS_QB), *KVB = (bf16_t*)(ws + WS_KVB), *QM = (bf16_t*)(ws + WS_QM), *KVM = (bf16_t*)(ws + WS_KVM), *Y = (bf16_t*)(ws + WS_Y);
    float* ZCKV = (float*)(ws + WS_ZCKV);
    const int lo = P.lo, hi = P.hi;
#ifndef MK_PHMASK
#define MK_PHMASK 0xff
#endif
#define PH(k) (((MK_PHMASK >> (k)) & 1) && lo <= (k) && (k) < hi)
#ifndef MK_REP
#define MK_REP -1
#endif
#define REP(k) for (int rep_ = 0; rep_ < ((MK_REP) == (k) ? 2 : 1); ++rep_)
    { volatile LAS unsigned* misc = (volatile LAS unsigned*)(lds + LDS_RING + 32); if (threadIdx.x < 2) misc[threadIdx.x] = 0u; __syncthreads(); }
    const XcdBarrier xbar = xcd_barrier_post(ctl + 1024, (volatile LAS unsigned*)(lds + LDS_RING + 32));
#define SEAM(k) do { if (PH(k) && PH((k) + 1)) { if (P.coop == 2) cg::this_grid().sync(); else xcd_barrier(xbar); } } while (0)

    if (PH(0)) REP(0) {
        PHASE_IDS();
        LAS float* scr = (LAS float*)(lds + wave * 8448);
        for (int it = gw; it < 96 * 16; it += NGW) { const int ng = it / 16, kb = it % 16; tr_item(w_in, IN_W, win_src(ng), 1024, Win, 32 * ng, 64 * kb, scr, lane); }
        for (int mb = gw * 4; mb < M1; mb += NGW * 4) xn_rows4(mb, x_p, x_s, g_mix, XN, lane);
        const int gt = blockIdx.x * 512 + tid, NGT = G * 512;
        for (int i = gt; i < (PAST + TS) * 16; i += NGT) rope_entry(rope, i >> 4, i & 15);
    }
    SEAM(0);
#ifdef MK_XSYNC
    for (int i_ = 0; i_ < MK_XSYNC; ++i_) xcd_barrier(xbar);
#endif
    if (PH(1)) REP(1) {
        pg8::Gemm g{XN, Win, M1, NIN, 1024}; pg8::StaticOrder S; S.init(M1, NIN, G, (int)blockIdx.x);
        EpiG1 E{ZCQ, KPE, SG, QB, KVB, ZCKV, out, rope};
        pg8::gemm_phase<EpiG1, pg8::StaticOrder, true, true>(lds, g, S, E);
        {   PHASE_IDS();
            const int nlast = (M1 / 256 * (NIN / 256)) % G;
            const int nsb = (nlast > 0 && nlast * 2 < G) ? nlast : 0;
            if ((int)blockIdx.x >= nsb) {
                LAS float* scr = (LAS float*)(lds + wave * 8448);
                const int gwp = ((int)blockIdx.x - nsb) * 8 + wave, NGWP = (G - nsb) * 8;
                constexpr int I_UQ = 24 * 4, I_UKV = 32 * 2, I_OUT = 32 * 16, I_TOT = I_UQ + I_UKV + I_OUT;
                for (int it = gwp; it < I_TOT; it += NGWP) {
                    int r = it;
                    if (r < I_UQ) { const int ng = r / 4, kb = r % 4; const int src = ng < 16 ? (ng >> 1) * 96 + 32 * (ng & 1) : (ng - 16) * 96 + 64; tr_item(w_uq, 768, src, 256, Wuq, 32 * ng, 64 * kb, scr, lane); continue; } r -= I_UQ;
                    if (r < I_UKV) { const int ng = r / 2, kb = r % 2; tr_item(ng < 16 ? w_uk : w_uv, 512, 32 * (ng & 15), 128, Wukv, 32 * ng, 64 * kb, scr, lane); continue; } r -= I_UKV;
                    { const int ng = r / 16, kb = r % 16; tr_item(w_out, 1024, 32 * ng, 1024, Wout, 32 * ng, 64 * kb, scr, lane); }
                }
                const int gt = ((int)blockIdx.x - nsb) * 512 + tid, NGT = (G - nsb) * 512;
#pragma unroll 4
        for (int i = gt; i < NB * PAST * 32; i += NGT) { const int r = i >> 5, c = (i & 31) * 4; const int bb = r >> 12, p = r & 4095;
            const f32x4 v = __builtin_nontemporal_load((const f32x4*)(c_ckv + (size_t)r * 128 + c)); u32x2 w; w.x = pk_bf16(v[0], v[1]); w.y = pk_bf16(v[2], v[3]);
            *(u32x2*)(CKV + (size_t)(MP + bb * KVS + p) * 128 + c) = w; }
        for (int i = gt; i < NB * PAST * 8; i += NGT) { const int r = i >> 3, c = (i & 7) * 4; const int bb = r >> 12, p = r & 4095;
            const f32x4 v = __builtin_nontemporal_load((const f32x4*)(c_kpe + (size_t)r * 32 + c)); u32x2 w; w.x = pk_bf16(v[0], v[1]); w.y = pk_bf16(v[2], v[3]);
            *(u32x2*)(KPE + (size_t)(MP + bb * KVS + p) * 32 + c) = w; }
#pragma unroll 2
        for (int i = gt; i < NB * 512 * 128; i += NGT) { const int r = i >> 7, c = (i & 127) * 4; const int bb = r >> 9, p = r & 511;
            const f32x4 kv = __builtin_nontemporal_load((const f32x4*)(c_kb + (size_t)r * 512 + c)), vv = __builtin_nontemporal_load((const f32x4*)(c_vb + (size_t)r * 512 + c));
            u32x2 w; w.x = pk_bf16(kv[0], kv[1]); w.y = pk_bf16(kv[2], kv[3]); bf16_t* d = KVB + (size_t)(MP + bb * BVS + p) * 1024 + c; *(u32x2*)d = w;
            w.x = pk_bf16(vv[0], vv[1]); w.y = pk_bf16(vv[2], vv[3]); *(u32x2*)(d + 512) = w; }
        for (int i = gt; i < NB * 32 * 32; i += NGT) { const int r = i >> 5, c = (i & 31) * 4; *(u32x2*)(CKV + (size_t)(MP + (r >> 5) * KVS + PAST + 32 + (r & 31)) * 128 + c) = (u32x2){0u, 0u}; }
        for (int i = gt; i < NB * 32 * 8; i += NGT) { const int r = i >> 3, c = (i & 7) * 4; *(u32x2*)(KPE + (size_t)(MP + (r >> 5) * KVS + PAST + 32 + (r & 31)) * 32 + c) = (u32x2){0u, 0u}; }
        for (int i = gt; i < NB * 32 * 256; i += NGT) { const int r = i >> 8, c = (i & 255) * 4; *(u32x2*)(KVB + (size_t)(MP + (r >> 5) * BVS + 512 + 32 + (r & 31)) * 1024 + c) = (u32x2){0u, 0u}; }
            }
        }
    }
    SEAM(1);
    if (PH(2)) REP(2) {
        PHASE_IDS();
        for (int mb = gw * 4; mb < M1; mb += NGW * 4) {
            u32x2 wq[4]; f32x2 vk[4];
#pragma unroll
            for (int q = 0; q < 4; ++q) { wq[q] = __builtin_nontemporal_load((const u32x2*)(ZCQ + (size_t)(mb + q) * 256 + 4 * lane)); vk[q] = __builtin_nontemporal_load((const f32x2*)(ZCKV + (size_t)(mb + q) * 128 + 2 * lane)); }
            const f32x4 gq = *(const f32x4*)(g_cq + 4 * lane); const f32x2 gk = *(const f32x2*)(g_ckv + 2 * lane);
#pragma unroll
            for (int q = 0; q < 4; ++q) { const int m = mb + q;
                f32x4 v = {bf_lo(wq[q].x), bf_hi(wq[q].x), bf_lo(wq[q].y), bf_hi(wq[q].y)};
                const float rq = 1.0f / sqrtf(wave_sum((v[0] * v[0] + v[1] * v[1]) + (v[2] * v[2] + v[3] * v[3])) * (1.0f / 256.0f) + EPS);
                v = v * rq * gq; u32x2 o; o.x = pk_bf16(v[0], v[1]); o.y = pk_bf16(v[2], v[3]); *(u32x2*)(CQ + (size_t)m * 256 + 4 * lane) = o;
                f32x2 k = vk[q];
                const float rk = 1.0f / sqrtf(wave_sum(k[0] * k[0] + k[1] * k[1]) * (1.0f / 128.0f) + EPS);
                k = k * rk * gk;
                float* po = (m < MP) ? out + O_CKVP + (size_t)m * 128 : out + O_CKVS + (size_t)(m - MP) * 128; *(f32x2*)(po + 2 * lane) = k;
                *(unsigned*)(CKV + (size_t)kvrow_m(m) * 128 + 2 * lane) = pk_bf16(k[0], k[1]); }
        }
    }
    SEAM(2);
    if (PH(3)) REP(3) {
        { pg8::Gemm g{CQ, Wuq, M1, 768, 256}; pg8::StaticOrder S; S.init(M1, 768, G, (int)blockIdx.x); EpiG2 E{QM, rope};
          pg8::gemm_phase<EpiG2, pg8::StaticOrder, true, true>(lds, g, S, E); }
    }
    if (PH(4)) REP(4) {
        { pg8::Gemm g{CKV, Wukv, KVR, 1024, 128}; SkewOrder S; S.init(KVR, 1024, G, (int)blockIdx.x, (KVR / 256 * 4) / G, (M1 / 256 * 3) % G);
          EpiPlain E{KVM, 1024};
          pg8::gemm_phase<EpiPlain, SkewOrder, true, true>(lds, g, S, E); }
    }
    SEAM(4);
    if (PH(5)) REP(5) {
        PHASE_IDS();
        const at::Tens T{QM, QB, KVM, KVB, KPE, SG, Y, relb};
        LAS volatile unsigned* sidx = (LAS volatile unsigned*)(lds + at::L_IDX);
        unsigned nxt = 0; if (tid == 0) nxt = atomicAdd(ctl + rep_, 1u);
        for (;;) {
            if (tid == 0) sidx[0] = nxt;
            __syncthreads();
            const int idx = (int)sidx[0];
            if (idx >= at::NU_TOT) break;
            if (tid == 0) nxt = atomicAdd(ctl + rep_, 1u);
            if (idx >= at::IDX_G4S && idx < at::IDX_G4S + at::NU_G4S) {
                if (tid == 0) { unsigned sp = 0; while (__hip_atomic_load(ctl + 2, __ATOMIC_RELAXED, __HIP_MEMORY_SCOPE_AGENT) < 128u) { __builtin_amdgcn_s_sleep(4); if (++sp > (1u << 22)) break; }
                    __builtin_amdgcn_fence(__ATOMIC_ACQUIRE, "agent"); asm volatile("s_waitcnt vmcnt(0)" ::: "memory"); }
                __syncthreads();
                pg8::Gemm g{Y, Wout, M1, 1024, 1024}; OneUnit S1{MP / 256, idx - at::IDX_G4S}; EpiG4 E{x_p, x_s, out, (bf16_t*)(ws + WS_X1), (float*)(ws + WS_SSQ)};
                pg8::gemm_phase<EpiG4, OneUnit, false, true>(lds, g, S1, E);
                continue;
            }
            at::run_unit(T, idx, lds);
            if (idx < at::NU_MS + at::NU_BS) {
                asm volatile("s_waitcnt vmcnt(0)" ::: "memory"); __syncthreads();
                if (tid == 0) { __builtin_amdgcn_fence(__ATOMIC_RELEASE, "agent"); asm volatile("s_waitcnt vmcnt(0)" ::: "memory"); __hip_atomic_fetch_add(ctl + 2, 1u, __ATOMIC_RELAXED, __HIP_MEMORY_SCOPE_AGENT); }
            }
        }
    }
    SEAM(5);
    if (PH(6)) REP(6) {
        pg8::Gemm g{Y, Wout, MP, 1024, 1024}; pg8::StaticOrder S; S.init(MP, 1024, G, (int)blockIdx.x); EpiG4 E{x_p, x_s, out, (bf16_t*)(ws + WS_X1), (float*)(ws + WS_SSQ)};
        pg8::gemm_phase<EpiG4, pg8::StaticOrder, true, true>(lds, g, S, E);
    }
    SEAM(6);
    if (PH(7)) {
        PHASE_IDS();
        const bf16_t* X1 = (const bf16_t*)(ws + WS_X1); const float* SSQ = (const float*)(ws + WS_SSQ);
        for (int mb = gw * 4; mb < MP; mb += NGW * 4) {
            float sp[4]; u32x4 w[4][2];
#pragma unroll
            for (int q = 0; q < 4; ++q) { sp[q] = lane < 16 ? SSQ[(size_t)(mb + q) * 16 + lane] : 0.f;
#pragma unroll
                for (int j = 0; j < 2; ++j) w[q][j] = __builtin_nontemporal_load((const u32x4*)(X1 + (size_t)(mb + q) * DM + 8 * lane + 512 * j)); }
#pragma unroll
            for (int q = 0; q < 4; ++q) sp[q] = 1.0f / sqrtf(wave_sum(sp[q]) * (1.0f / DM) + EPS);
#pragma unroll
            for (int j = 0; j < 2; ++j) { const int c = 8 * lane + 512 * j; const f32x4 g0 = *(const f32x4*)(g_fin + c), g1 = *(const f32x4*)(g_fin + c + 4);
#pragma unroll
                for (int q = 0; q < 4; ++q) { const u32x4 ww = w[q][j];
                    const f32x4 a = {bf_lo(ww.x), bf_hi(ww.x), bf_lo(ww.y), bf_hi(ww.y)}, b = {bf_lo(ww.z), bf_hi(ww.z), bf_lo(ww.w), bf_hi(ww.w)};
                    *(f32x4*)(out + (size_t)(mb + q) * DM + c) = a * sp[q] * g0; *(f32x4*)(out + (size_t)(mb + q) * DM + c + 4) = b * sp[q] * g1; } }
        }
        for (int m = MP + gw; m < M1; m += NGW) {
            float* xr = out + (size_t)m * DM; f32x4 v[4]; float s = 0.f;
#pragma unroll
            for (int j = 0; j < 4; ++j) { v[j] = *(const f32x4*)(xr + 4 * lane + 256 * j); s += (v[j][0] * v[j][0] + v[j][1] * v[j][1]) + (v[j][2] * v[j][2] + v[j][3] * v[j][3]); }
            const float rstd = 1.0f / sqrtf(wave_sum(s) * (1.0f / DM) + EPS);
#pragma unroll
            for (int j = 0; j < 4; ++j) { const f32x4 g = *(const f32x4*)(g_fin + 4 * lane + 256 * j); *(f32x4*)(xr + 4 * lane + 256 * j) = v[j] * rstd * g; }
        }
    }
#undef PH
#undef SEAM
}

constexpr int NPH = 8;
extern "C" void kernel_launch(void* const* d_in, const int* in_sizes, int n_in, void* d_out, int out_size, void* d_ws, size_t ws_size, hipStream_t stream) {
    static int grid = 0;
    if (grid == 0) {
        if (n_in != 16 || (size_t)out_size != O_END || ws_size < WS_END) { fprintf(stderr, "kernel_launch: unexpected shapes (n_in %d out %d ws %zu need %zu)\n", n_in, out_size, ws_size, (size_t)WS_END); grid = -1; return; }
        int dev = 0, cus = 0, per_cu = 0;
        hipGetDevice(&dev); hipDeviceGetAttribute(&cus, hipDeviceAttributeMultiprocessorCount, dev);
        hipFuncSetAttribute((const void*)mk_fwd, hipFuncAttributeMaxDynamicSharedMemorySize, LDS_TOTAL);
        hipOccupancyMaxActiveBlocksPerMultiprocessor(&per_cu, (const void*)mk_fwd, 512, LDS_TOTAL);
        (void)hipGetLastError();
        if (per_cu < 1) per_cu = 1;
        grid = cus * per_cu;
        if (grid > 256) grid = 256;
    }
    if (grid < 0) return;
    if (hipMemsetAsync(d_ws, 0, 32768, stream) != hipSuccess) { fprintf(stderr, "memset failed\n"); return; }
    Params p{};
    for (int i = 0; i < 16; ++i) p.in[i] = (const float*)d_in[i];
    p.out = (float*)d_out; p.ws = (unsigned char*)d_ws;
#if MK_COOP
    p.lo = 0; p.hi = NPH; p.coop = 1;
    void* args[] = {&p};
    hipError_t e = hipLaunchCooperativeKernel((const void*)mk_fwd, dim3(grid), dim3(512), args, LDS_TOTAL, stream);
    if (e != hipSuccess) fprintf(stderr, "cooperative launch failed: %s (grid %d)\n", hipGetErrorString(e), grid);
#else
    for (int ph = 0; ph < NPH; ++ph) { p.lo = ph; p.hi = ph + 1; p.coop = 0; hipLaunchKernelGGL(mk_fwd, dim3(grid), dim3(512), LDS_TOTAL, stream, p); }
#endif
}
```

```cpp
#include <hip/hip_runtime.h>
#include <hip/hip_bf16.h>
#include <hip/hip_cooperative_groups.h>
#include <cstdio>
#include <cstdint>
#include <type_traits>
namespace cg = cooperative_groups;
#ifndef MK_COOP
#define MK_COOP 1
#endif

namespace pg8 {
#define PG8_LAS __attribute__((address_space(3)))
typedef unsigned short bf16_t;
typedef short bf16x8 __attribute__((ext_vector_type(8)));
typedef float f32x4 __attribute__((ext_vector_type(4)));
typedef unsigned u32x4 __attribute__((ext_vector_type(4)));
constexpr int BM = 256, BK = 64, HALF = 128, HTB = HALF * BK * 2  , STAGE_BYTES = 8 * HTB, NXCD = 8, WGM = 8;

__host__ __device__ __forceinline__ int lds_byte(int r, int c) { const int st = (r >> 4) * 2 + (c >> 5), rr = r & 15, cc = c & 31, ob = rr * 64 + cc * 2; return st * 1024 + (ob ^ (((ob >> 9) & 1) << 5)); }
__host__ __device__ __forceinline__ void stage_rc(int b, int& R, int& C) { const int st = b / 1024, sb = b % 1024, swz = sb ^ (((sb >> 9) & 1) << 5); R = (st >> 1) * 16 + swz / 64; C = (st & 1) * 32 + (swz % 64) / 2; }
__host__ __device__ __forceinline__ int perm32(int rho) { const int n = rho >> 4, i = rho & 15; return 8 * (i >> 2) + 4 * n + (i & 3); }

struct Unit { int pm, pn; };
struct Gemm { const bf16_t* A; const bf16_t* Bt; int M, N, K; };

struct StaticOrder {
    int nM, nN, nwg, G, c;
    __host__ __device__ void init(int M, int N, int G_, int c_) { nM = M / BM; nN = N / BM; nwg = nM * nN; G = G_; c = c_; }
    __host__ __device__ bool next(int i, Unit& u) const {
        const long L = (long)i * G + c; if (L >= nwg) return false;
        int wgid = (int)L; { const int q = nwg / NXCD, r = nwg % NXCD, xcd = wgid % NXCD, off = wgid / NXCD; wgid = (xcd < r ? xcd * (q + 1) : r * (q + 1) + (xcd - r) * q) + off; }
        const int nig = WGM * nN, gid = wgid / nig, fm = gid * WGM, gsz = (nM - fm) < WGM ? (nM - fm) : WGM;
        u.pm = fm + ((wgid % nig) % gsz); u.pn = (wgid % nig) / gsz; return true;
    }
    __device__ __forceinline__ void a_ready(const Unit&) const {}
    __device__ __forceinline__ void done(const Unit&) const {}
};

__device__ __forceinline__ unsigned cvt_pk_bf16(float lo, float hi) { unsigned r; asm volatile("v_cvt_pk_bf16_f32 %0, %1, %2" : "=v"(r) : "v"(lo), "v"(hi)); return r; }
typedef float f32x2 __attribute__((ext_vector_type(2)));
template <class Epi, class Sched, bool ALIGN_EPI = false, bool SP2 = false>
__device__ __forceinline__ void gemm_phase(PG8_LAS unsigned char* lds, const Gemm g, const Sched& S, const Epi& E) {
    int tid_l = threadIdx.x; asm volatile("" : "+v"(tid_l));
    const int tid = tid_l, wid = __builtin_amdgcn_readfirstlane(tid >> 6), lane = tid & 63, wr = wid >> 2, wc = wid & 3, fr = lane & 15, fq = lane >> 4;
    int K_l = g.K; asm volatile("" : "+s"(K_l));
    const int K = K_l, nt = K / BK;
    unsigned voffA[2], voffB[2];
#pragma unroll
    for (int i = 0; i < 2; ++i) { int R, C; stage_rc(tid * 16 + i * 8192, R, C); const int Rb = Epi::PERM ? ((R & ~31) + perm32(R & 31)) : R;
        voffA[i] = (unsigned)(R * K + C) * 2u; voffB[i] = (unsigned)(Rb * K + C) * 2u; }
    const size_t kstep = (size_t)(BK * 2);
    const size_t hstep = (size_t)HALF * K * 2;
    const size_t tstep = 2 * hstep;
    const unsigned ldsw = (unsigned)wid * 1024u;
    const int aoff = lds_byte(wr * 64 + fr, fq * 8), boff = lds_byte(wc * 32 + fr, fq * 8);
#define PG8_SA(b, h) (((b) * 2 + (h)) * HTB)
#define PG8_SB(b, h) ((4 + (b) * 2 + (h)) * HTB)
#define PG8_STAGE(bufoff, gbase, voff) do { _Pragma("unroll") for (int _i = 0; _i < 2; ++_i) \
        __builtin_amdgcn_global_load_lds((const unsigned*)((const char*)(gbase) + (voff)[_i]), (PG8_LAS unsigned*)(lds + (bufoff) + ldsw + _i * 8192), 16, 0, 0); } while (0)
#define PG8_LDA(dst, b, h) do { _Pragma("unroll") for (int m = 0; m < 4; ++m) _Pragma("unroll") for (int k = 0; k < 2; ++k) dst[m][k] = *(const PG8_LAS bf16x8*)(lds + PG8_SA(b, h) + aoff + m * 2048 + k * 1024); } while (0)
#define PG8_LDB(dst, b, h) do { _Pragma("unroll") for (int n = 0; n < 2; ++n) _Pragma("unroll") for (int k = 0; k < 2; ++k) dst[n][k] = *(const PG8_LAS bf16x8*)(lds + PG8_SB(b, h) + boff + n * 2048 + k * 1024); } while (0)
#define PG8_MMA(ai, bj, At, Bt) do { __builtin_amdgcn_s_setprio(1); _Pragma("unroll") for (int m = 0; m < 4; ++m) _Pragma("unroll") for (int n = 0; n < 2; ++n) _Pragma("unroll") for (int k = 0; k < 2; ++k) \
        acc[ai][bj][m][n] = __builtin_amdgcn_mfma_f32_16x16x32_bf16(Bt[n][k], At[m][k], acc[ai][bj][m][n], 0, 0, 0); __builtin_amdgcn_s_setprio(0); } while (0)
#define PG8_WAIT_V(n) asm volatile("s_waitcnt vmcnt(" #n ")" ::: "memory")
#define PG8_WAIT_L(n) asm volatile("s_waitcnt lgkmcnt(" #n ")" ::: "memory")
#define PG8_BAR __builtin_amdgcn_s_barrier()
#define PG8_SCHED __builtin_amdgcn_sched_barrier(0)
    Unit cur, nxt; int ui = 0;
    if (!S.next(0, cur)) return;
    f32x4 acc[2][2][4][2];
#pragma unroll
    for (int a = 0; a < 2; ++a)
#pragma unroll
        for (int b = 0; b < 2; ++b)
#pragma unroll
            for (int m = 0; m < 4; ++m)
#pragma unroll
                for (int n = 0; n < 2; ++n) acc[a][b][m][n] = (f32x4){0.f, 0.f, 0.f, 0.f};
    bf16x8 At[4][2], B0[2][2], B1[2][2];
    const char* cA = (const char*)g.A + (size_t)cur.pm * tstep; const char* cB = (const char*)g.Bt + (size_t)cur.pn * tstep;
    S.a_ready(cur);
    if constexpr (SP2) {
        PG8_STAGE(PG8_SB(0, 0), cB, voffB); PG8_STAGE(PG8_SB(0, 1), cB + hstep, voffB); PG8_STAGE(PG8_SA(0, 0), cA, voffA); PG8_STAGE(PG8_SA(0, 1), cA + hstep, voffA);
        if (wr == 1) PG8_BAR;
        PG8_WAIT_V(2); PG8_BAR;
        PG8_STAGE(PG8_SB(1, 0), cB + kstep, voffB); PG8_STAGE(PG8_SA(1, 0), cA + kstep, voffA); PG8_STAGE(PG8_SB(1, 1), cB + hstep + kstep, voffB);
        PG8_WAIT_V(6); PG8_BAR;
    } else {
        PG8_STAGE(PG8_SB(0, 0), cB, voffB); PG8_STAGE(PG8_SA(0, 0), cA, voffA); PG8_STAGE(PG8_SB(0, 1), cB + hstep, voffB); PG8_STAGE(PG8_SA(0, 1), cA + hstep, voffA);
        if (wr == 1) PG8_BAR;
        PG8_WAIT_V(4); PG8_BAR;
        PG8_STAGE(PG8_SB(1, 0), cB + kstep, voffB); PG8_STAGE(PG8_SA(1, 0), cA + kstep, voffA); PG8_STAGE(PG8_SB(1, 1), cB + hstep + kstep, voffB);
        PG8_WAIT_V(6); PG8_BAR;
    }
    for (;;) {
        const bool has_next = S.next(ui + 1, nxt);
        const char* nA = has_next ? (const char*)g.A + (size_t)nxt.pm * tstep : cA; const char* nB = has_next ? (const char*)g.Bt + (size_t)nxt.pn * tstep : cB;
        for (int t = 0; t < nt; t += 2) {
            const bool last = (t == nt - 2);
            const char* a1 = cA + (size_t)(t + 1) * kstep;
            const char* a2 = last ? nA : cA + (size_t)(t + 2) * kstep; const char* b2 = last ? nB : cB + (size_t)(t + 2) * kstep;
            const char* a3 = a2 + kstep; const char* b3 = b2 + kstep;
            if (last && has_next) S.a_ready(nxt);
            if constexpr (SP2) {
            PG8_LDB(B0, 0, 0); PG8_LDB(B1, 0, 1); PG8_SCHED; PG8_LDA(At, 0, 0); PG8_STAGE(PG8_SA(1, 1), a1 + hstep, voffA);
            PG8_WAIT_V(8); PG8_WAIT_L(0); PG8_BAR; PG8_MMA(0, 0, At, B0); PG8_MMA(0, 1, At, B1); PG8_BAR; PG8_SCHED;
            PG8_LDA(At, 0, 1); PG8_STAGE(PG8_SB(0, 0), b2, voffB); PG8_STAGE(PG8_SB(0, 1), b2 + hstep, voffB); PG8_STAGE(PG8_SA(0, 0), a2, voffA);
            PG8_WAIT_V(8); PG8_WAIT_L(0); PG8_BAR; PG8_MMA(1, 0, At, B0); PG8_MMA(1, 1, At, B1); PG8_BAR; PG8_SCHED;
            PG8_LDB(B0, 1, 0); PG8_LDB(B1, 1, 1); PG8_SCHED; PG8_LDA(At, 1, 0); PG8_STAGE(PG8_SA(0, 1), a2 + hstep, voffA);
            PG8_WAIT_V(8); PG8_WAIT_L(0); PG8_BAR; PG8_MMA(0, 0, At, B0); PG8_MMA(0, 1, At, B1); PG8_BAR; PG8_SCHED;
            PG8_LDA(At, 1, 1); PG8_STAGE(PG8_SB(1, 0), b3, voffB); PG8_STAGE(PG8_SB(1, 1), b3 + hstep, voffB); PG8_STAGE(PG8_SA(1, 0), a3, voffA);
            PG8_WAIT_V(8); PG8_WAIT_L(0); PG8_BAR; PG8_MMA(1, 0, At, B0); PG8_MMA(1, 1, At, B1); PG8_BAR; PG8_SCHED;
            } else {
            PG8_LDB(B0, 0, 0); PG8_SCHED; PG8_LDA(At, 0, 0); PG8_STAGE(PG8_SA(1, 1), a1 + hstep, voffA);
            PG8_WAIT_L(8); PG8_BAR; PG8_WAIT_L(0); PG8_MMA(0, 0, At, B0); PG8_BAR; PG8_SCHED;
            PG8_LDB(B1, 0, 1); PG8_STAGE(PG8_SB(0, 0), b2, voffB);
            PG8_BAR; PG8_WAIT_L(0); PG8_MMA(0, 1, At, B1); PG8_BAR;
            PG8_LDA(At, 0, 1); PG8_STAGE(PG8_SA(0, 0), a2, voffA);
            PG8_BAR; PG8_WAIT_L(0); PG8_MMA(1, 0, At, B0); PG8_BAR; PG8_SCHED;
            PG8_STAGE(PG8_SB(0, 1), b2 + hstep, voffB);
            PG8_WAIT_V(6); PG8_BAR; PG8_MMA(1, 1, At, B1); PG8_BAR;
            PG8_LDB(B0, 1, 0); PG8_SCHED; PG8_LDA(At, 1, 0); PG8_STAGE(PG8_SA(0, 1), a2 + hstep, voffA);
            PG8_WAIT_L(8); PG8_BAR; PG8_WAIT_L(0); PG8_MMA(0, 0, At, B0); PG8_BAR; PG8_SCHED;
            PG8_LDB(B1, 1, 1); PG8_STAGE(PG8_SB(1, 0), b3, voffB);
            PG8_BAR; PG8_WAIT_L(0); PG8_MMA(0, 1, At, B1); PG8_BAR;
            PG8_LDA(At, 1, 1); PG8_STAGE(PG8_SA(1, 0), a3, voffA);
            PG8_BAR; PG8_WAIT_L(0); PG8_MMA(1, 0, At, B0); PG8_BAR; PG8_SCHED;
            PG8_STAGE(PG8_SB(1, 1), b3 + hstep, voffB);
            PG8_WAIT_V(6); PG8_BAR; PG8_MMA(1, 1, At, B1); PG8_BAR;
            }
        }
        if constexpr (ALIGN_EPI) { if (wr == 0) PG8_BAR; }
        if constexpr (!Epi::AFTER_DRAIN) { E(acc, cur, wr, wc, fr, fq); S.done(cur); }
        if (!has_next) break;
#pragma unroll
        for (int a = 0; a < 2; ++a)
#pragma unroll
            for (int b = 0; b < 2; ++b)
#pragma unroll
                for (int m = 0; m < 4; ++m)
#pragma unroll
                    for (int n = 0; n < 2; ++n) acc[a][b][m][n] = (f32x4){0.f, 0.f, 0.f, 0.f};
        cur = nxt; cA = nA; cB = nB; ++ui;
        if constexpr (ALIGN_EPI) { if (wr == 1) PG8_BAR; }
    }
    PG8_WAIT_V(0);
    if constexpr (!ALIGN_EPI) { if (wr == 0) PG8_BAR; }
    PG8_BAR;
    if constexpr (Epi::AFTER_DRAIN) { E.fused(acc, cur, wr, wc, fr, fq, lds, wid, lane); S.done(cur); }
#undef PG8_SA
#undef PG8_SB
#undef PG8_STAGE
#undef PG8_LDA
#undef PG8_LDB
#undef PG8_MMA
#undef PG8_WAIT_V
#undef PG8_WAIT_L
#undef PG8_BAR
#undef PG8_SCHED
}
}

#define LAS __attribute__((address_space(3)))
typedef unsigned short bf16_t;
typedef short bf16x8 __attribute__((ext_vector_type(8)));
typedef short s16x4 __attribute__((ext_vector_type(4)));
typedef float f32x4 __attribute__((ext_vector_type(4)));
typedef float f32x2 __attribute__((ext_vector_type(2)));
typedef float f32x16 __attribute__((ext_vector_type(16)));
typedef unsigned u32x4 __attribute__((ext_vector_type(4)));
typedef unsigned u32x2 __attribute__((ext_vector_type(2)));

constexpr int DM = 1024, SEQ = 4096, NB = 8, TS = 32, PAST = 4096;
constexpr int MP = NB * SEQ, MS = NB * TS, M1 = MP + MS;
constexpr int KVS = PAST + 64, KVR = MP + NB * KVS;
constexpr int BVS = 512 + 64, BVR = MP + NB * BVS;
constexpr int NIN = 3072;
constexpr float EPS = 1e-6f, LOG2E = 1.4426950408889634f;
constexpr float QS_MLA = 0.10206207261596575f * LOG2E;
constexpr float QS_B = 0.125f * LOG2E;
constexpr int OFF_CQ = 0, OFF_CKV = 256, OFF_KR = 384, OFF_GA = 416, OFF_QB = 928, OFF_KB = 1440, OFF_VB = 1952, OFF_GB = 2464, IN_W = 2976;
constexpr size_t O_YP = 0, O_YS = O_YP + (size_t)MP * DM, O_CKVP = O_YS + (size_t)MS * DM, O_KPEP = O_CKVP + (size_t)MP * 128,
                 O_KBP = O_KPEP + (size_t)MP * 32, O_VBP = O_KBP + (size_t)NB * 512 * 512, O_CKVS = O_VBP + (size_t)NB * 512 * 512,
                 O_KPES = O_CKVS + (size_t)MS * 128, O_KBS = O_KPES + (size_t)MS * 32, O_VBS = O_KBS + (size_t)MS * 512, O_END = O_VBS + (size_t)MS * 512;
constexpr size_t al256(size_t x) { return (x + 255) & ~(size_t)255; }
constexpr size_t WS_CTL = 0, WS_ROPE = 32768, WS_WIN = al256(WS_ROPE + (size_t)(PAST + TS) * 32 * 4), WS_WUQ = WS_WIN + (size_t)NIN * 1024 * 2,
                 WS_WUKV = WS_WUQ + (size_t)768 * 256 * 2, WS_WOUT = WS_WUKV + (size_t)1024 * 128 * 2, WS_XN = WS_WOUT + (size_t)1024 * 1024 * 2,
                 WS_CQ = WS_XN + (size_t)M1 * 1024 * 2, WS_CKV = WS_CQ + (size_t)M1 * 256 * 2, WS_KPE = WS_CKV + (size_t)KVR * 128 * 2,
                 WS_SG = WS_KPE + (size_t)KVR * 32 * 2, WS_QB = WS_SG + (size_t)M1 * 1024 * 2, WS_KVB = WS_QB + (size_t)M1 * 512 * 2,
                 WS_QM = WS_KVB + (size_t)BVR * 1024 * 2, WS_KVM = WS_QM + (size_t)M1 * 768 * 2, WS_END = WS_KVM + (size_t)KVR * 1024 * 2;
constexpr size_t WS_Y = WS_XN;
constexpr size_t WS_ZCQ = WS_QM, WS_ZCKV = WS_QM + (size_t)M1 * 256 * 2;
static_assert(WS_ZCKV + (size_t)M1 * 128 * 4 <= WS_KVM, "overlay");
constexpr size_t WS_X1 = WS_KVM, WS_SSQ = WS_QM;

constexpr int LDS_RING = 131072, LDS_TOTAL = LDS_RING + 1024;

__device__ __forceinline__ unsigned pk_bf16(float lo, float hi) { f32x2 v = {lo, hi}; typedef __bf16 bf2 __attribute__((ext_vector_type(2))); bf2 b = __builtin_convertvector(v, bf2); return __builtin_bit_cast(unsigned, b); }
__device__ __forceinline__ float bf_lo(unsigned w) { return __builtin_bit_cast(float, w << 16); }
__device__ __forceinline__ float bf_hi(unsigned w) { return __builtin_bit_cast(float, w & 0xffff0000u); }
__device__ __forceinline__ u32x4 pk8(const f32x4 a, const f32x4 b) { u32x4 w; w.x = pk_bf16(a[0], a[1]); w.y = pk_bf16(a[2], a[3]); w.z = pk_bf16(b[0], b[1]); w.w = pk_bf16(b[2], b[3]); return w; }
__device__ __forceinline__ float wave_sum(float v) {
#pragma unroll
    for (int o = 1; o < 64; o <<= 1) v += __shfl_xor(v, o);
    return v;
}
__device__ __forceinline__ int kvrow_m(int row) { if (row < MP) return row; const int r = row - MP; return MP + (r >> 5) * KVS + PAST + (r & 31); }
__device__ __forceinline__ int kvrow_b(int row) { if (row < MP) return row; const int r = row - MP; return MP + (r >> 5) * BVS + 512 + (r & 31); }
__device__ __forceinline__ int pos_of(int row) { if (row < MP) return row & (SEQ - 1); return PAST + ((row - MP) & 31); }

__device__ __forceinline__ void rope8(f32x4& v0, f32x4& v1, const float* rp  , int fq) {
    const int i0 = 8 * (fq & 1);
    const f32x4 c0 = *(const f32x4*)(rp + i0), c1 = *(const f32x4*)(rp + i0 + 4), s0 = *(const f32x4*)(rp + 16 + i0), s1 = *(const f32x4*)(rp + 16 + i0 + 4);
    f32x4 p0, p1;
#pragma unroll
    for (int j = 0; j < 4; ++j) { p0[j] = __shfl_xor(v0[j], 32); p1[j] = __shfl_xor(v1[j], 32); }
    if (fq < 2) { v0 = v0 * c0 - p0 * s0; v1 = v1 * c1 - p1 * s1; }
    else        { v0 = p0 * s0 + v0 * c0; v1 = p1 * s1 + v1 * c1; }
}
__device__ __forceinline__ float silu_f(float g) { return g * __builtin_amdgcn_rcpf(1.0f + __builtin_amdgcn_exp2f(-g * LOG2E)); }

struct EpiG1 {
    static constexpr bool PERM = true, AFTER_DRAIN = false;
    bf16_t *zcq, *kpe, *sg, *qb, *kvb; float* zckv; float* out; const float* rope;
    __device__ __forceinline__ void operator()(const f32x4 (&acc)[2][2][4][2], const pg8::Unit& u, int wr, int wc, int fr, int fq) const {
        const int pn = u.pn, row0 = u.pm * 256 + wr * 64 + fr, cl = wc * 32 + 8 * fq;
        if (pn == 0) {
#pragma unroll
            for (int ai = 0; ai < 2; ++ai)
#pragma unroll
                for (int m = 0; m < 4; ++m) { const int row = row0 + ai * 128 + m * 16;
#pragma unroll
                    for (int bj = 0; bj < 2; ++bj) *(u32x4*)(zcq + (size_t)row * 256 + bj * 128 + cl) = pk8(acc[ai][bj][m][0], acc[ai][bj][m][1]); }
        } else if (pn == 1) {
#pragma unroll
            for (int ai = 0; ai < 2; ++ai)
#pragma unroll
                for (int m = 0; m < 4; ++m) { const int row = row0 + ai * 128 + m * 16; float* p = zckv + (size_t)row * 128 + cl;
                    *(f32x4*)p = acc[ai][0][m][0]; *(f32x4*)(p + 4) = acc[ai][0][m][1]; }
            if (wc == 0) {
#pragma unroll
                for (int ai = 0; ai < 2; ++ai)
#pragma unroll
                    for (int m = 0; m < 4; ++m) { const int row = row0 + ai * 128 + m * 16; f32x4 v0 = acc[ai][1][m][0], v1 = acc[ai][1][m][1];
                        rope8(v0, v1, rope + (size_t)pos_of(row) * 32, fq);
                        float* po = (row < MP) ? out + O_KPEP + (size_t)row * 32 + 8 * fq : out + O_KPES + (size_t)(row - MP) * 32 + 8 * fq;
                        *(f32x4*)po = v0; *(f32x4*)(po + 4) = v1;
                        *(u32x4*)(kpe + (size_t)kvrow_m(row) * 32 + 8 * fq) = pk8(v0, v1); asm volatile("" ::: "memory"); }
            }
        } else if (pn < 6) {
            const int cb = (pn - 2) * 256 + cl;
#pragma unroll
            for (int ai = 0; ai < 2; ++ai)
#pragma unroll
                for (int m = 0; m < 4; ++m) { const int row = row0 + ai * 128 + m * 16;
#pragma unroll
                    for (int bj = 0; bj < 2; ++bj) { f32x4 a = acc[ai][bj][m][0], b = acc[ai][bj][m][1];
#pragma unroll
                        for (int j = 0; j < 4; ++j) { a[j] = silu_f(a[j]); b[j] = silu_f(b[j]); }
                        *(u32x4*)(sg + (size_t)row * 1024 + cb + bj * 128) = pk8(a, b); } }
        } else if (pn < 8) {
            const int cb = (pn - 6) * 256 + cl;
#pragma unroll
            for (int ai = 0; ai < 2; ++ai)
#pragma unroll
                for (int m = 0; m < 4; ++m) { const int row = row0 + ai * 128 + m * 16;
#pragma unroll
                    for (int bj = 0; bj < 2; ++bj) *(u32x4*)(qb + (size_t)row * 512 + cb + bj * 128) = pk8(acc[ai][bj][m][0] * QS_B, acc[ai][bj][m][1] * QS_B); }
        } else if (pn < 12) {
            const int cb = (pn - 8) * 256 + cl;
            const bool isv = pn >= 10; const int co = cb - (isv ? 512 : 0);
#pragma unroll
            for (int ai = 0; ai < 2; ++ai)
#pragma unroll
                for (int m = 0; m < 4; ++m) { const int row = row0 + ai * 128 + m * 16;
                    float* po = nullptr;
                    if (row < MP) { const int s = row & (SEQ - 1); if (s >= SEQ - 512) po = out + (isv ? O_VBP : O_KBP) + ((size_t)(row >> 12) * 512 + (s - (SEQ - 512))) * 512 + co; }
                    else po = out + (isv ? O_VBS : O_KBS) + (size_t)(row - MP) * 512 + co;
                    bf16_t* pk = kvb + (size_t)kvrow_b(row) * 1024 + cb;
#pragma unroll
                    for (int bj = 0; bj < 2; ++bj) { *(u32x4*)(pk + bj * 128) = pk8(acc[ai][bj][m][0], acc[ai][bj][m][1]);
                        if (po) { *(f32x4*)(po + bj * 128) = acc[ai][bj][m][0]; *(f32x4*)(po + bj * 128 + 4) = acc[ai][bj][m][1]; } } }
        }
    }
};
__device__ __forceinline__ void rope8t(f32x4& v0, f32x4& v1, const f32x4 c0, const f32x4 c1, const f32x4 s0, const f32x4 s1, int fq) {
    f32x4 p0, p1;
#pragma unroll
    for (int j = 0; j < 4; ++j) { p0[j] = __shfl_xor(v0[j], 32); p1[j] = __shfl_xor(v1[j], 32); }
    if (fq < 2) { v0 = v0 * c0 - p0 * s0; v1 = v1 * c1 - p1 * s1; }
    else        { v0 = p0 * s0 + v0 * c0; v1 = p1 * s1 + v1 * c1; }
}
struct EpiG2 {
    static constexpr bool PERM = true, AFTER_DRAIN = false;
    bf16_t* qm; const float* rope;
    __device__ __forceinline__ void operator()(const f32x4 (&acc)[2][2][4][2], const pg8::Unit& u, int wr, int wc, int fr, int fq) const {
        const int pn = u.pn, row0 = u.pm * 256 + wr * 64 + fr;
        if (pn < 2) {
#pragma unroll
            for (int ai = 0; ai < 2; ++ai)
#pragma unroll
                for (int m = 0; m < 4; ++m) { const int row = row0 + ai * 128 + m * 16;
#pragma unroll
                    for (int bj = 0; bj < 2; ++bj) { const int n = pn * 256 + bj * 128 + wc * 32 + 8 * fq; const int dc = (n >> 6) * 96 + (n & 63);
                        *(u32x4*)(qm + (size_t)row * 768 + dc) = pk8(acc[ai][bj][m][0] * QS_MLA, acc[ai][bj][m][1] * QS_MLA); } }
        } else {
            const int i0 = 8 * (fq & 1);
#pragma unroll
            for (int ai = 0; ai < 2; ++ai)
#pragma unroll
                for (int mp = 0; mp < 4; mp += 2) {
                    f32x4 c0[2], c1[2], s0[2], s1[2];
#pragma unroll
                    for (int q = 0; q < 2; ++q) { const float* rp = rope + (size_t)pos_of(row0 + ai * 128 + (mp + q) * 16) * 32 + i0;
                        c0[q] = *(const f32x4*)rp; c1[q] = *(const f32x4*)(rp + 4); s0[q] = *(const f32x4*)(rp + 16); s1[q] = *(const f32x4*)(rp + 20); }
#pragma unroll
                    for (int q = 0; q < 2; ++q) { const int m = mp + q, row = row0 + ai * 128 + m * 16;
#pragma unroll
                        for (int bj = 0; bj < 2; ++bj) { f32x4 v0 = acc[ai][bj][m][0], v1 = acc[ai][bj][m][1];
                            rope8t(v0, v1, c0[q], c1[q], s0[q], s1[q], fq);
                            *(u32x4*)(qm + (size_t)row * 768 + (bj * 4 + wc) * 96 + 64 + 8 * fq) = pk8(v0 * QS_MLA, v1 * QS_MLA); } }
                    asm volatile("" ::: "memory");
                }
        }
    }
};
struct EpiPlain {
    static constexpr bool PERM = true, AFTER_DRAIN = false;
    bf16_t* O; int ldc;
    __device__ __forceinline__ void operator()(const f32x4 (&acc)[2][2][4][2], const pg8::Unit& u, int wr, int wc, int fr, int fq) const {
        const int row0 = u.pm * 256 + wr * 64 + fr, col0 = u.pn * 256 + wc * 32 + 8 * fq;
#pragma unroll
        for (int ai = 0; ai < 2; ++ai)
#pragma unroll
            for (int m = 0; m < 4; ++m) { bf16_t* p = O + (size_t)(row0 + ai * 128 + m * 16) * ldc + col0;
#pragma unroll
                for (int bj = 0; bj < 2; ++bj) *(u32x4*)(p + bj * 128) = pk8(acc[ai][bj][m][0], acc[ai][bj][m][1]); }
    }
};
struct EpiG4 {
    static constexpr bool PERM = true, AFTER_DRAIN = false;
    const float *xp, *xs; float* out; bf16_t* x1; float* ssq;
    __device__ __forceinline__ void operator()(const f32x4 (&acc)[2][2][4][2], const pg8::Unit& u, int wr, int wc, int fr, int fq) const {
        const int row0 = u.pm * 256 + wr * 64 + fr, col0 = u.pn * 256 + wc * 32 + 8 * fq;
        if (u.pm < MP / 256) {
#pragma unroll
            for (int ai = 0; ai < 2; ++ai) {
                f32x4 xr[4][2][2];
#pragma unroll
                for (int m = 0; m < 4; ++m) { const float* px = xp + (size_t)(row0 + ai * 128 + m * 16) * 1024 + col0;
#pragma unroll
                    for (int bj = 0; bj < 2; ++bj) { xr[m][bj][0] = __builtin_nontemporal_load((const f32x4*)(px + bj * 128)); xr[m][bj][1] = __builtin_nontemporal_load((const f32x4*)(px + bj * 128 + 4)); } }
#pragma unroll
                for (int m = 0; m < 4; ++m) { const int row = row0 + ai * 128 + m * 16; bf16_t* po = x1 + (size_t)row * 1024 + col0; float s = 0.f;
#pragma unroll
                    for (int bj = 0; bj < 2; ++bj) { const f32x4 a = xr[m][bj][0] + acc[ai][bj][m][0], b = xr[m][bj][1] + acc[ai][bj][m][1];
                        s += (a[0] * a[0] + a[1] * a[1]) + (a[2] * a[2] + a[3] * a[3]) + (b[0] * b[0] + b[1] * b[1]) + (b[2] * b[2] + b[3] * b[3]);
                        *(u32x4*)(po + bj * 128) = pk8(a, b); }
                    s += __shfl_xor(s, 16); s += __shfl_xor(s, 32);
                    if (fq == 0) ssq[(size_t)row * 16 + u.pn * 4 + wc] = s; }
                asm volatile("" ::: "memory");
            }
        } else {
#pragma unroll
            for (int ai = 0; ai < 2; ++ai)
#pragma unroll
                for (int m = 0; m < 4; ++m) { const int row = row0 + ai * 128 + m * 16;
                    const float* px = xs + (size_t)(row - MP) * 1024 + col0; float* po = out + (size_t)row * 1024 + col0;
#pragma unroll
                    for (int bj = 0; bj < 2; ++bj) { const f32x4 a = *(const f32x4*)(px + bj * 128), b = *(const f32x4*)(px + bj * 128 + 4);
                        *(f32x4*)(po + bj * 128) = a + acc[ai][bj][m][0]; *(f32x4*)(po + bj * 128 + 4) = b + acc[ai][bj][m][1]; } }
        }
    }
};

struct SkewOrder {
    int nM, nN, nwg, G, c, base_rounds, c0;
    __device__ void init(int M, int N, int G_, int c_, int br, int c0_) { nM = M / 256; nN = N / 256; nwg = nM * nN; G = G_; c = c_; base_rounds = br; c0 = c0_; }
    __device__ bool next(int i, pg8::Unit& u) const {
        long L;
        if (i < base_rounds) L = (long)i * G + c;
        else { if (c < c0) return false; L = (long)base_rounds * G + (long)(i - base_rounds) * (G - c0) + (c - c0); }
        if (L >= nwg) return false;
        int wgid = (int)L; { const int q = nwg / 8, r = nwg % 8, xcd = wgid % 8, off = wgid / 8; wgid = (xcd < r ? xcd * (q + 1) : r * (q + 1) + (xcd - r) * q) + off; }
        const int nig = 8 * nN, gid = wgid / nig, fm = gid * 8, gsz = (nM - fm) < 8 ? (nM - fm) : 8;
        u.pm = fm + ((wgid % nig) % gsz); u.pn = (wgid % nig) / gsz; return true;
    }
    __device__ __forceinline__ void a_ready(const pg8::Unit&) const {}
    __device__ __forceinline__ void done(const pg8::Unit&) const {}
};
struct OneUnit {
    int pm, pn;
    __device__ __forceinline__ bool next(int i, pg8::Unit& u) const { if (i > 0) return false; u.pm = pm; u.pn = pn; return true; }
    __device__ __forceinline__ void a_ready(const pg8::Unit&) const {}
    __device__ __forceinline__ void done(const pg8::Unit&) const {}
};
#ifndef MK_E1
#define MK_E1 0
#endif
#ifndef MK_E2
#define MK_E2 0
#endif
#ifndef MK_GRP_ODD
#define MK_GRP_ODD 0
#endif
namespace at {
constexpr int KSLOT = 12288, VSLOT = 8192;
constexpr int L_K = 0, L_V = 4 * KSLOT, L_WS = L_V + 4 * VSLOT, L_OST = L_WS + 8 * 256, L_TAB = L_OST + 8 * 4096, L_IDX = L_TAB + 1296, L_END = L_IDX + 16;
static_assert(L_END <= LDS_RING, "attention LDS");
__device__ __forceinline__ int crow(int r, int hi) { return (r & 3) + 8 * (r >> 2) + 4 * hi; }
__device__ __forceinline__ void glds16(const void* gsrc, unsigned lds_dst) { unsigned keep;
    asm volatile("s_mov_b32 %0, m0\n\ts_mov_b32 m0, %2\n\ts_nop 0\n\tglobal_load_lds_dwordx4 %1, off\n\ts_mov_b32 m0, %0" : "=&s"(keep) : "v"(gsrc), "s"(lds_dst) : "memory"); }
#define AT_WAITBAR() asm volatile("s_waitcnt vmcnt(0) lgkmcnt(0)\n\ts_barrier" ::: "memory")
#define AT_BAR() asm volatile("s_waitcnt lgkmcnt(0)\n\ts_barrier" ::: "memory")
#define AT_MFMA(a, b, c) __builtin_amdgcn_mfma_f32_32x32x16_bf16(a, b, c, 0, 0, 0)

template <int NQ> __device__ __forceinline__ void kload(bf16x8* kf, LAS const char* kslot, int r32, int hi) {
    LAS const char* kb = kslot + hi * 1024 + r32 * 16;
#pragma unroll
    for (int d0 = 0; d0 < NQ; ++d0) { kf[2 * d0] = *(LAS const bf16x8*)(kb + d0 * 2048); kf[2 * d0 + 1] = *(LAS const bf16x8*)(kb + d0 * 2048 + 512); }
}
template <int NQ> __device__ __forceinline__ void qkmm(f32x16& p0, f32x16& p1, const bf16x8* kf, const bf16x8* qr, const f32x16& cinit) {
#pragma unroll
    for (int d0 = 0; d0 < NQ; ++d0) {
        if (d0 == 0) { p0 = AT_MFMA(kf[0], qr[0], cinit); p1 = AT_MFMA(kf[1], qr[0], cinit); }
        else { p0 = AT_MFMA(kf[2 * d0], qr[d0], p0); p1 = AT_MFMA(kf[2 * d0 + 1], qr[d0], p1); }
    }
}
__device__ __forceinline__ float max3f(float a, float b, float c) { float r; asm("v_max3_f32 %0, %1, %2, %3" : "=v"(r) : "v"(a), "v"(b), "v"(c)); return r; }
__device__ __forceinline__ float max2f(float a, float b) { float r; asm("v_max_f32_e32 %0, %1, %2" : "=v"(r) : "v"(a), "v"(b)); return r; }
__device__ __forceinline__ float rowmax3(const f32x16& p0, const f32x16& p1) {
    float a = max3f(p0[0], p0[1], p1[0]), b = max3f(p0[2], p0[3], p1[1]); a = max3f(a, p1[2], p1[3]);
#pragma unroll
    for (int r = 4; r < 16; r += 4) { a = max3f(a, p0[r], p0[r + 1]); b = max3f(b, p0[r + 2], p0[r + 3]); a = max3f(a, p1[r], p1[r + 1]); b = max3f(b, p1[r + 2], p1[r + 3]); }
    const float m = max2f(a, b);
    auto rr = __builtin_amdgcn_permlane32_swap(__float_as_uint(m), __float_as_uint(m), false, false);
    return max2f(__uint_as_float(rr[0]), __uint_as_float(rr[1]));
}
__device__ __forceinline__ float rowmax(const f32x16& p0, const f32x16& p1) {
    float a = fmaxf(p0[0], p1[0]);
#pragma unroll
    for (int r = 1; r < 16; ++r) a = fmaxf(a, fmaxf(p0[r], p1[r]));
    auto rr = __builtin_amdgcn_permlane32_swap(__float_as_uint(a), __float_as_uint(a), false, false);
    return fmaxf(__uint_as_float(rr[0]), __uint_as_float(rr[1]));
}
typedef short v4i16_t __attribute__((ext_vector_type(4)));
__device__ __forceinline__ s16x4 vtr(LAS const char* p) { return __builtin_bit_cast(s16x4, __builtin_amdgcn_ds_read_tr16_b64_v4i16((LAS v4i16_t*)p)); }
__device__ __forceinline__ void vload(s16x4* vf, LAS const char* vp) {
#pragma unroll
    for (int d0 = 0; d0 < 2; ++d0)
#pragma unroll
        for (int ks = 0; ks < 4; ++ks) { vf[d0 * 8 + 2 * ks] = vtr(vp + d0 * 4096 + ks * 1024); vf[d0 * 8 + 2 * ks + 1] = vtr(vp + d0 * 4096 + ks * 1024 + 512); }
}
__device__ __forceinline__ void pvm(f32x16* o, const s16x4* vf, bf16x8 pa0, bf16x8 pa1, bf16x8 pa2, bf16x8 pa3) {
#define AT_PK(d, k) (bf16x8){vf[d * 8 + 2 * k][0], vf[d * 8 + 2 * k][1], vf[d * 8 + 2 * k][2], vf[d * 8 + 2 * k][3], vf[d * 8 + 2 * k + 1][0], vf[d * 8 + 2 * k + 1][1], vf[d * 8 + 2 * k + 1][2], vf[d * 8 + 2 * k + 1][3]}
    o[0] = AT_MFMA(pa0, AT_PK(0, 0), o[0]); o[1] = AT_MFMA(pa0, AT_PK(1, 0), o[1]);
    o[0] = AT_MFMA(pa1, AT_PK(0, 1), o[0]); o[1] = AT_MFMA(pa1, AT_PK(1, 1), o[1]);
    o[0] = AT_MFMA(pa2, AT_PK(0, 2), o[0]); o[1] = AT_MFMA(pa2, AT_PK(1, 2), o[1]);
    o[0] = AT_MFMA(pa3, AT_PK(0, 3), o[0]); o[1] = AT_MFMA(pa3, AT_PK(1, 3), o[1]);
#undef AT_PK
}

struct Tens { const bf16_t *qm, *qb, *kvm, *kvb, *kpe, *sg; bf16_t* y; const float* relb; };

template <int KIND> __device__ __forceinline__ void unit(const Tens& T, int seq, int h, int u, LAS unsigned char* lds) {
    constexpr int NQ = KIND == 0 ? 6 : 4;
    int tid_l = threadIdx.x; asm volatile("" : "+v"(tid_l));
    const int tid = tid_l, lane = tid & 63, r32 = lane & 31, hi = lane >> 5; const int wid = __builtin_amdgcn_readfirstlane(tid >> 6);
    const bool samp = seq >= NB; const int b = seq & 7;
    const unsigned lds0 = (unsigned)(uintptr_t)lds;
    int qrow, T0, T1, vlo, vhi, cq; size_t kvbase; bool active = true;
    if (KIND == 0) {
        if (!samp) { qrow = b * SEQ + 256 * u + 32 * wid; kvbase = (size_t)b * SEQ; T0 = 0; T1 = 4 * u + 4; vlo = 0; vhi = 4 * u + (wid >> 1); cq = vhi; }
        else { qrow = MP + b * TS; kvbase = (size_t)MP + (size_t)b * KVS; T0 = 0; T1 = 65; vlo = 0; vhi = 64; cq = 64; active = (wid == 0); }
    } else {
        if (!samp) { qrow = b * SEQ + 256 * u + 32 * wid; kvbase = (size_t)b * SEQ; T0 = 4 * u - 8 < 0 ? 0 : 4 * u - 8; T1 = 4 * u + 4; cq = 4 * u + (wid >> 1); vlo = cq - 8 < 0 ? 0 : cq - 8; vhi = cq; }
        else { qrow = MP + b * TS; kvbase = (size_t)MP + (size_t)b * BVS; T0 = 0; T1 = 9; vlo = 0; vhi = 8; cq = 8; active = (wid == 0); }
    }
    const bf16_t* KV = (KIND == 0 ? T.kvm : T.kvb) + kvbase * 1024 + h * 64;
    const bf16_t* ksrc = KV + (size_t)lane * 1024 + wid * 8;
    const bf16_t* k2src = T.kpe + (kvbase + lane) * 32 + (wid & 3) * 8;
    const bf16_t* vsrc = KV + 512 + (size_t)(16 * (wid & 3) + (lane >> 2)) * 1024 + (wid >> 2) * 32 + (lane & 3) * 8;
    const unsigned kdst = lds0 + L_K + wid * 1024, k2dst = lds0 + L_K + (8 + (wid & 3)) * 1024, vdst = lds0 + L_V + wid * 1024;
#define AT_DMA(t, s) do { AT_DMA1(t, s); if (MK_E1) AT_DMA1(t, s); } while (0)
#define AT_DMA1(t, s) do { glds16(ksrc + (size_t)(t) * 64 * 1024, (unsigned)__builtin_amdgcn_readfirstlane(kdst + (s) * KSLOT)); \
        if (KIND == 0 && wid < 4) glds16(k2src + (size_t)(t) * 64 * 32, (unsigned)__builtin_amdgcn_readfirstlane(k2dst + (s) * KSLOT)); \
        glds16(vsrc + (size_t)(t) * 64 * 1024, (unsigned)__builtin_amdgcn_readfirstlane(vdst + (s) * VSLOT)); } while (0)
    const int grp = (MK_GRP_ODD) ? (wid & 1) : (wid >> 2);
#define AT_DMA_K(t, s) glds16(ksrc + (size_t)(t) * 64 * 1024, (unsigned)__builtin_amdgcn_readfirstlane(kdst + (s) * KSLOT))
#define AT_DMA_K2(t, s) do { if (KIND == 0 && wid < 4) glds16(k2src + (size_t)(t) * 64 * 32, (unsigned)__builtin_amdgcn_readfirstlane(k2dst + (s) * KSLOT)); } while (0)
#define AT_DMA_V(t, s) glds16(vsrc + (size_t)(t) * 64 * 1024, (unsigned)__builtin_amdgcn_readfirstlane(vdst + (s) * VSLOT))
    AT_DMA(T0, 0);
    LAS float* tab = (LAS float*)(lds + L_TAB);
    if (KIND == 1) { if (tid < 320) tab[tid] = T.relb[h * 257 + (tid > 256 ? 256 : tid)] * LOG2E; }
    bf16x8 qr[NQ];
    {   const bf16_t* Qw = (KIND == 0 ? T.qm + (size_t)qrow * 768 + h * 96 : T.qb + (size_t)qrow * 512 + h * 64) + (size_t)r32 * (KIND == 0 ? 768 : 512) + hi * 8;
#pragma unroll
        for (int d0 = 0; d0 < NQ; ++d0) qr[d0] = active ? *(const bf16x8*)(Qw + d0 * 16) : (bf16x8){0, 0, 0, 0, 0, 0, 0, 0}; }
#pragma unroll
    for (int d0 = 0; d0 < NQ; ++d0) asm volatile("" : "+v"(qr[d0]));
    AT_DMA(T0 + 1, 1); AT_DMA(T0 + 2, 2);
#define AT_WAIT_TILES(n) do { if ((n) == 2) asm volatile("s_waitcnt vmcnt(4)" ::: "memory"); else if ((n) == 1) asm volatile("s_waitcnt vmcnt(2)" ::: "memory"); else asm volatile("s_waitcnt vmcnt(0)" ::: "memory"); } while (0)
    AT_WAIT_TILES(2);
    AT_BAR();
    LAS float* wsf = (LAS float*)(lds + L_WS) + wid * 64;
    const int vboff = ((lane >> 4) & 1) * 32 + (lane & 3) * 8 + (4 * hi + ((lane & 15) >> 2)) * 64;
    float m_ref = 0.f, l_run = 0.f; bool first = true; f32x16 o[2]; o[0] = f32x16{}; o[1] = f32x16{};
    const float cbfar = (KIND == 1) ? tab[256] : 0.f;
    f32x16 negn = f32x16{}, negf;
#pragma unroll
    for (int r = 0; r < 16; ++r) negf[r] = cbfar;
    const int aq = 32 * (wid & 1) + r32;
    bf16x8 kf[2 * NQ]; s16x4 vf[16];
    f32x16 p0, p1;
    if (grp == 1) { AT_WAIT_TILES(1); AT_DMA(T0 + 3, 3); }
    if (active && T0 >= vlo) kload<NQ>(kf, (LAS const char*)(lds + L_K), r32, hi);
    if (grp == 1) AT_BAR();
#define AT_PK(d, k) (bf16x8){vf[d * 8 + 2 * k][0], vf[d * 8 + 2 * k][1], vf[d * 8 + 2 * k][2], vf[d * 8 + 2 * k][3], vf[d * 8 + 2 * k + 1][0], vf[d * 8 + 2 * k + 1][1], vf[d * 8 + 2 * k + 1][2], vf[d * 8 + 2 * k + 1][3]}
#define AT_TILE(ST, j, GR) do { \
        const int sc = (j - T0) & 3; \
        const bool vis = ST || (active && j >= vlo && j <= vhi); \
        const bool visn = ST || (active && j + 1 >= vlo && j + 1 <= vhi && j + 1 < T1); \
        const bool issA = ((GR) == 0) && (ST || j + 3 < T1), issB = ((GR) == 1) && (ST || j + 4 < T1); \
        if ((GR) == 0) { if (ST || j + 2 < T1) AT_WAIT_TILES(1); else AT_WAIT_TILES(0); if (issA && !vis) AT_DMA(j + 3, (sc + 3) & 3); } \
        if (vis) { \
            const int jd = cq - j; \
            vload(vf, (LAS const char*)(lds + L_V + sc * VSLOT) + vboff); \
            __builtin_amdgcn_sched_barrier(0); \
            if (KIND == 1 && (ST || jd >= 3)) { p0 = AT_MFMA(kf[0], qr[0], negf); p1 = AT_MFMA(kf[1], qr[0], negf); asm volatile("" ::: "memory"); } \
            else { p0 = AT_MFMA(kf[0], qr[0], negn); p1 = AT_MFMA(kf[1], qr[0], negn); asm volatile("" ::: "memory"); } \
            __builtin_amdgcn_sched_barrier(0); if (issA) AT_DMA_K(j + 3, (sc + 3) & 3); __builtin_amdgcn_sched_barrier(0); \
            p0 = AT_MFMA(kf[2], qr[1], p0); p1 = AT_MFMA(kf[3], qr[1], p1); \
            __builtin_amdgcn_sched_barrier(0); if (issA) AT_DMA_V(j + 3, (sc + 3) & 3); __builtin_amdgcn_sched_barrier(0); \
            p0 = AT_MFMA(kf[4], qr[2], p0); p1 = AT_MFMA(kf[5], qr[2], p1); \
            __builtin_amdgcn_sched_barrier(0); if (issA) AT_DMA_K2(j + 3, (sc + 3) & 3); __builtin_amdgcn_sched_barrier(0); \
_Pragma("unroll") \
            for (int d0 = 3; d0 < NQ; ++d0) { p0 = AT_MFMA(kf[2 * d0], qr[d0], p0); p1 = AT_MFMA(kf[2 * d0 + 1], qr[d0], p1); } \
            if (KIND == 1 && !ST && jd < 3) { LAS const float* tb = tab + (64 * jd + aq + 128 - 4 * hi - 27 - 32); \
_Pragma("unroll") \
                for (int r = 0; r < 16; ++r) { const int c = 27 - ((r & 3) + 8 * (r >> 2)); p0[r] += tb[32 + c]; p1[r] += tb[c]; } } \
            if (!ST && samp && j == T1 - 1) { \
_Pragma("unroll") \
                for (int r = 0; r < 16; ++r) p1[r] = -INFINITY; \
                asm volatile("" : "+v"(p1)); } \
            asm volatile("s_nop 15\n\ts_nop 7" : "+v"(p0), "+v"(p1)); \
            const float rm = rowmax3(p0, p1); \
            const bool fst = !ST && first; \
            if (fst || __any(rm > 8.0f)) { \
                const float dl = fst ? rm : fmaxf(rm, 0.f); \
                m_ref += dl; \
_Pragma("unroll") \
                for (int r = 0; r < 16; ++r) { p0[r] -= dl; p1[r] -= dl; } \
_Pragma("unroll") \
                for (int r = 0; r < 16; ++r) { negn[r] = -m_ref; negf[r] = cbfar - m_ref; } \
                asm volatile("" : "+v"(negn), "+v"(negf)); \
                if (!fst) { \
                    const float alpha = __builtin_amdgcn_exp2f(-dl); l_run *= alpha; \
                    if (hi == 0) wsf[r32] = alpha; \
_Pragma("unroll") \
                    for (int r = 0; r < 16; ++r) { const float a = wsf[crow(r, hi)]; o[0][r] *= a; o[1][r] *= a; } \
                } \
                first = false; \
            } \
        } \
        AT_BAR(); \
        if ((GR) == 1) { if (ST || j + 3 < T1) AT_WAIT_TILES(1); else AT_WAIT_TILES(0); if (issB && !vis) AT_DMA(j + 4, sc); } \
        if (visn) kload<NQ>(kf, (LAS const char*)(lds + L_K + ((sc + 1) & 3) * KSLOT), r32, hi); \
        __builtin_amdgcn_sched_barrier(0); \
        if (vis) { \
            float sacc = 0.f; \
_Pragma("unroll") \
            for (int r = 0; r < 16; ++r) { p0[r] = __builtin_amdgcn_exp2f(p0[r]); p1[r] = __builtin_amdgcn_exp2f(p1[r]); sacc += p0[r] + p1[r]; } \
            l_run += sacc; \
            u32x4 w0, w1, w2, w3; \
            w0 = (u32x4){pk_bf16(p0[0], p0[1]), pk_bf16(p0[2], p0[3]), pk_bf16(p0[4], p0[5]), pk_bf16(p0[6], p0[7])}; \
            w1 = (u32x4){pk_bf16(p0[8], p0[9]), pk_bf16(p0[10], p0[11]), pk_bf16(p0[12], p0[13]), pk_bf16(p0[14], p0[15])}; \
            w2 = (u32x4){pk_bf16(p1[0], p1[1]), pk_bf16(p1[2], p1[3]), pk_bf16(p1[4], p1[5]), pk_bf16(p1[6], p1[7])}; \
            w3 = (u32x4){pk_bf16(p1[8], p1[9]), pk_bf16(p1[10], p1[11]), pk_bf16(p1[12], p1[13]), pk_bf16(p1[14], p1[15])}; \
            __builtin_amdgcn_sched_barrier(0); \
            {   const bf16x8 pa0 = __builtin_bit_cast(bf16x8, w0), pa1 = __builtin_bit_cast(bf16x8, w1), pa2 = __builtin_bit_cast(bf16x8, w2), pa3 = __builtin_bit_cast(bf16x8, w3); \
                o[0] = AT_MFMA(pa0, AT_PK(0, 0), o[0]); o[1] = AT_MFMA(pa0, AT_PK(1, 0), o[1]); \
                __builtin_amdgcn_sched_barrier(0); if (issB) AT_DMA_K(j + 4, sc); __builtin_amdgcn_sched_barrier(0); \
                o[0] = AT_MFMA(pa1, AT_PK(0, 1), o[0]); o[1] = AT_MFMA(pa1, AT_PK(1, 1), o[1]); \
                __builtin_amdgcn_sched_barrier(0); if (issB) AT_DMA_V(j + 4, sc); __builtin_amdgcn_sched_barrier(0); \
                o[0] = AT_MFMA(pa2, AT_PK(0, 2), o[0]); o[1] = AT_MFMA(pa2, AT_PK(1, 2), o[1]); \
                __builtin_amdgcn_sched_barrier(0); if (issB) AT_DMA_K2(j + 4, sc); __builtin_amdgcn_sched_barrier(0); \
                o[0] = AT_MFMA(pa3, AT_PK(0, 3), o[0]); o[1] = AT_MFMA(pa3, AT_PK(1, 3), o[1]); \
            } \
        } \
        AT_BAR(); \
    } while (0)
    int js = T1, je = T1;
    if (active) { js = vlo + 1; int jl = vhi - 1; if (T1 - 5 < jl) jl = T1 - 5; if (KIND == 1 && cq - 3 < jl) jl = cq - 3; je = jl + 1; if (js > T1) js = T1; if (je < js) je = js; }
    int j = T0;
    for (; j < js; ++j) AT_TILE(false, j, grp);
    const int jeA = (grp == 0) ? je : js;
    for (; j < jeA; ++j) AT_TILE(true, j, 0);
    for (; j < je; ++j) AT_TILE(true, j, 1);
    for (; j < T1; ++j) AT_TILE(false, j, grp);
#undef AT_TILE
#undef AT_PK
    const int colb = KIND * 512 + h * 64;
    u32x4 gpre[4];
    if (active) {
#pragma unroll
        for (int i = 0; i < 4; ++i) gpre[i] = __builtin_nontemporal_load((const u32x4*)(T.sg + (size_t)(qrow + i * 8 + (lane >> 3)) * 1024 + colb + (lane & 7) * 8)); }
    if (grp == 0) AT_BAR();
    if (active) {
        { auto rr = __builtin_amdgcn_permlane32_swap(__float_as_uint(l_run), __float_as_uint(l_run), false, false); l_run = __uint_as_float(rr[0]) + __uint_as_float(rr[1]); }
        if (hi == 0) wsf[32 + r32] = l_run;
        LAS bf16_t* stg = (LAS bf16_t*)(lds + L_OST) + wid * 2048;
#pragma unroll
        for (int r = 0; r < 16; ++r) { const int orow = crow(r, hi); const float rl = __builtin_amdgcn_rcpf(wsf[32 + orow]);
#pragma unroll
            for (int d0 = 0; d0 < 2; ++d0) stg[orow * 64 + d0 * 32 + r32] = (bf16_t)(pk_bf16(o[d0][r] * rl, 0.f) & 0xffffu); }
#pragma unroll
        for (int i = 0; i < 4; ++i) { const int row = i * 8 + (lane >> 3), ch = lane & 7;
            const u32x4 v = *(LAS const u32x4*)(stg + row * 64 + ch * 8);
            const size_t gi = (size_t)(qrow + row) * 1024 + colb + ch * 8;
            const u32x4 g = gpre[i]; u32x4 w;
            w.x = pk_bf16(bf_lo(v.x) * bf_lo(g.x), bf_hi(v.x) * bf_hi(g.x)); w.y = pk_bf16(bf_lo(v.y) * bf_lo(g.y), bf_hi(v.y) * bf_hi(g.y));
            w.z = pk_bf16(bf_lo(v.z) * bf_lo(g.z), bf_hi(v.z) * bf_hi(g.z)); w.w = pk_bf16(bf_lo(v.w) * bf_lo(g.w), bf_hi(v.w) * bf_hi(g.w));
            *(u32x4*)(T.y + gi) = w; }
    }
#undef AT_DMA
#undef AT_DMA_K
#undef AT_DMA_K2
#undef AT_DMA_V
#undef AT_WAIT_TILES
#undef AT_DMA1
}
constexpr int NU_MS = 64, NU_MP = 1024, NU_BP = 1024, NU_BS = 64, NU_G4S = 4, NU_TOT = NU_MS + NU_MP + NU_BP + NU_BS + NU_G4S;
constexpr int IDX_G4S = NU_MS + NU_BS + 13 * 64;
__device__ __forceinline__ void run_unit(const Tens& T, int idx, LAS unsigned char* lds) {
    int kind, seq, h, u;
    if (idx < NU_MS) { kind = 0; seq = 8 + (idx >> 3); h = idx & 7; u = 0; }
    else if (idx < NU_MS + NU_BS) { const int i = idx - NU_MS; kind = 1; seq = 8 + (i >> 3); h = i & 7; u = 0; }
    else if (idx < IDX_G4S) { const int i = idx - NU_MS - NU_BS; kind = 0; u = 15 - i / 64; seq = (i % 64) >> 3; h = i & 7; }
    else if (idx < IDX_G4S + NU_G4S + NU_BP) { const int i = idx - IDX_G4S - NU_G4S; kind = 1; u = 15 - i / 64; seq = (i % 64) >> 3; h = i & 7; }
    else { const int i = idx - IDX_G4S - NU_G4S - NU_BP; kind = 0; u = 2 - i / 64; seq = (i % 64) >> 3; h = i & 7; }
    if (kind == 0) unit<0>(T, seq, h, u, lds); else unit<1>(T, seq, h, u, lds);
}
}

__device__ __forceinline__ void tr_item(const float* W, int N, int srccol0, int K, bf16_t* WT, int destrow0, int k0, LAS float* scr, int lane) {
    float tv[32];
#pragma unroll
    for (int i = 0; i < 32; ++i) { const int kk = 2 * i + (lane >> 5); tv[i] = srccol0 >= 0 ? __builtin_nontemporal_load(W + (size_t)(k0 + kk) * N + srccol0 + (lane & 31)) : 0.f; }
#pragma unroll
    for (int i = 0; i < 32; ++i) { const int kk = 2 * i + (lane >> 5); scr[kk * 33 + (lane & 31)] = tv[i]; }
    const int c = lane & 7;
#pragma unroll
    for (int j = 0; j < 4; ++j) { const int n = (lane >> 3) + 8 * j; const LAS float* s = scr + (8 * c) * 33 + n;
        u32x4 o; o.x = pk_bf16(s[0 * 33], s[1 * 33]); o.y = pk_bf16(s[2 * 33], s[3 * 33]); o.z = pk_bf16(s[4 * 33], s[5 * 33]); o.w = pk_bf16(s[6 * 33], s[7 * 33]);
        *(u32x4*)(WT + (size_t)(destrow0 + n) * K + k0 + 8 * c) = o; }
}
__device__ __forceinline__ int win_src(int ng) {
    if (ng < 8) return OFF_CQ + 32 * ng;
    if (ng < 12) return OFF_CKV + 32 * (ng - 8);
    if (ng == 12) return OFF_KR;
    if (ng < 16) return -1;
    if (ng < 32) return OFF_GA + 32 * (ng - 16);
    if (ng < 48) return OFF_GB + 32 * (ng - 32);
    if (ng < 64) return OFF_QB + 32 * (ng - 48);
    if (ng < 80) return OFF_KB + 32 * (ng - 64);
    return OFF_VB + 32 * (ng - 80);
}
__device__ __forceinline__ void sincos_d(double a, float& s, float& c) {
    const double twopi = 6.283185307179586476925286766559;
    const double k = __builtin_rint(a / twopi); const double r = a - k * twopi; const double r2 = r * r;
    double ts = 1.0, tc = 1.0;
#pragma unroll 1
    for (int n = 29; n >= 3; n -= 2) { ts = 1.0 - ts * r2 / (double)(n * (n - 1)); tc = 1.0 - tc * r2 / (double)(n * (n + 1)); }
    s = (float)(r * ts); c = (float)(1.0 - tc * r2 * 0.5);
}


__device__ __forceinline__ void xn_rows4(int mb, const float* x_p, const float* x_s, const float* g_mix, bf16_t* XN, int lane) {
    f32x4 v[4][4]; float s[4];
#pragma unroll
    for (int q = 0; q < 4; ++q) { const int m = mb + q; const float* xr = (m < MP) ? x_p + (size_t)m * DM : x_s + (size_t)(m - MP) * DM;
#pragma unroll
        for (int j = 0; j < 4; ++j) v[q][j] = __builtin_nontemporal_load((const f32x4*)(xr + 4 * lane + 256 * j)); }
#pragma unroll
    for (int q = 0; q < 4; ++q) { s[q] = 0.f;
#pragma unroll
        for (int j = 0; j < 4; ++j) s[q] += (v[q][j][0] * v[q][j][0] + v[q][j][1] * v[q][j][1]) + (v[q][j][2] * v[q][j][2] + v[q][j][3] * v[q][j][3]);
        s[q] = 1.0f / sqrtf(wave_sum(s[q]) * (1.0f / DM) + EPS); }
#pragma unroll
    for (int j = 0; j < 4; ++j) { const f32x4 g = *(const f32x4*)(g_mix + 4 * lane + 256 * j);
#pragma unroll
        for (int q = 0; q < 4; ++q) { const f32x4 o = v[q][j] * s[q] * g; u32x2 w; w.x = pk_bf16(o[0], o[1]); w.y = pk_bf16(o[2], o[3]); *(u32x2*)(XN + (size_t)(mb + q) * DM + 4 * lane + 256 * j) = w; } }
}
__device__ __forceinline__ void rope_entry(float* rope, int pos, int f) {
    const double inv = exp2(-(double)f * (13.287712379549449 / 16.0));
    float s, c; sincos_d((double)pos * inv, s, c); rope[pos * 32 + f] = c; rope[pos * 32 + 16 + f] = s;
}

__device__ __forceinline__ void grid_bar(unsigned* cnt, unsigned target) {
    asm volatile("s_waitcnt vmcnt(0)" ::: "memory");
    __syncthreads();
    if (threadIdx.x == 0) {
        __builtin_amdgcn_fence(__ATOMIC_RELEASE, "agent");
        asm volatile("s_waitcnt vmcnt(0)" ::: "memory");
        __hip_atomic_fetch_add(cnt, 1u, __ATOMIC_RELAXED, __HIP_MEMORY_SCOPE_AGENT);
        unsigned spins = 0;
        while (__hip_atomic_load(cnt, __ATOMIC_RELAXED, __HIP_MEMORY_SCOPE_AGENT) < target) { __builtin_amdgcn_s_sleep(2); if (++spins > (1u << 22)) break; }
        __builtin_amdgcn_fence(__ATOMIC_ACQUIRE, "agent");
        asm volatile("s_waitcnt vmcnt(0)" ::: "memory");
    }
    __syncthreads();
}
#define XB_TMO      128
#define XB_XCNT(j)  (256  + 64 * (j))
#define XB_XSUB(j)  (1280 + 64 * (j))
#define XB_XGEN(j)  (2304 + 64 * (j))
#define XB_TOP      3328
#define XB_TOPGEN   3392
#define XCD_BAR_WORDS 3456
#define XB_SPIN_CAP (1u << 18)

__device__ __forceinline__ unsigned xb_ld(unsigned* p)              { return __hip_atomic_load(p, __ATOMIC_RELAXED, __HIP_MEMORY_SCOPE_AGENT); }
__device__ __forceinline__ unsigned xb_add(unsigned* p, unsigned v) { return __hip_atomic_fetch_add(p, v, __ATOMIC_RELAXED, __HIP_MEMORY_SCOPE_AGENT); }
__device__ __forceinline__ unsigned xb_xcc_id() { return (unsigned)__builtin_amdgcn_s_getreg((3 << 11) | 20) & 0xFu; }
#define XB_SPIN(cond, bar) do { unsigned _sp = 0; while (cond) { __builtin_amdgcn_s_sleep(1); \
    if ((++_sp & 255u) == 0u) { if (xb_ld(&(bar)[XB_TMO])) break; if (_sp > XB_SPIN_CAP) { atomicAdd(&(bar)[XB_TMO], 1u); break; } } } } while (0)

struct XcdBarrier {
    unsigned* bar; unsigned x;
    volatile LAS unsigned* st;
};

__device__ __forceinline__ XcdBarrier xcd_barrier_post(unsigned* bar, volatile LAS unsigned* st) {
    XcdBarrier b; b.bar = bar; b.x = xb_xcc_id(); b.st = st;
    if (threadIdx.x == 0) (void)xb_add(&bar[XB_XCNT(b.x)], 1u);
    return b;
}
__device__ __forceinline__ void xcd_barrier_complete(unsigned* bar, unsigned x, unsigned& nloc, unsigned& nx) {
    const unsigned G = gridDim.x * gridDim.y * gridDim.z;
    unsigned sum, cnt, mine, sp = 0u;
    for (;;) {
        sum = 0u; cnt = 0u; mine = 0u;
#pragma unroll
        for (unsigned j = 0; j < 16; ++j) { const unsigned c = xb_ld(&bar[XB_XCNT(j)]); sum += c; cnt += (c > 0u) ? 1u : 0u; mine = (j == x) ? c : mine; }
        if (sum == G) break;
        __builtin_amdgcn_s_sleep(1);
        if ((++sp & 255u) == 0u) { if (xb_ld(&bar[XB_TMO])) break; if (sp > XB_SPIN_CAP) { atomicAdd(&bar[XB_TMO], 1u); break; } }
    }
    nloc = mine > 0u ? mine : 1u; nx = cnt > 0u ? cnt : 1u;
}

__device__ __forceinline__ void xcd_barrier(const XcdBarrier& b) {
    asm volatile("s_waitcnt vmcnt(0)" ::: "memory");
    __syncthreads();
    if (threadIdx.x == 0) {
        unsigned* bar = b.bar;
        __builtin_amdgcn_s_waitcnt(0);
        unsigned nloc = b.st[0], nx = b.st[1];
        if (nloc == 0u) { xcd_barrier_complete(bar, b.x, nloc, nx); b.st[0] = nloc; b.st[1] = nx; }
        const unsigned old = xb_add(&bar[XB_XSUB(b.x)], 1u);
        const unsigned gen = old / nloc;
        if (old + 1u == (gen + 1u) * nloc) {
            __builtin_amdgcn_fence(__ATOMIC_RELEASE, "agent");
            asm volatile("s_waitcnt vmcnt(0)" ::: "memory");
            const unsigned og = xb_add(&bar[XB_TOP], 1u);
            const unsigned tg = og / nx;
            if (og + 1u == (tg + 1u) * nx) xb_add(&bar[XB_TOPGEN], 1u);
            else XB_SPIN(xb_ld(&bar[XB_TOPGEN]) == tg, bar);
            __builtin_amdgcn_fence(__ATOMIC_ACQUIRE, "agent");
            xb_add(&bar[XB_XGEN(b.x)], 1u);
            asm volatile("s_waitcnt vmcnt(0)" ::: "memory");
        } else {
            XB_SPIN(xb_ld(&bar[XB_XGEN(b.x)]) == gen, bar);
            __builtin_amdgcn_fence(__ATOMIC_ACQUIRE, "agent");
            asm volatile("s_waitcnt vmcnt(0)" ::: "memory");
        }
    }
    __syncthreads();
}

struct Params { const float* in[16]; float* out; unsigned char* ws; int lo, hi, coop, pad; };

__global__ void __launch_bounds__(512, 2) mk_fwd(Params P) {
    extern __shared__ __attribute__((aligned(16))) unsigned char lds_raw[];
    LAS unsigned char* lds = (LAS unsigned char*)lds_raw;
    const int G = gridDim.x, NGW = G * 8;
#define PHASE_IDS() int tid_l = threadIdx.x; asm volatile("" : "+v"(tid_l)); const int tid = tid_l, lane = tid & 63; const int wave = __builtin_amdgcn_readfirstlane(tid >> 6); const int gw = blockIdx.x * 8 + wave; (void)lane; (void)gw
    unsigned char* ws = P.ws; float* out = P.out;
    const float *x_p = P.in[0], *x_s = P.in[1], *c_ckv = P.in[2], *c_kpe = P.in[3], *c_kb = P.in[4], *c_vb = P.in[5], *w_in = P.in[6], *g_mix = P.in[7], *g_cq = P.in[8],
                *w_uq = P.in[9], *g_ckv = P.in[10], *w_uk = P.in[11], *w_uv = P.in[12], *relb = P.in[13], *w_out = P.in[14], *g_fin = P.in[15];
    unsigned* ctl = (unsigned*)(ws + WS_CTL); float* rope = (float*)(ws + WS_ROPE);
    bf16_t *Win = (bf16_t*)(ws + WS_WIN), *Wuq = (bf16_t*)(ws + WS_WUQ), *Wukv = (bf16_t*)(ws + WS_WUKV), *Wout = (bf16_t*)(ws + WS_WOUT), *XN = (bf16_t*)(ws + WS_XN),
           *ZCQ = (bf16_t*)(ws + WS_ZCQ), *CQ = (bf16_t*)(ws + WS_CQ), *CKV = (bf16_t*)(ws + WS_CKV), *KPE = (bf16_t*)(ws + WS_KPE), *SG = (bf16_t*)(ws + WS_SG),
           *QB = (bf16_t*)(ws + WS_QB), *KVB = (bf16_t*)(ws + WS_KVB), *QM = (bf16_t*)(ws + WS_QM), *KVM = (bf16_t*)(ws + WS_KVM), *Y = (bf16_t*)(ws + WS_Y);
    float* ZCKV = (float*)(ws + WS_ZCKV);
    const int lo = P.lo, hi = P.hi;
#ifndef MK_PHMASK
#define MK_PHMASK 0xff
#endif
#define PH(k) (((MK_PHMASK >> (k)) & 1) && lo <= (k) && (k) < hi)
#ifndef MK_REP
#define MK_REP -1
#endif
#define REP(k) for (int rep_ = 0; rep_ < ((MK_REP) == (k) ? 2 : 1); ++rep_)
    { volatile LAS unsigned* misc = (volatile LAS unsigned*)(lds + LDS_RING + 32); if (threadIdx.x < 2) misc[threadIdx.x] = 0u; __syncthreads(); }
    const XcdBarrier xbar = xcd_barrier_post(ctl + 1024, (volatile LAS unsigned*)(lds + LDS_RING + 32));
#define SEAM(k) do { if (PH(k) && PH((k) + 1)) { if (P.coop == 2) cg::this_grid().sync(); else xcd_barrier(xbar); } } while (0)

    if (PH(0)) REP(0) {
        PHASE_IDS();
        LAS float* scr = (LAS float*)(lds + wave * 8448);
        for (int it = gw; it < 96 * 16; it += NGW) { const int ng = it / 16, kb = it % 16; tr_item(w_in, IN_W, win_src(ng), 1024, Win, 32 * ng, 64 * kb, scr, lane); }
        for (int mb = gw * 4; mb < M1; mb += NGW * 4) xn_rows4(mb, x_p, x_s, g_mix, XN, lane);
        const int gt = blockIdx.x * 512 + tid, NGT = G * 512;
        for (int i = gt; i < (PAST + TS) * 16; i += NGT) rope_entry(rope, i >> 4, i & 15);
    }
    SEAM(0);
#ifdef MK_XSYNC
    for (int i_ = 0; i_ < MK_XSYNC; ++i_) xcd_barrier(xbar);
#endif
    if (PH(1)) REP(1) {
        pg8::Gemm g{XN, Win, M1, NIN, 1024}; pg8::StaticOrder S; S.init(M1, NIN, G, (int)blockIdx.x);
        EpiG1 E{ZCQ, KPE, SG, QB, KVB, ZCKV, out, rope};
        pg8::gemm_phase<EpiG1, pg8::StaticOrder, true, true>(lds, g, S, E);
        {   PHASE_IDS();
            const int nlast = (M1 / 256 * (NIN / 256)) % G;
            const int nsb = (nlast > 0 && nlast * 2 < G) ? nlast : 0;
            if ((int)blockIdx.x >= nsb) {
                LAS float* scr = (LAS float*)(lds + wave * 8448);
                const int gwp = ((int)blockIdx.x - nsb) * 8 + wave, NGWP = (G - nsb) * 8;
                constexpr int I_UQ = 24 * 4, I_UKV = 32 * 2, I_OUT = 32 * 16, I_TOT = I_UQ + I_UKV + I_OUT;
                for (int it = gwp; it < I_TOT; it += NGWP) {
                    int r = it;
                    if (r < I_UQ) { const int ng = r / 4, kb = r % 4; const int src = ng < 16 ? (ng >> 1) * 96 + 32 * (ng & 1) : (ng - 16) * 96 + 64; tr_item(w_uq, 768, src, 256, Wuq, 32 * ng, 64 * kb, scr, lane); continue; } r -= I_UQ;
                    if (r < I_UKV) { const int ng = r / 2, kb = r % 2; tr_item(ng < 16 ? w_uk : w_uv, 512, 32 * (ng & 15), 128, Wukv, 32 * ng, 64 * kb, scr, lane); continue; } r -= I_UKV;
                    { const int ng = r / 16, kb = r % 16; tr_item(w_out, 1024, 32 * ng, 1024, Wout, 32 * ng, 64 * kb, scr, lane); }
                }
                const int gt = ((int)blockIdx.x - nsb) * 512 + tid, NGT = (G - nsb) * 512;
#pragma unroll 4
        for (int i = gt; i < NB * PAST * 32; i += NGT) { const int r = i >> 5, c = (i & 31) * 4; const int bb = r >> 12, p = r & 4095;
            const f32x4 v = __builtin_nontemporal_load((const f32x4*)(c_ckv + (size_t)r * 128 + c)); u32x2 w; w.x = pk_bf16(v[0], v[1]); w.y = pk_bf16(v[2], v[3]);
            *(u32x2*)(CKV + (size_t)(MP + bb * KVS + p) * 128 + c) = w; }
        for (int i = gt; i < NB * PAST * 8; i += NGT) { const int r = i >> 3, c = (i & 7) * 4; const int bb = r >> 12, p = r & 4095;
            const f32x4 v = __builtin_nontemporal_load((const f32x4*)(c_kpe + (size_t)r * 32 + c)); u32x2 w; w.x = pk_bf16(v[0], v[1]); w.y = pk_bf16(v[2], v[3]);
            *(u32x2*)(KPE + (size_t)(MP + bb * KVS + p) * 32 + c) = w; }
#pragma unroll 2
        for (int i = gt; i < NB * 512 * 128; i += NGT) { const int r = i >> 7, c = (i & 127) * 4; const int bb = r >> 9, p = r & 511;
            const f32x4 kv = __builtin_nontemporal_load((const f32x4*)(c_kb + (size_t)r * 512 + c)), vv = __builtin_nontemporal_load((const f32x4*)(c_vb + (size_t)r * 512 + c));
            u32x2 w; w.x = pk_bf16(kv[0], kv[1]); w.y = pk_bf16(kv[2], kv[3]); bf16_t* d = KVB + (size_t)(MP + bb * BVS + p) * 1024 + c; *(u32x2*)d = w;
            w.x = pk_bf16(vv[0], vv[1]); w.y = pk_bf16(vv[2], vv[3]); *(u32x2*)(d + 512) = w; }
        for (int i = gt; i < NB * 32 * 32; i += NGT) { const int r = i >> 5, c = (i & 31) * 4; *(u32x2*)(CKV + (size_t)(MP + (r >> 5) * KVS + PAST + 32 + (r & 31)) * 128 + c) = (u32x2){0u, 0u}; }
        for (int i = gt; i < NB * 32 * 8; i += NGT) { const int r = i >> 3, c = (i & 7) * 4; *(u32x2*)(KPE + (size_t)(MP + (r >> 5) * KVS + PAST + 32 + (r & 31)) * 32 + c) = (u32x2){0u, 0u}; }
        for (int i = gt; i < NB * 32 * 256; i += NGT) { const int r = i >> 8, c = (i & 255) * 4; *(u32x2*)(KVB + (size_t)(MP + (r >> 5) * BVS + 512 + 32 + (r & 31)) * 1024 + c) = (u32x2){0u, 0u}; }
            }
        }
    }
    SEAM(1);
    if (PH(2)) REP(2) {
        PHASE_IDS();
        for (int mb = gw * 4; mb < M1; mb += NGW * 4) {
            u32x2 wq[4]; f32x2 vk[4];
#pragma unroll
            for (int q = 0; q < 4; ++q) { wq[q] = __builtin_nontemporal_load((const u32x2*)(ZCQ + (size_t)(mb + q) * 256 + 4 * lane)); vk[q] = __builtin_nontemporal_load((const f32x2*)(ZCKV + (size_t)(mb + q) * 128 + 2 * lane)); }
            const f32x4 gq = *(const f32x4*)(g_cq + 4 * lane); const f32x2 gk = *(const f32x2*)(g_ckv + 2 * lane);
#pragma unroll
            for (int q = 0; q < 4; ++q) { const int m = mb + q;
                f32x4 v = {bf_lo(wq[q].x), bf_hi(wq[q].x), bf_lo(wq[q].y), bf_hi(wq[q].y)};
                const float rq = 1.0f / sqrtf(wave_sum((v[0] * v[0] + v[1] * v[1]) + (v[2] * v[2] + v[3] * v[3])) * (1.0f / 256.0f) + EPS);
                v = v * rq * gq; u32x2 o; o.x = pk_bf16(v[0], v[1]); o.y = pk_bf16(v[2], v[3]); *(u32x2*)(CQ + (size_t)m * 256 + 4 * lane) = o;
                f32x2 k = vk[q];
                const float rk = 1.0f / sqrtf(wave_sum(k[0] * k[0] + k[1] * k[1]) * (1.0f / 128.0f) + EPS);
                k = k * rk * gk;
                float* po = (m < MP) ? out + O_CKVP + (size_t)m * 128 : out + O_CKVS + (size_t)(m - MP) * 128; *(f32x2*)(po + 2 * lane) = k;
                *(unsigned*)(CKV + (size_t)kvrow_m(m) * 128 + 2 * lane) = pk_bf16(k[0], k[1]); }
        }
    }
    SEAM(2);
    if (PH(3)) REP(3) {
        { pg8::Gemm g{CQ, Wuq, M1, 768, 256}; pg8::StaticOrder S; S.init(M1, 768, G, (int)blockIdx.x); EpiG2 E{QM, rope};
          pg8::gemm_phase<EpiG2, pg8::StaticOrder, true, true>(lds, g, S, E); }
    }
    if (PH(4)) REP(4) {
        { pg8::Gemm g{CKV, Wukv, KVR, 1024, 128}; SkewOrder S; S.init(KVR, 1024, G, (int)blockIdx.x, (KVR / 256 * 4) / G, (M1 / 256 * 3) % G);
          EpiPlain E{KVM, 1024};
          pg8::gemm_phase<EpiPlain, SkewOrder, true, true>(lds, g, S, E); }
    }
    SEAM(4);
    if (PH(5)) REP(5) {
        PHASE_IDS();
        const at::Tens T{QM, QB, KVM, KVB, KPE, SG, Y, relb};
        LAS volatile unsigned* sidx = (LAS volatile unsigned*)(lds + at::L_IDX);
        unsigned nxt = 0; if (tid == 0) nxt = atomicAdd(ctl + rep_, 1u);
        for (;;) {
            if (tid == 0) sidx[0] = nxt;
            __syncthreads();
            const int idx = (int)sidx[0];
            if (idx >= at::NU_TOT) break;
            if (tid == 0) nxt = atomicAdd(ctl + rep_, 1u);
            if (idx >= at::IDX_G4S && idx < at::IDX_G4S + at::NU_G4S) {
                if (tid == 0) { unsigned sp = 0; while (__hip_atomic_load(ctl + 2, __ATOMIC_RELAXED, __HIP_MEMORY_SCOPE_AGENT) < 128u) { __builtin_amdgcn_s_sleep(4); if (++sp > (1u << 22)) break; }
                    __builtin_amdgcn_fence(__ATOMIC_ACQUIRE, "agent"); asm volatile("s_waitcnt vmcnt(0)" ::: "memory"); }
                __syncthreads();
                pg8::Gemm g{Y, Wout, M1, 1024, 1024}; OneUnit S1{MP / 256, idx - at::IDX_G4S}; EpiG4 E{x_p, x_s, out, (bf16_t*)(ws + WS_X1), (float*)(ws + WS_SSQ)};
                pg8::gemm_phase<EpiG4, OneUnit, false, true>(lds, g, S1, E);
                continue;
            }
            at::run_unit(T, idx, lds);
            if (idx < at::NU_MS + at::NU_BS) {
                asm volatile("s_waitcnt vmcnt(0)" ::: "memory"); __syncthreads();
                if (tid == 0) { __builtin_amdgcn_fence(__ATOMIC_RELEASE, "agent"); asm volatile("s_waitcnt vmcnt(0)" ::: "memory"); __hip_atomic_fetch_add(ctl + 2, 1u, __ATOMIC_RELAXED, __HIP_MEMORY_SCOPE_AGENT); }
            }
        }
    }
    SEAM(5);
    if (PH(6)) REP(6) {
        pg8::Gemm g{Y, Wout, MP, 1024, 1024}; pg8::StaticOrder S; S.init(MP, 1024, G, (int)blockIdx.x); EpiG4 E{x_p, x_s, out, (bf16_t*)(ws + WS_X1), (float*)(ws + WS_SSQ)};
        pg8::gemm_phase<EpiG4, pg8::StaticOrder, true, true>(lds, g, S, E);
    }
    SEAM(6);
    if (PH(7)) {
        PHASE_IDS();
        const bf16_t* X1 = (const bf16_t*)(ws + WS_X1); const float* SSQ = (const float*)(ws + WS_SSQ);
        for (int mb = gw * 4; mb < MP; mb += NGW * 4) {
            float sp[4]; u32x4 w[4][2];
#pragma unroll
            for (int q = 0; q < 4; ++q) { sp[q] = lane < 16 ? SSQ[(size_t)(mb + q) * 16 + lane] : 0.f;
#pragma unroll
                for (int j = 0; j < 2; ++j) w[q][j] = __builtin_nontemporal_load((const u32x4*)(X1 + (size_t)(mb + q) * DM + 8 * lane + 512 * j)); }
#pragma unroll
            for (int q = 0; q < 4; ++q) sp[q] = 1.0f / sqrtf(wave_sum(sp[q]) * (1.0f / DM) + EPS);
#pragma unroll
            for (int j = 0; j < 2; ++j) { const int c = 8 * lane + 512 * j; const f32x4 g0 = *(const f32x4*)(g_fin + c), g1 = *(const f32x4*)(g_fin + c + 4);
#pragma unroll
                for (int q = 0; q < 4; ++q) { const u32x4 ww = w[q][j];
                    const f32x4 a = {bf_lo(ww.x), bf_hi(ww.x), bf_lo(ww.y), bf_hi(ww.y)}, b = {bf_lo(ww.z), bf_hi(ww.z), bf_lo(ww.w), bf_hi(ww.w)};
                    *(f32x4*)(out + (size_t)(mb + q) * DM + c) = a * sp[q] * g0; *(f32x4*)(out + (size_t)(mb + q) * DM + c + 4) = b * sp[q] * g1; } }
        }
        for (int m = MP + gw; m < M1; m += NGW) {
            float* xr = out + (size_t)m * DM; f32x4 v[4]; float s = 0.f;
#pragma unroll
            for (int j = 0; j < 4; ++j) { v[j] = *(const f32x4*)(xr + 4 * lane + 256 * j); s += (v[j][0] * v[j][0] + v[j][1] * v[j][1]) + (v[j][2] * v[j][2] + v[j][3] * v[j][3]); }
            const float rstd = 1.0f / sqrtf(wave_sum(s) * (1.0f / DM) + EPS);
#pragma unroll
            for (int j = 0; j < 4; ++j) { const f32x4 g = *(const f32x4*)(g_fin + 4 * lane + 256 * j); *(f32x4*)(xr + 4 * lane + 256 * j) = v[j] * rstd * g; }
        }
    }
#undef PH
#undef SEAM
}

constexpr int NPH = 8;
extern "C" void kernel_launch(void* const* d_in, const int* in_sizes, int n_in, void* d_out, int out_size, void* d_ws, size_t ws_size, hipStream_t stream) {
    static int grid = 0;
    if (grid == 0) {
        if (n_in != 16 || (size_t)out_size != O_END || ws_size < WS_END) { fprintf(stderr, "kernel_launch: unexpected shapes (n_in %d out %d ws %zu need %zu)\n", n_in, out_size, ws_size, (size_t)WS_END); grid = -1; return; }
        int dev = 0, cus = 0, per_cu = 0;
        hipGetDevice(&dev); hipDeviceGetAttribute(&cus, hipDeviceAttributeMultiprocessorCount, dev);
        hipFuncSetAttribute((const void*)mk_fwd, hipFuncAttributeMaxDynamicSharedMemorySize, LDS_TOTAL);
        hipOccupancyMaxActiveBlocksPerMultiprocessor(&per_cu, (const void*)mk_fwd, 512, LDS_TOTAL);
        (void)hipGetLastError();
        if (per_cu < 1) per_cu = 1;
        grid = cus * per_cu;
        if (grid > 256) grid = 256;
    }
    if (grid < 0) return;
    if (hipMemsetAsync(d_ws, 0, 32768, stream) != hipSuccess) { fprintf(stderr, "memset failed\n"); return; }
    Params p{};
    for (int i = 0; i < 16; ++i) p.in[i] = (const float*)d_in[i];
    p.out = (float*)d_out; p.ws = (unsigned char*)d_ws;
#if MK_COOP
    p.lo = 0; p.hi = NPH; p.coop = 1;
    void* args[] = {&p};
    hipError_t e = hipLaunchCooperativeKernel((const void*)mk_fwd, dim3(grid), dim3(512), args, LDS_TOTAL, stream);
    if (e != hipSuccess) fprintf(stderr, "cooperative launch failed: %s (grid %d)\n", hipGetErrorString(e), grid);
#else
    for (int ph = 0; ph < NPH; ++ph) { p.lo = ph; p.hi = ph + 1; p.coop = 0; hipLaunchKernelGGL(mk_fwd, dim3(grid), dim3(512), LDS_TOTAL, stream, p); }
#endif
}
```

```cpp
#include <hip/hip_runtime.h>
#include <hip/hip_bf16.h>
#include <hip/hip_cooperative_groups.h>
#include <cstdio>
#include <cstdint>
#include <type_traits>
namespace cg = cooperative_groups;
#ifndef MK_COOP
#define MK_COOP 1
#endif

namespace pg8 {
#define PG8_LAS __attribute__((address_space(3)))
typedef unsigned short bf16_t;
typedef short bf16x8 __attribute__((ext_vector_type(8)));
typedef float f32x4 __attribute__((ext_vector_type(4)));
typedef unsigned u32x4 __attribute__((ext_vector_type(4)));
constexpr int BM = 256, BK = 64, HALF = 128, HTB = HALF * BK * 2  , STAGE_BYTES = 8 * HTB, NXCD = 8, WGM = 8;

__host__ __device__ __forceinline__ int lds_byte(int r, int c) { const int st = (r >> 4) * 2 + (c >> 5), rr = r & 15, cc = c & 31, ob = rr * 64 + cc * 2; return st * 1024 + (ob ^ (((ob >> 9) & 1) << 5)); }
__host__ __device__ __forceinline__ void stage_rc(int b, int& R, int& C) { const int st = b / 1024, sb = b % 1024, swz = sb ^ (((sb >> 9) & 1) << 5); R = (st >> 1) * 16 + swz / 64; C = (st & 1) * 32 + (swz % 64) / 2; }
__host__ __device__ __forceinline__ int perm32(int rho) { const int n = rho >> 4, i = rho & 15; return 8 * (i >> 2) + 4 * n + (i & 3); }

struct Unit { int pm, pn; };
struct Gemm { const bf16_t* A; const bf16_t* Bt; int M, N, K; };

struct StaticOrder {
    int nM, nN, nwg, G, c;
    __host__ __device__ void init(int M, int N, int G_, int c_) { nM = M / BM; nN = N / BM; nwg = nM * nN; G = G_; c = c_; }
    __host__ __device__ bool next(int i, Unit& u) const {
        const long L = (long)i * G + c; if (L >= nwg) return false;
        int wgid = (int)L; { const int q = nwg / NXCD, r = nwg % NXCD, xcd = wgid % NXCD, off = wgid / NXCD; wgid = (xcd < r ? xcd * (q + 1) : r * (q + 1) + (xcd - r) * q) + off; }
        const int nig = WGM * nN, gid = wgid / nig, fm = gid * WGM, gsz = (nM - fm) < WGM ? (nM - fm) : WGM;
        u.pm = fm + ((wgid % nig) % gsz); u.pn = (wgid % nig) / gsz; return true;
    }
    __device__ __forceinline__ void a_ready(const Unit&) const {}
    __device__ __forceinline__ void done(const Unit&) const {}
};

__device__ __forceinline__ unsigned cvt_pk_bf16(float lo, float hi) { unsigned r; asm volatile("v_cvt_pk_bf16_f32 %0, %1, %2" : "=v"(r) : "v"(lo), "v"(hi)); return r; }
typedef float f32x2 __attribute__((ext_vector_type(2)));
template <class Epi, class Sched, bool ALIGN_EPI = false, bool SP2 = false>
__device__ __forceinline__ void gemm_phase(PG8_LAS unsigned char* lds, const Gemm g, const Sched& S, const Epi& E) {
    int tid_l = threadIdx.x; asm volatile("" : "+v"(tid_l));
    const int tid = tid_l, wid = __builtin_amdgcn_readfirstlane(tid >> 6), lane = tid & 63, wr = wid >> 2, wc = wid & 3, fr = lane & 15, fq = lane >> 4;
    int K_l = g.K; asm volatile("" : "+s"(K_l));
    const int K = K_l, nt = K / BK;
    unsigned voffA[2], voffB[2];
#pragma unroll
    for (int i = 0; i < 2; ++i) { int R, C; stage_rc(tid * 16 + i * 8192, R, C); const int Rb = Epi::PERM ? ((R & ~31) + perm32(R & 31)) : R;
        voffA[i] = (unsigned)(R * K + C) * 2u; voffB[i] = (unsigned)(Rb * K + C) * 2u; }
    const size_t kstep = (size_t)(BK * 2);
    const size_t hstep = (size_t)HALF * K * 2;
    const size_t tstep = 2 * hstep;
    const unsigned ldsw = (unsigned)wid * 1024u;
    const int aoff = lds_byte(wr * 64 + fr, fq * 8), boff = lds_byte(wc * 32 + fr, fq * 8);
#define PG8_SA(b, h) (((b) * 2 + (h)) * HTB)
#define PG8_SB(b, h) ((4 + (b) * 2 + (h)) * HTB)
#define PG8_STAGE(bufoff, gbase, voff) do { _Pragma("unroll") for (int _i = 0; _i < 2; ++_i) \
        __builtin_amdgcn_global_load_lds((const unsigned*)((const char*)(gbase) + (voff)[_i]), (PG8_LAS unsigned*)(lds + (bufoff) + ldsw + _i * 8192), 16, 0, 0); } while (0)
#define PG8_LDA(dst, b, h) do { _Pragma("unroll") for (int m = 0; m < 4; ++m) _Pragma("unroll") for (int k = 0; k < 2; ++k) dst[m][k] = *(const PG8_LAS bf16x8*)(lds + PG8_SA(b, h) + aoff + m * 2048 + k * 1024); } while (0)
#define PG8_LDB(dst, b, h) do { _Pragma("unroll") for (int n = 0; n < 2; ++n) _Pragma("unroll") for (int k = 0; k < 2; ++k) dst[n][k] = *(const PG8_LAS bf16x8*)(lds + PG8_SB(b, h) + boff + n * 2048 + k * 1024); } while (0)
#define PG8_MMA(ai, bj, At, Bt) do { __builtin_amdgcn_s_setprio(1); _Pragma("unroll") for (int m = 0; m < 4; ++m) _Pragma("unroll") for (int n = 0; n < 2; ++n) _Pragma("unroll") for (int k = 0; k < 2; ++k) \
        acc[ai][bj][m][n] = __builtin_amdgcn_mfma_f32_16x16x32_bf16(Bt[n][k], At[m][k], acc[ai][bj][m][n], 0, 0, 0); __builtin_amdgcn_s_setprio(0); } while (0)
#define PG8_WAIT_V(n) asm volatile("s_waitcnt vmcnt(" #n ")" ::: "memory")
#define PG8_WAIT_L(n) asm volatile("s_waitcnt lgkmcnt(" #n ")" ::: "memory")
#define PG8_BAR __builtin_amdgcn_s_barrier()
#define PG8_SCHED __builtin_amdgcn_sched_barrier(0)
    Unit cur, nxt; int ui = 0;
    if (!S.next(0, cur)) return;
    f32x4 acc[2][2][4][2];
#pragma unroll
    for (int a = 0; a < 2; ++a)
#pragma unroll
        for (int b = 0; b < 2; ++b)
#pragma unroll
            for (int m = 0; m < 4; ++m)
#pragma unroll
                for (int n = 0; n < 2; ++n) acc[a][b][m][n] = (f32x4){0.f, 0.f, 0.f, 0.f};
    bf16x8 At[4][2], B0[2][2], B1[2][2];
    const char* cA = (const char*)g.A + (size_t)cur.pm * tstep; const char* cB = (const char*)g.Bt + (size_t)cur.pn * tstep;
    S.a_ready(cur);
    if constexpr (SP2) {
        PG8_STAGE(PG8_SB(0, 0), cB, voffB); PG8_STAGE(PG8_SB(0, 1), cB + hstep, voffB); PG8_STAGE(PG8_SA(0, 0), cA, voffA); PG8_STAGE(PG8_SA(0, 1), cA + hstep, voffA);
        if (wr == 1) PG8_BAR;
        PG8_WAIT_V(2); PG8_BAR;
        PG8_STAGE(PG8_SB(1, 0), cB + kstep, voffB); PG8_STAGE(PG8_SA(1, 0), cA + kstep, voffA); PG8_STAGE(PG8_SB(1, 1), cB + hstep + kstep, voffB);
        PG8_WAIT_V(6); PG8_BAR;
    } else {
        PG8_STAGE(PG8_SB(0, 0), cB, voffB); PG8_STAGE(PG8_SA(0, 0), cA, voffA); PG8_STAGE(PG8_SB(0, 1), cB + hstep, voffB); PG8_STAGE(PG8_SA(0, 1), cA + hstep, voffA);
        if (wr == 1) PG8_BAR;
        PG8_WAIT_V(4); PG8_BAR;
        PG8_STAGE(PG8_SB(1, 0), cB + kstep, voffB); PG8_STAGE(PG8_SA(1, 0), cA + kstep, voffA); PG8_STAGE(PG8_SB(1, 1), cB + hstep + kstep, voffB);
        PG8_WAIT_V(6); PG8_BAR;
    }
    for (;;) {
        const bool has_next = S.next(ui + 1, nxt);
        const char* nA = has_next ? (const char*)g.A + (size_t)nxt.pm * tstep : cA; const char* nB = has_next ? (const char*)g.Bt + (size_t)nxt.pn * tstep : cB;
        for (int t = 0; t < nt; t += 2) {
            const bool last = (t == nt - 2);
            const char* a1 = cA + (size_t)(t + 1) * kstep;
            const char* a2 = last ? nA : cA + (size_t)(t + 2) * kstep; const char* b2 = last ? nB : cB + (size_t)(t + 2) * kstep;
            const char* a3 = a2 + kstep; const char* b3 = b2 + kstep;
            if (last && has_next) S.a_ready(nxt);
            if constexpr (SP2) {
            PG8_LDB(B0, 0, 0); PG8_LDB(B1, 0, 1); PG8_SCHED; PG8_LDA(At, 0, 0); PG8_STAGE(PG8_SA(1, 1), a1 + hstep, voffA);
            PG8_WAIT_V(8); PG8_WAIT_L(0); PG8_BAR; PG8_MMA(0, 0, At, B0); PG8_MMA(0, 1, At, B1); PG8_BAR; PG8_SCHED;
            PG8_LDA(At, 0, 1); PG8_STAGE(PG8_SB(0, 0), b2, voffB); PG8_STAGE(PG8_SB(0, 1), b2 + hstep, voffB); PG8_STAGE(PG8_SA(0, 0), a2, voffA);
            PG8_WAIT_V(8); PG8_WAIT_L(0); PG8_BAR; PG8_MMA(1, 0, At, B0); PG8_MMA(1, 1, At, B1); PG8_BAR; PG8_SCHED;
            PG8_LDB(B0, 1, 0); PG8_LDB(B1, 1, 1); PG8_SCHED; PG8_LDA(At, 1, 0); PG8_STAGE(PG8_SA(0, 1), a2 + hstep, voffA);
            PG8_WAIT_V(8); PG8_WAIT_L(0); PG8_BAR; PG8_MMA(0, 0, At, B0); PG8_MMA(0, 1, At, B1); PG8_BAR; PG8_SCHED;
            PG8_LDA(At, 1, 1); PG8_STAGE(PG8_SB(1, 0), b3, voffB); PG8_STAGE(PG8_SB(1, 1), b3 + hstep, voffB); PG8_STAGE(PG8_SA(1, 0), a3, voffA);
            PG8_WAIT_V(8); PG8_WAIT_L(0); PG8_BAR; PG8_MMA(1, 0, At, B0); PG8_MMA(1, 1, At, B1); PG8_BAR; PG8_SCHED;
            } else {
            PG8_LDB(B0, 0, 0); PG8_SCHED; PG8_LDA(At, 0, 0); PG8_STAGE(PG8_SA(1, 1), a1 + hstep, voffA);
            PG8_WAIT_L(8); PG8_BAR; PG8_WAIT_L(0); PG8_MMA(0, 0, At, B0); PG8_BAR; PG8_SCHED;
            PG8_LDB(B1, 0, 1); PG8_STAGE(PG8_SB(0, 0), b2, voffB);
            PG8_BAR; PG8_WAIT_L(0); PG8_MMA(0, 1, At, B1); PG8_BAR;
            PG8_LDA(At, 0, 1); PG8_STAGE(PG8_SA(0, 0), a2, voffA);
            PG8_BAR; PG8_WAIT_L(0); PG8_MMA(1, 0, At, B0); PG8_BAR; PG8_SCHED;
            PG8_STAGE(PG8_SB(0, 1), b2 + hstep, voffB);
            PG8_WAIT_V(6); PG8_BAR; PG8_MMA(1, 1, At, B1); PG8_BAR;
            PG8_LDB(B0, 1, 0); PG8_SCHED; PG8_LDA(At, 1, 0); PG8_STAGE(PG8_SA(0, 1), a2 + hstep, voffA);
            PG8_WAIT_L(8); PG8_BAR; PG8_WAIT_L(0); PG8_MMA(0, 0, At, B0); PG8_BAR; PG8_SCHED;
            PG8_LDB(B1, 1, 1); PG8_STAGE(PG8_SB(1, 0), b3, voffB);
            PG8_BAR; PG8_WAIT_L(0); PG8_MMA(0, 1, At, B1); PG8_BAR;
            PG8_LDA(At, 1, 1); PG8_STAGE(PG8_SA(1, 0), a3, voffA);
            PG8_BAR; PG8_WAIT_L(0); PG8_MMA(1, 0, At, B0); PG8_BAR; PG8_SCHED;
            PG8_STAGE(PG8_SB(1, 1), b3 + hstep, voffB);
            PG8_WAIT_V(6); PG8_BAR; PG8_MMA(1, 1, At, B1); PG8_BAR;
            }
        }
        if constexpr (ALIGN_EPI) { if (wr == 0) PG8_BAR; }
        if constexpr (!Epi::AFTER_DRAIN) { E(acc, cur, wr, wc, fr, fq); S.done(cur); }
        if (!has_next) break;
#pragma unroll
        for (int a = 0; a < 2; ++a)
#pragma unroll
            for (int b = 0; b < 2; ++b)
#pragma unroll
                for (int m = 0; m < 4; ++m)
#pragma unroll
                    for (int n = 0; n < 2; ++n) acc[a][b][m][n] = (f32x4){0.f, 0.f, 0.f, 0.f};
        cur = nxt; cA = nA; cB = nB; ++ui;
        if constexpr (ALIGN_EPI) { if (wr == 1) PG8_BAR; }
    }
    PG8_WAIT_V(0);
    if constexpr (!ALIGN_EPI) { if (wr == 0) PG8_BAR; }
    PG8_BAR;
    if constexpr (Epi::AFTER_DRAIN) { E.fused(acc, cur, wr, wc, fr, fq, lds, wid, lane); S.done(cur); }
#undef PG8_SA
#undef PG8_SB
#undef PG8_STAGE
#undef PG8_LDA
#undef PG8_LDB
#undef PG8_MMA
#undef PG8_WAIT_V
#undef PG8_WAIT_L
#undef PG8_BAR
#undef PG8_SCHED
}
}

#define LAS __attribute__((address_space(3)))
typedef unsigned short bf16_t;
typedef short bf16x8 __attribute__((ext_vector_type(8)));
typedef short s16x4 __attribute__((ext_vector_type(4)));
typedef float f32x4 __attribute__((ext_vector_type(4)));
typedef float f32x2 __attribute__((ext_vector_type(2)));
typedef float f32x16 __attribute__((ext_vector_type(16)));
typedef unsigned u32x4 __attribute__((ext_vector_type(4)));
typedef unsigned u32x2 __attribute__((ext_vector_type(2)));

constexpr int DM = 1024, SEQ = 4096, NB = 8, TS = 32, PAST = 4096;
constexpr int MP = NB * SEQ, MS = NB * TS, M1 = MP + MS;
constexpr int KVS = PAST + 64, KVR = MP + NB * KVS;
constexpr int BVS = 512 + 64, BVR = MP + NB * BVS;
constexpr int NIN = 3072;
constexpr float EPS = 1e-6f, LOG2E = 1.4426950408889634f;
constexpr float QS_MLA = 0.10206207261596575f * LOG2E;
constexpr float QS_B = 0.125f * LOG2E;
constexpr int OFF_CQ = 0, OFF_CKV = 256, OFF_KR = 384, OFF_GA = 416, OFF_QB = 928, OFF_KB = 1440, OFF_VB = 1952, OFF_GB = 2464, IN_W = 2976;
constexpr size_t O_YP = 0, O_YS = O_YP + (size_t)MP * DM, O_CKVP = O_YS + (size_t)MS * DM, O_KPEP = O_CKVP + (size_t)MP * 128,
                 O_KBP = O_KPEP + (size_t)MP * 32, O_VBP = O_KBP + (size_t)NB * 512 * 512, O_CKVS = O_VBP + (size_t)NB * 512 * 512,
                 O_KPES = O_CKVS + (size_t)MS * 128, O_KBS = O_KPES + (size_t)MS * 32, O_VBS = O_KBS + (size_t)MS * 512, O_END = O_VBS + (size_t)MS * 512;
constexpr size_t al256(size_t x) { return (x + 255) & ~(size_t)255; }
constexpr size_t WS_CTL = 0, WS_ROPE = 32768, WS_WIN = al256(WS_ROPE + (size_t)(PAST + TS) * 32 * 4), WS_WUQ = WS_WIN + (size_t)NIN * 1024 * 2,
                 WS_WUKV = WS_WUQ + (size_t)768 * 256 * 2, WS_WOUT = WS_WUKV + (size_t)1024 * 128 * 2, WS_XN = WS_WOUT + (size_t)1024 * 1024 * 2,
                 WS_CQ = WS_XN + (size_t)M1 * 1024 * 2, WS_CKV = WS_CQ + (size_t)M1 * 256 * 2, WS_KPE = WS_CKV + (size_t)KVR * 128 * 2,
                 WS_SG = WS_KPE + (size_t)KVR * 32 * 2, WS_QB = WS_SG + (size_t)M1 * 1024 * 2, WS_KVB = WS_QB + (size_t)M1 * 512 * 2,
                 WS_QM = WS_KVB + (size_t)BVR * 1024 * 2, WS_KVM = WS_QM + (size_t)M1 * 768 * 2, WS_END = WS_KVM + (size_t)KVR * 1024 * 2;
constexpr size_t WS_Y = WS_XN;
constexpr size_t WS_ZCQ = WS_QM, WS_ZCKV = WS_QM + (size_t)M1 * 256 * 2;
static_assert(WS_ZCKV + (size_t)M1 * 128 * 4 <= WS_KVM, "overlay");
constexpr size_t WS_X1 = WS_KVM, WS_SSQ = WS_QM;

constexpr int LDS_RING = 131072, LDS_TOTAL = LDS_RING + 1024;

__device__ __forceinline__ unsigned pk_bf16(float lo, float hi) { f32x2 v = {lo, hi}; typedef __bf16 bf2 __attribute__((ext_vector_type(2))); bf2 b = __builtin_convertvector(v, bf2); return __builtin_bit_cast(unsigned, b); }
__device__ __forceinline__ float bf_lo(unsigned w) { return __builtin_bit_cast(float, w << 16); }
__device__ __forceinline__ float bf_hi(unsigned w) { return __builtin_bit_cast(float, w & 0xffff0000u); }
__device__ __forceinline__ u32x4 pk8(const f32x4 a, const f32x4 b) { u32x4 w; w.x = pk_bf16(a[0], a[1]); w.y = pk_bf16(a[2], a[3]); w.z = pk_bf16(b[0], b[1]); w.w = pk_bf16(b[2], b[3]); return w; }
__device__ __forceinline__ float wave_sum(float v) {
#pragma unroll
    for (int o = 1; o < 64; o <<= 1) v += __shfl_xor(v, o);
    return v;
}
__device__ __forceinline__ int kvrow_m(int row) { if (row < MP) return row; const int r = row - MP; return MP + (r >> 5) * KVS + PAST + (r & 31); }
__device__ __forceinline__ int kvrow_b(int row) { if (row < MP) return row; const int r = row - MP; return MP + (r >> 5) * BVS + 512 + (r & 31); }
__device__ __forceinline__ int pos_of(int row) { if (row < MP) return row & (SEQ - 1); return PAST + ((row - MP) & 31); }

__device__ __forceinline__ void rope8(f32x4& v0, f32x4& v1, const float* rp  , int fq) {
    const int i0 = 8 * (fq & 1);
    const f32x4 c0 = *(const f32x4*)(rp + i0), c1 = *(const f32x4*)(rp + i0 + 4), s0 = *(const f32x4*)(rp + 16 + i0), s1 = *(const f32x4*)(rp + 16 + i0 + 4);
    f32x4 p0, p1;
#pragma unroll
    for (int j = 0; j < 4; ++j) { p0[j] = __shfl_xor(v0[j], 32); p1[j] = __shfl_xor(v1[j], 32); }
    if (fq < 2) { v0 = v0 * c0 - p0 * s0; v1 = v1 * c1 - p1 * s1; }
    else        { v0 = p0 * s0 + v0 * c0; v1 = p1 * s1 + v1 * c1; }
}
__device__ __forceinline__ float silu_f(float g) { return g * __builtin_amdgcn_rcpf(1.0f + __builtin_amdgcn_exp2f(-g * LOG2E)); }

struct EpiG1 {
    static constexpr bool PERM = true, AFTER_DRAIN = false;
    bf16_t *zcq, *kpe, *sg, *qb, *kvb; float* zckv; float* out; const float* rope;
    __device__ __forceinline__ void operator()(const f32x4 (&acc)[2][2][4][2], const pg8::Unit& u, int wr, int wc, int fr, int fq) const {
        const int pn = u.pn, row0 = u.pm * 256 + wr * 64 + fr, cl = wc * 32 + 8 * fq;
        if (pn == 0) {
#pragma unroll
            for (int ai = 0; ai < 2; ++ai)
#pragma unroll
                for (int m = 0; m < 4; ++m) { const int row = row0 + ai * 128 + m * 16;
#pragma unroll
                    for (int bj = 0; bj < 2; ++bj) *(u32x4*)(zcq + (size_t)row * 256 + bj * 128 + cl) = pk8(acc[ai][bj][m][0], acc[ai][bj][m][1]); }
        } else if (pn == 1) {
#pragma unroll
            for (int ai = 0; ai < 2; ++ai)
#pragma unroll
                for (int m = 0; m < 4; ++m) { const int row = row0 + ai * 128 + m * 16; float* p = zckv + (size_t)row * 128 + cl;
                    *(f32x4*)p = acc[ai][0][m][0]; *(f32x4*)(p + 4) = acc[ai][0][m][1]; }
            if (wc == 0) {
#pragma unroll
                for (int ai = 0; ai < 2; ++ai)
#pragma unroll
                    for (int m = 0; m < 4; ++m) { const int row = row0 + ai * 128 + m * 16; f32x4 v0 = acc[ai][1][m][0], v1 = acc[ai][1][m][1];
                        rope8(v0, v1, rope + (size_t)pos_of(row) * 32, fq);
                        float* po = (row < MP) ? out + O_KPEP + (size_t)row * 32 + 8 * fq : out + O_KPES + (size_t)(row - MP) * 32 + 8 * fq;
                        *(f32x4*)po = v0; *(f32x4*)(po + 4) = v1;
                        *(u32x4*)(kpe + (size_t)kvrow_m(row) * 32 + 8 * fq) = pk8(v0, v1); asm volatile("" ::: "memory"); }
            }
        } else if (pn < 6) {
            const int cb = (pn - 2) * 256 + cl;
#pragma unroll
            for (int ai = 0; ai < 2; ++ai)
#pragma unroll
                for (int m = 0; m < 4; ++m) { const int row = row0 + ai * 128 + m * 16;
#pragma unroll
                    for (int bj = 0; bj < 2; ++bj) { f32x4 a = acc[ai][bj][m][0], b = acc[ai][bj][m][1];
#pragma unroll
                        for (int j = 0; j < 4; ++j) { a[j] = silu_f(a[j]); b[j] = silu_f(b[j]); }
                        *(u32x4*)(sg + (size_t)row * 1024 + cb + bj * 128) = pk8(a, b); } }
        } else if (pn < 8) {
            const int cb = (pn - 6) * 256 + cl;
#pragma unroll
            for (int ai = 0; ai < 2; ++ai)
#pragma unroll
                for (int m = 0; m < 4; ++m) { const int row = row0 + ai * 128 + m * 16;
#pragma unroll
                    for (int bj = 0; bj < 2; ++bj) *(u32x4*)(qb + (size_t)row * 512 + cb + bj * 128) = pk8(acc[ai][bj][m][0] * QS_B, acc[ai][bj][m][1] * QS_B); }
        } else if (pn < 12) {
            const int cb = (pn - 8) * 256 + cl;
            const bool isv = pn >= 10; const int co = cb - (isv ? 512 : 0);
#pragma unroll
            for (int ai = 0; ai < 2; ++ai)
#pragma unroll
                for (int m = 0; m < 4; ++m) { const int row = row0 + ai * 128 + m * 16;
                    float* po = nullptr;
                    if (row < MP) { const int s = row & (SEQ - 1); if (s >= SEQ - 512) po = out + (isv ? O_VBP : O_KBP) + ((size_t)(row >> 12) * 512 + (s - (SEQ - 512))) * 512 + co; }
                    else po = out + (isv ? O_VBS : O_KBS) + (size_t)(row - MP) * 512 + co;
                    bf16_t* pk = kvb + (size_t)kvrow_b(row) * 1024 + cb;
#pragma unroll
                    for (int bj = 0; bj < 2; ++bj) { *(u32x4*)(pk + bj * 128) = pk8(acc[ai][bj][m][0], acc[ai][bj][m][1]);
                        if (po) { *(f32x4*)(po + bj * 128) = acc[ai][bj][m][0]; *(f32x4*)(po + bj * 128 + 4) = acc[ai][bj][m][1]; } } }
        }
    }
};
__device__ __forceinline__ void rope8t(f32x4& v0, f32x4& v1, const f32x4 c0, const f32x4 c1, const f32x4 s0, const f32x4 s1, int fq) {
    f32x4 p0, p1;
#pragma unroll
    for (int j = 0; j < 4; ++j) { p0[j] = __shfl_xor(v0[j], 32); p1[j] = __shfl_xor(v1[j], 32); }
    if (fq < 2) { v0 = v0 * c0 - p0 * s0; v1 = v1 * c1 - p1 * s1; }
    else        { v0 = p0 * s0 + v0 * c0; v1 = p1 * s1 + v1 * c1; }
}
struct EpiG2 {
    static constexpr bool PERM = true, AFTER_DRAIN = false;
    bf16_t* qm; const float* rope;
    __device__ __forceinline__ void operator()(const f32x4 (&acc)[2][2][4][2], const pg8::Unit& u, int wr, int wc, int fr, int fq) const {
        const int pn = u.pn, row0 = u.pm * 256 + wr * 64 + fr;
        if (pn < 2) {
#pragma unroll
            for (int ai = 0; ai < 2; ++ai)
#pragma unroll
                for (int m = 0; m < 4; ++m) { const int row = row0 + ai * 128 + m * 16;
#pragma unroll
                    for (int bj = 0; bj < 2; ++bj) { const int n = pn * 256 + bj * 128 + wc * 32 + 8 * fq; const int dc = (n >> 6) * 96 + (n & 63);
                        __builtin_nontemporal_store(pk8(acc[ai][bj][m][0] * QS_MLA, acc[ai][bj][m][1] * QS_MLA), (u32x4*)(qm + (size_t)row * 768 + dc)); } }
        } else {
            const int i0 = 8 * (fq & 1);
#pragma unroll
            for (int ai = 0; ai < 2; ++ai)
#pragma unroll
                for (int mp = 0; mp < 4; mp += 2) {
                    f32x4 c0[2], c1[2], s0[2], s1[2];
#pragma unroll
                    for (int q = 0; q < 2; ++q) { const float* rp = rope + (size_t)pos_of(row0 + ai * 128 + (mp + q) * 16) * 32 + i0;
                        c0[q] = *(const f32x4*)rp; c1[q] = *(const f32x4*)(rp + 4); s0[q] = *(const f32x4*)(rp + 16); s1[q] = *(const f32x4*)(rp + 20); }
#pragma unroll
                    for (int q = 0; q < 2; ++q) { const int m = mp + q, row = row0 + ai * 128 + m * 16;
#pragma unroll
                        for (int bj = 0; bj < 2; ++bj) { f32x4 v0 = acc[ai][bj][m][0], v1 = acc[ai][bj][m][1];
                            rope8t(v0, v1, c0[q], c1[q], s0[q], s1[q], fq);
                            __builtin_nontemporal_store(pk8(v0 * QS_MLA, v1 * QS_MLA), (u32x4*)(qm + (size_t)row * 768 + (bj * 4 + wc) * 96 + 64 + 8 * fq)); } }
                    asm volatile("" ::: "memory");
                }
        }
    }
};
struct EpiPlain {
    static constexpr bool PERM = true, AFTER_DRAIN = false;
    bf16_t* O; int ldc;
    __device__ __forceinline__ void operator()(const f32x4 (&acc)[2][2][4][2], const pg8::Unit& u, int wr, int wc, int fr, int fq) const {
        const int row0 = u.pm * 256 + wr * 64 + fr, col0 = u.pn * 256 + wc * 32 + 8 * fq;
#pragma unroll
        for (int ai = 0; ai < 2; ++ai)
#pragma unroll
            for (int m = 0; m < 4; ++m) { bf16_t* p = O + (size_t)(row0 + ai * 128 + m * 16) * ldc + col0;
#pragma unroll
                for (int bj = 0; bj < 2; ++bj) *(u32x4*)(p + bj * 128) = pk8(acc[ai][bj][m][0], acc[ai][bj][m][1]); }
    }
};
struct EpiG4 {
    static constexpr bool PERM = true, AFTER_DRAIN = false;
    const float *xp, *xs; float* out; bf16_t* x1; float* ssq;
    __device__ __forceinline__ void operator()(const f32x4 (&acc)[2][2][4][2], const pg8::Unit& u, int wr, int wc, int fr, int fq) const {
        const int row0 = u.pm * 256 + wr * 64 + fr, col0 = u.pn * 256 + wc * 32 + 8 * fq;
        if (u.pm < MP / 256) {
#pragma unroll
            for (int ai = 0; ai < 2; ++ai) {
                f32x4 xr[4][2][2];
#pragma unroll
                for (int m = 0; m < 4; ++m) { const float* px = xp + (size_t)(row0 + ai * 128 + m * 16) * 1024 + col0;
#pragma unroll
                    for (int bj = 0; bj < 2; ++bj) { xr[m][bj][0] = __builtin_nontemporal_load((const f32x4*)(px + bj * 128)); xr[m][bj][1] = __builtin_nontemporal_load((const f32x4*)(px + bj * 128 + 4)); } }
#pragma unroll
                for (int m = 0; m < 4; ++m) { const int row = row0 + ai * 128 + m * 16; bf16_t* po = x1 + (size_t)row * 1024 + col0; float s = 0.f;
#pragma unroll
                    for (int bj = 0; bj < 2; ++bj) { const f32x4 a = xr[m][bj][0] + acc[ai][bj][m][0], b = xr[m][bj][1] + acc[ai][bj][m][1];
                        s += (a[0] * a[0] + a[1] * a[1]) + (a[2] * a[2] + a[3] * a[3]) + (b[0] * b[0] + b[1] * b[1]) + (b[2] * b[2] + b[3] * b[3]);
                        *(u32x4*)(po + bj * 128) = pk8(a, b); }
                    s += __shfl_xor(s, 16); s += __shfl_xor(s, 32);
                    if (fq == 0) ssq[(size_t)row * 16 + u.pn * 4 + wc] = s; }
                asm volatile("" ::: "memory");
            }
        } else {
#pragma unroll
            for (int ai = 0; ai < 2; ++ai)
#pragma unroll
                for (int m = 0; m < 4; ++m) { const int row = row0 + ai * 128 + m * 16;
                    const float* px = xs + (size_t)(row - MP) * 1024 + col0; float* po = out + (size_t)row * 1024 + col0;
#pragma unroll
                    for (int bj = 0; bj < 2; ++bj) { const f32x4 a = *(const f32x4*)(px + bj * 128), b = *(const f32x4*)(px + bj * 128 + 4);
                        *(f32x4*)(po + bj * 128) = a + acc[ai][bj][m][0]; *(f32x4*)(po + bj * 128 + 4) = b + acc[ai][bj][m][1]; } }
        }
    }
};

struct SkewOrder {
    int nM, nN, nwg, G, c, base_rounds, c0;
    __device__ void init(int M, int N, int G_, int c_, int br, int c0_) { nM = M / 256; nN = N / 256; nwg = nM * nN; G = G_; c = c_; base_rounds = br; c0 = c0_; }
    __device__ bool next(int i, pg8::Unit& u) const {
        long L;
        if (i < base_rounds) L = (long)i * G + c;
        else { if (c < c0) return false; L = (long)base_rounds * G + (long)(i - base_rounds) * (G - c0) + (c - c0); }
        if (L >= nwg) return false;
        int wgid = (int)L; { const int q = nwg / 8, r = nwg % 8, xcd = wgid % 8, off = wgid / 8; wgid = (xcd < r ? xcd * (q + 1) : r * (q + 1) + (xcd - r) * q) + off; }
        const int nig = 8 * nN, gid = wgid / nig, fm = gid * 8, gsz = (nM - fm) < 8 ? (nM - fm) : 8;
        u.pm = fm + ((wgid % nig) % gsz); u.pn = (wgid % nig) / gsz; return true;
    }
    __device__ __forceinline__ void a_ready(const pg8::Unit&) const {}
    __device__ __forceinline__ void done(const pg8::Unit&) const {}
};
struct OneUnit {
    int pm, pn;
    __device__ __forceinline__ bool next(int i, pg8::Unit& u) const { if (i > 0) return false; u.pm = pm; u.pn = pn; return true; }
    __device__ __forceinline__ void a_ready(const pg8::Unit&) const {}
    __device__ __forceinline__ void done(const pg8::Unit&) const {}
};
#ifndef MK_E1
#define MK_E1 0
#endif
#ifndef MK_E2
#define MK_E2 0
#endif
#ifndef MK_GRP_ODD
#define MK_GRP_ODD 0
#endif
namespace at {
constexpr int KSLOT = 12288, VSLOT = 8192;
constexpr int L_K = 0, L_V = 4 * KSLOT, L_WS = L_V + 4 * VSLOT, L_OST = L_WS + 8 * 256, L_TAB = L_OST + 8 * 4096, L_IDX = L_TAB + 1296, L_END = L_IDX + 16;
static_assert(L_END <= LDS_RING, "attention LDS");
__device__ __forceinline__ int crow(int r, int hi) { return (r & 3) + 8 * (r >> 2) + 4 * hi; }
__device__ __forceinline__ void glds16(const void* gsrc, unsigned lds_dst) { unsigned keep;
    asm volatile("s_mov_b32 %0, m0\n\ts_mov_b32 m0, %2\n\ts_nop 0\n\tglobal_load_lds_dwordx4 %1, off\n\ts_mov_b32 m0, %0" : "=&s"(keep) : "v"(gsrc), "s"(lds_dst) : "memory"); }
#define AT_WAITBAR() asm volatile("s_waitcnt vmcnt(0) lgkmcnt(0)\n\ts_barrier" ::: "memory")
#define AT_BAR() asm volatile("s_waitcnt lgkmcnt(0)\n\ts_barrier" ::: "memory")
#define AT_MFMA(a, b, c) __builtin_amdgcn_mfma_f32_32x32x16_bf16(a, b, c, 0, 0, 0)

template <int NQ> __device__ __forceinline__ void kload(bf16x8* kf, LAS const char* kslot, int r32, int hi) {
    LAS const char* kb = kslot + hi * 1024 + r32 * 16;
#pragma unroll
    for (int d0 = 0; d0 < NQ; ++d0) { kf[2 * d0] = *(LAS const bf16x8*)(kb + d0 * 2048); kf[2 * d0 + 1] = *(LAS const bf16x8*)(kb + d0 * 2048 + 512); }
}
template <int NQ> __device__ __forceinline__ void qkmm(f32x16& p0, f32x16& p1, const bf16x8* kf, const bf16x8* qr, const f32x16& cinit) {
#pragma unroll
    for (int d0 = 0; d0 < NQ; ++d0) {
        if (d0 == 0) { p0 = AT_MFMA(kf[0], qr[0], cinit); p1 = AT_MFMA(kf[1], qr[0], cinit); }
        else { p0 = AT_MFMA(kf[2 * d0], qr[d0], p0); p1 = AT_MFMA(kf[2 * d0 + 1], qr[d0], p1); }
    }
}
__device__ __forceinline__ float max3f(float a, float b, float c) { float r; asm("v_max3_f32 %0, %1, %2, %3" : "=v"(r) : "v"(a), "v"(b), "v"(c)); return r; }
__device__ __forceinline__ float max2f(float a, float b) { float r; asm("v_max_f32_e32 %0, %1, %2" : "=v"(r) : "v"(a), "v"(b)); return r; }
__device__ __forceinline__ float rowmax3(const f32x16& p0, const f32x16& p1) {
    float a = max3f(p0[0], p0[1], p1[0]), b = max3f(p0[2], p0[3], p1[1]); a = max3f(a, p1[2], p1[3]);
#pragma unroll
    for (int r = 4; r < 16; r += 4) { a = max3f(a, p0[r], p0[r + 1]); b = max3f(b, p0[r + 2], p0[r + 3]); a = max3f(a, p1[r], p1[r + 1]); b = max3f(b, p1[r + 2], p1[r + 3]); }
    const float m = max2f(a, b);
    auto rr = __builtin_amdgcn_permlane32_swap(__float_as_uint(m), __float_as_uint(m), false, false);
    return max2f(__uint_as_float(rr[0]), __uint_as_float(rr[1]));
}
__device__ __forceinline__ float rowmax(const f32x16& p0, const f32x16& p1) {
    float a = fmaxf(p0[0], p1[0]);
#pragma unroll
    for (int r = 1; r < 16; ++r) a = fmaxf(a, fmaxf(p0[r], p1[r]));
    auto rr = __builtin_amdgcn_permlane32_swap(__float_as_uint(a), __float_as_uint(a), false, false);
    return fmaxf(__uint_as_float(rr[0]), __uint_as_float(rr[1]));
}
typedef short v4i16_t __attribute__((ext_vector_type(4)));
__device__ __forceinline__ s16x4 vtr(LAS const char* p) { return __builtin_bit_cast(s16x4, __builtin_amdgcn_ds_read_tr16_b64_v4i16((LAS v4i16_t*)p)); }
__device__ __forceinline__ void vload(s16x4* vf, LAS const char* vp) {
#pragma unroll
    for (int d0 = 0; d0 < 2; ++d0)
#pragma unroll
        for (int ks = 0; ks < 4; ++ks) { vf[d0 * 8 + 2 * ks] = vtr(vp + d0 * 4096 + ks * 1024); vf[d0 * 8 + 2 * ks + 1] = vtr(vp + d0 * 4096 + ks * 1024 + 512); }
}
__device__ __forceinline__ void pvm(f32x16* o, const s16x4* vf, bf16x8 pa0, bf16x8 pa1, bf16x8 pa2, bf16x8 pa3) {
#define AT_PK(d, k) (bf16x8){vf[d * 8 + 2 * k][0], vf[d * 8 + 2 * k][1], vf[d * 8 + 2 * k][2], vf[d * 8 + 2 * k][3], vf[d * 8 + 2 * k + 1][0], vf[d * 8 + 2 * k + 1][1], vf[d * 8 + 2 * k + 1][2], vf[d * 8 + 2 * k + 1][3]}
    o[0] = AT_MFMA(pa0, AT_PK(0, 0), o[0]); o[1] = AT_MFMA(pa0, AT_PK(1, 0), o[1]);
    o[0] = AT_MFMA(pa1, AT_PK(0, 1), o[0]); o[1] = AT_MFMA(pa1, AT_PK(1, 1), o[1]);
    o[0] = AT_MFMA(pa2, AT_PK(0, 2), o[0]); o[1] = AT_MFMA(pa2, AT_PK(1, 2), o[1]);
    o[0] = AT_MFMA(pa3, AT_PK(0, 3), o[0]); o[1] = AT_MFMA(pa3, AT_PK(1, 3), o[1]);
#undef AT_PK
}

struct Tens { const bf16_t *qm, *qb, *kvm, *kvb, *kpe, *sg; bf16_t* y; const float* relb; };

template <int KIND> __device__ __forceinline__ void unit(const Tens& T, int seq, int h, int u, LAS unsigned char* lds) {
    constexpr int NQ = KIND == 0 ? 6 : 4;
    int tid_l = threadIdx.x; asm volatile("" : "+v"(tid_l));
    const int tid = tid_l, lane = tid & 63, r32 = lane & 31, hi = lane >> 5; const int wid = __builtin_amdgcn_readfirstlane(tid >> 6);
    const bool samp = seq >= NB; const int b = seq & 7;
    const unsigned lds0 = (unsigned)(uintptr_t)lds;
    int qrow, T0, T1, vlo, vhi, cq; size_t kvbase; bool active = true;
    if (KIND == 0) {
        if (!samp) { qrow = b * SEQ + 256 * u + 32 * wid; kvbase = (size_t)b * SEQ; T0 = 0; T1 = 4 * u + 4; vlo = 0; vhi = 4 * u + (wid >> 1); cq = vhi; }
        else { qrow = MP + b * TS; kvbase = (size_t)MP + (size_t)b * KVS; T0 = 0; T1 = 65; vlo = 0; vhi = 64; cq = 64; active = (wid == 0); }
    } else {
        if (!samp) { qrow = b * SEQ + 256 * u + 32 * wid; kvbase = (size_t)b * SEQ; T0 = 4 * u - 8 < 0 ? 0 : 4 * u - 8; T1 = 4 * u + 4; cq = 4 * u + (wid >> 1); vlo = cq - 8 < 0 ? 0 : cq - 8; vhi = cq; }
        else { qrow = MP + b * TS; kvbase = (size_t)MP + (size_t)b * BVS; T0 = 0; T1 = 9; vlo = 0; vhi = 8; cq = 8; active = (wid == 0); }
    }
    const bf16_t* KV = (KIND == 0 ? T.kvm : T.kvb) + kvbase * 1024 + h * 64;
    const bf16_t* ksrc = KV + (size_t)lane * 1024 + wid * 8;
    const bf16_t* k2src = T.kpe + (kvbase + lane) * 32 + (wid & 3) * 8;
    const bf16_t* vsrc = KV + 512 + (size_t)(16 * (wid & 3) + (lane >> 2)) * 1024 + (wid >> 2) * 32 + (lane & 3) * 8;
    const unsigned kdst = lds0 + L_K + wid * 1024, k2dst = lds0 + L_K + (8 + (wid & 3)) * 1024, vdst = lds0 + L_V + wid * 1024;
#define AT_DMA(t, s) do { AT_DMA1(t, s); if (MK_E1) AT_DMA1(t, s); } while (0)
#define AT_DMA1(t, s) do { glds16(ksrc + (size_t)(t) * 64 * 1024, (unsigned)__builtin_amdgcn_readfirstlane(kdst + (s) * KSLOT)); \
        if (KIND == 0 && wid < 4) glds16(k2src + (size_t)(t) * 64 * 32, (unsigned)__builtin_amdgcn_readfirstlane(k2dst + (s) * KSLOT)); \
        glds16(vsrc + (size_t)(t) * 64 * 1024, (unsigned)__builtin_amdgcn_readfirstlane(vdst + (s) * VSLOT)); } while (0)
    const int grp = (MK_GRP_ODD) ? (wid & 1) : (wid >> 2);
#define AT_DMA_K(t, s) glds16(ksrc + (size_t)(t) * 64 * 1024, (unsigned)__builtin_amdgcn_readfirstlane(kdst + (s) * KSLOT))
#define AT_DMA_K2(t, s) do { if (KIND == 0 && wid < 4) glds16(k2src + (size_t)(t) * 64 * 32, (unsigned)__builtin_amdgcn_readfirstlane(k2dst + (s) * KSLOT)); } while (0)
#define AT_DMA_V(t, s) glds16(vsrc + (size_t)(t) * 64 * 1024, (unsigned)__builtin_amdgcn_readfirstlane(vdst + (s) * VSLOT))
    AT_DMA(T0, 0);
    LAS float* tab = (LAS float*)(lds + L_TAB);
    if (KIND == 1) { if (tid < 320) tab[tid] = T.relb[h * 257 + (tid > 256 ? 256 : tid)] * LOG2E; }
    bf16x8 qr[NQ];
    {   const bf16_t* Qw = (KIND == 0 ? T.qm + (size_t)qrow * 768 + h * 96 : T.qb + (size_t)qrow * 512 + h * 64) + (size_t)r32 * (KIND == 0 ? 768 : 512) + hi * 8;
#pragma unroll
        for (int d0 = 0; d0 < NQ; ++d0) qr[d0] = active ? *(const bf16x8*)(Qw + d0 * 16) : (bf16x8){0, 0, 0, 0, 0, 0, 0, 0}; }
#pragma unroll
    for (int d0 = 0; d0 < NQ; ++d0) asm volatile("" : "+v"(qr[d0]));
    AT_DMA(T0 + 1, 1); AT_DMA(T0 + 2, 2);
#define AT_WAIT_TILES(n) do { if ((n) == 2) asm volatile("s_waitcnt vmcnt(4)" ::: "memory"); else if ((n) == 1) asm volatile("s_waitcnt vmcnt(2)" ::: "memory"); else asm volatile("s_waitcnt vmcnt(0)" ::: "memory"); } while (0)
    AT_WAIT_TILES(2);
    AT_BAR();
    LAS float* wsf = (LAS float*)(lds + L_WS) + wid * 64;
    const int vboff = ((lane >> 4) & 1) * 32 + (lane & 3) * 8 + (4 * hi + ((lane & 15) >> 2)) * 64;
    float m_ref = 0.f, l_run = 0.f; bool first = true; f32x16 o[2]; o[0] = f32x16{}; o[1] = f32x16{};
    const float cbfar = (KIND == 1) ? tab[256] : 0.f;
    f32x16 negn = f32x16{}, negf;
#pragma unroll
    for (int r = 0; r < 16; ++r) negf[r] = cbfar;
    const int aq = 32 * (wid & 1) + r32;
    bf16x8 kf[2 * NQ]; s16x4 vf[16];
    f32x16 p0, p1;
    if (grp == 1) { AT_WAIT_TILES(1); AT_DMA(T0 + 3, 3); }
    if (active && T0 >= vlo) kload<NQ>(kf, (LAS const char*)(lds + L_K), r32, hi);
    if (grp == 1) AT_BAR();
#define AT_PK(d, k) (bf16x8){vf[d * 8 + 2 * k][0], vf[d * 8 + 2 * k][1], vf[d * 8 + 2 * k][2], vf[d * 8 + 2 * k][3], vf[d * 8 + 2 * k + 1][0], vf[d * 8 + 2 * k + 1][1], vf[d * 8 + 2 * k + 1][2], vf[d * 8 + 2 * k + 1][3]}
#define AT_TILE(ST, j, GR) do { \
        const int sc = (j - T0) & 3; \
        const bool vis = ST || (active && j >= vlo && j <= vhi); \
        const bool visn = ST || (active && j + 1 >= vlo && j + 1 <= vhi && j + 1 < T1); \
        const bool issA = ((GR) == 0) && (ST || j + 3 < T1), issB = ((GR) == 1) && (ST || j + 4 < T1); \
        if ((GR) == 0) { if (ST || j + 2 < T1) AT_WAIT_TILES(1); else AT_WAIT_TILES(0); if (issA && !vis) AT_DMA(j + 3, (sc + 3) & 3); } \
        if (vis) { \
            const int jd = cq - j; \
            vload(vf, (LAS const char*)(lds + L_V + sc * VSLOT) + vboff); \
            __builtin_amdgcn_sched_barrier(0); \
            if (KIND == 1 && (ST || jd >= 3)) { p0 = AT_MFMA(kf[0], qr[0], negf); p1 = AT_MFMA(kf[1], qr[0], negf); asm volatile("" ::: "memory"); } \
            else { p0 = AT_MFMA(kf[0], qr[0], negn); p1 = AT_MFMA(kf[1], qr[0], negn); asm volatile("" ::: "memory"); } \
            __builtin_amdgcn_sched_barrier(0); if (issA) AT_DMA_K(j + 3, (sc + 3) & 3); __builtin_amdgcn_sched_barrier(0); \
            p0 = AT_MFMA(kf[2], qr[1], p0); p1 = AT_MFMA(kf[3], qr[1], p1); \
            __builtin_amdgcn_sched_barrier(0); if (issA) AT_DMA_V(j + 3, (sc + 3) & 3); __builtin_amdgcn_sched_barrier(0); \
            p0 = AT_MFMA(kf[4], qr[2], p0); p1 = AT_MFMA(kf[5], qr[2], p1); \
            __builtin_amdgcn_sched_barrier(0); if (issA) AT_DMA_K2(j + 3, (sc + 3) & 3); __builtin_amdgcn_sched_barrier(0); \
_Pragma("unroll") \
            for (int d0 = 3; d0 < NQ; ++d0) { p0 = AT_MFMA(kf[2 * d0], qr[d0], p0); p1 = AT_MFMA(kf[2 * d0 + 1], qr[d0], p1); } \
            if (KIND == 1 && !ST && jd < 3) { LAS const float* tb = tab + (64 * jd + aq + 128 - 4 * hi - 27 - 32); \
_Pragma("unroll") \
                for (int r = 0; r < 16; ++r) { const int c = 27 - ((r & 3) + 8 * (r >> 2)); p0[r] += tb[32 + c]; p1[r] += tb[c]; } } \
            if (!ST && samp && j == T1 - 1) { \
_Pragma("unroll") \
                for (int r = 0; r < 16; ++r) p1[r] = -INFINITY; \
                asm volatile("" : "+v"(p1)); } \
            asm volatile("s_nop 15\n\ts_nop 7" : "+v"(p0), "+v"(p1)); \
            const float rm = rowmax3(p0, p1); \
            const bool fst = !ST && first; \
            if (fst || __any(rm > 8.0f)) { \
                const float dl = fst ? rm : fmaxf(rm, 0.f); \
                m_ref += dl; \
_Pragma("unroll") \
                for (int r = 0; r < 16; ++r) { p0[r] -= dl; p1[r] -= dl; } \
_Pragma("unroll") \
                for (int r = 0; r < 16; ++r) { negn[r] = -m_ref; negf[r] = cbfar - m_ref; } \
                asm volatile("" : "+v"(negn), "+v"(negf)); \
                if (!fst) { \
                    const float alpha = __builtin_amdgcn_exp2f(-dl); l_run *= alpha; \
                    if (hi == 0) wsf[r32] = alpha; \
_Pragma("unroll") \
                    for (int r = 0; r < 16; ++r) { const float a = wsf[crow(r, hi)]; o[0][r] *= a; o[1][r] *= a; } \
                } \
                first = false; \
            } \
        } \
        AT_BAR(); \
        if ((GR) == 1) { if (ST || j + 3 < T1) AT_WAIT_TILES(1); else AT_WAIT_TILES(0); if (issB && !vis) AT_DMA(j + 4, sc); } \
        if (visn) kload<NQ>(kf, (LAS const char*)(lds + L_K + ((sc + 1) & 3) * KSLOT), r32, hi); \
        __builtin_amdgcn_sched_barrier(0); \
        if (vis) { \
            float sacc = 0.f; \
_Pragma("unroll") \
            for (int r = 0; r < 16; ++r) { p0[r] = __builtin_amdgcn_exp2f(p0[r]); p1[r] = __builtin_amdgcn_exp2f(p1[r]); sacc += p0[r] + p1[r]; } \
            l_run += sacc; \
            u32x4 w0, w1, w2, w3; \
            w0 = (u32x4){pk_bf16(p0[0], p0[1]), pk_bf16(p0[2], p0[3]), pk_bf16(p0[4], p0[5]), pk_bf16(p0[6], p0[7])}; \
            w1 = (u32x4){pk_bf16(p0[8], p0[9]), pk_bf16(p0[10], p0[11]), pk_bf16(p0[12], p0[13]), pk_bf16(p0[14], p0[15])}; \
            w2 = (u32x4){pk_bf16(p1[0], p1[1]), pk_bf16(p1[2], p1[3]), pk_bf16(p1[4], p1[5]), pk_bf16(p1[6], p1[7])}; \
            w3 = (u32x4){pk_bf16(p1[8], p1[9]), pk_bf16(p1[10], p1[11]), pk_bf16(p1[12], p1[13]), pk_bf16(p1[14], p1[15])}; \
            __builtin_amdgcn_sched_barrier(0); \
            {   const bf16x8 pa0 = __builtin_bit_cast(bf16x8, w0), pa1 = __builtin_bit_cast(bf16x8, w1), pa2 = __builtin_bit_cast(bf16x8, w2), pa3 = __builtin_bit_cast(bf16x8, w3); \
                o[0] = AT_MFMA(pa0, AT_PK(0, 0), o[0]); o[1] = AT_MFMA(pa0, AT_PK(1, 0), o[1]); \
                __builtin_amdgcn_sched_barrier(0); if (issB) AT_DMA_K(j + 4, sc); __builtin_amdgcn_sched_barrier(0); \
                o[0] = AT_MFMA(pa1, AT_PK(0, 1), o[0]); o[1] = AT_MFMA(pa1, AT_PK(1, 1), o[1]); \
                __builtin_amdgcn_sched_barrier(0); if (issB) AT_DMA_V(j + 4, sc); __builtin_amdgcn_sched_barrier(0); \
                o[0] = AT_MFMA(pa2, AT_PK(0, 2), o[0]); o[1] = AT_MFMA(pa2, AT_PK(1, 2), o[1]); \
                __builtin_amdgcn_sched_barrier(0); if (issB) AT_DMA_K2(j + 4, sc); __builtin_amdgcn_sched_barrier(0); \
                o[0] = AT_MFMA(pa3, AT_PK(0, 3), o[0]); o[1] = AT_MFMA(pa3, AT_PK(1, 3), o[1]); \
            } \
        } \
        AT_BAR(); \
    } while (0)
    int js = T1, je = T1;
    if (active) { js = vlo + 1; int jl = vhi - 1; if (T1 - 5 < jl) jl = T1 - 5; if (KIND == 1 && cq - 3 < jl) jl = cq - 3; je = jl + 1; if (js > T1) js = T1; if (je < js) je = js; }
    int j = T0;
    for (; j < js; ++j) AT_TILE(false, j, grp);
    const int jeA = (grp == 0) ? je : js;
    for (; j < jeA; ++j) AT_TILE(true, j, 0);
    for (; j < je; ++j) AT_TILE(true, j, 1);
    for (; j < T1; ++j) AT_TILE(false, j, grp);
#undef AT_TILE
#undef AT_PK
    const int colb = KIND * 512 + h * 64;
    u32x4 gpre[4];
    if (active) {
#pragma unroll
        for (int i = 0; i < 4; ++i) gpre[i] = __builtin_nontemporal_load((const u32x4*)(T.sg + (size_t)(qrow + i * 8 + (lane >> 3)) * 1024 + colb + (lane & 7) * 8)); }
    if (grp == 0) AT_BAR();
    if (active) {
        { auto rr = __builtin_amdgcn_permlane32_swap(__float_as_uint(l_run), __float_as_uint(l_run), false, false); l_run = __uint_as_float(rr[0]) + __uint_as_float(rr[1]); }
        if (hi == 0) wsf[32 + r32] = l_run;
        LAS bf16_t* stg = (LAS bf16_t*)(lds + L_OST) + wid * 2048;
#pragma unroll
        for (int r = 0; r < 16; ++r) { const int orow = crow(r, hi); const float rl = __builtin_amdgcn_rcpf(wsf[32 + orow]);
#pragma unroll
            for (int d0 = 0; d0 < 2; ++d0) stg[orow * 64 + d0 * 32 + r32] = (bf16_t)(pk_bf16(o[d0][r] * rl, 0.f) & 0xffffu); }
#pragma unroll
        for (int i = 0; i < 4; ++i) { const int row = i * 8 + (lane >> 3), ch = lane & 7;
            const u32x4 v = *(LAS const u32x4*)(stg + row * 64 + ch * 8);
            const size_t gi = (size_t)(qrow + row) * 1024 + colb + ch * 8;
            const u32x4 g = gpre[i]; u32x4 w;
            w.x = pk_bf16(bf_lo(v.x) * bf_lo(g.x), bf_hi(v.x) * bf_hi(g.x)); w.y = pk_bf16(bf_lo(v.y) * bf_lo(g.y), bf_hi(v.y) * bf_hi(g.y));
            w.z = pk_bf16(bf_lo(v.z) * bf_lo(g.z), bf_hi(v.z) * bf_hi(g.z)); w.w = pk_bf16(bf_lo(v.w) * bf_lo(g.w), bf_hi(v.w) * bf_hi(g.w));
            *(u32x4*)(T.y + gi) = w; }
    }
#undef AT_DMA
#undef AT_DMA_K
#undef AT_DMA_K2
#undef AT_DMA_V
#undef AT_WAIT_TILES
#undef AT_DMA1
}
constexpr int NU_MS = 64, NU_MP = 1024, NU_BP = 1024, NU_BS = 64, NU_G4S = 4, NU_TOT = NU_MS + NU_MP + NU_BP + NU_BS + NU_G4S;
constexpr int IDX_G4S = NU_MS + NU_BS + 13 * 64;
__device__ __forceinline__ void run_unit(const Tens& T, int idx, LAS unsigned char* lds) {
    int kind, seq, h, u;
    if (idx < NU_MS) { kind = 0; seq = 8 + (idx >> 3); h = idx & 7; u = 0; }
    else if (idx < NU_MS + NU_BS) { const int i = idx - NU_MS; kind = 1; seq = 8 + (i >> 3); h = i & 7; u = 0; }
    else if (idx < IDX_G4S) { const int i = idx - NU_MS - NU_BS; kind = 0; u = 15 - i / 64; seq = (i % 64) >> 3; h = i & 7; }
    else if (idx < IDX_G4S + NU_G4S + NU_BP) { const int i = idx - IDX_G4S - NU_G4S; kind = 1; u = 15 - i / 64; seq = (i % 64) >> 3; h = i & 7; }
    else { const int i = idx - IDX_G4S - NU_G4S - NU_BP; kind = 0; u = 2 - i / 64; seq = (i % 64) >> 3; h = i & 7; }
    if (kind == 0) unit<0>(T, seq, h, u, lds); else unit<1>(T, seq, h, u, lds);
}
}

__device__ __forceinline__ void tr_item(const float* W, int N, int srccol0, int K, bf16_t* WT, int destrow0, int k0, LAS float* scr, int lane) {
    float tv[32];
#pragma unroll
    for (int i = 0; i < 32; ++i) { const int kk = 2 * i + (lane >> 5); tv[i] = srccol0 >= 0 ? __builtin_nontemporal_load(W + (size_t)(k0 + kk) * N + srccol0 + (lane & 31)) : 0.f; }
#pragma unroll
    for (int i = 0; i < 32; ++i) { const int kk = 2 * i + (lane >> 5); scr[kk * 33 + (lane & 31)] = tv[i]; }
    const int c = lane & 7;
#pragma unroll
    for (int j = 0; j < 4; ++j) { const int n = (lane >> 3) + 8 * j; const LAS float* s = scr + (8 * c) * 33 + n;
        u32x4 o; o.x = pk_bf16(s[0 * 33], s[1 * 33]); o.y = pk_bf16(s[2 * 33], s[3 * 33]); o.z = pk_bf16(s[4 * 33], s[5 * 33]); o.w = pk_bf16(s[6 * 33], s[7 * 33]);
        *(u32x4*)(WT + (size_t)(destrow0 + n) * K + k0 + 8 * c) = o; }
}
__device__ __forceinline__ int win_src(int ng) {
    if (ng < 8) return OFF_CQ + 32 * ng;
    if (ng < 12) return OFF_CKV + 32 * (ng - 8);
    if (ng == 12) return OFF_KR;
    if (ng < 16) return -1;
    if (ng < 32) return OFF_GA + 32 * (ng - 16);
    if (ng < 48) return OFF_GB + 32 * (ng - 32);
    if (ng < 64) return OFF_QB + 32 * (ng - 48);
    if (ng < 80) return OFF_KB + 32 * (ng - 64);
    return OFF_VB + 32 * (ng - 80);
}
__device__ __forceinline__ void sincos_d(double a, float& s, float& c) {
    const double twopi = 6.283185307179586476925286766559;
    const double k = __builtin_rint(a / twopi); const double r = a - k * twopi; const double r2 = r * r;
    double ts = 1.0, tc = 1.0;
#pragma unroll 1
    for (int n = 29; n >= 3; n -= 2) { ts = 1.0 - ts * r2 / (double)(n * (n - 1)); tc = 1.0 - tc * r2 / (double)(n * (n + 1)); }
    s = (float)(r * ts); c = (float)(1.0 - tc * r2 * 0.5);
}


__device__ __forceinline__ void xn_rows4(int mb, const float* x_p, const float* x_s, const float* g_mix, bf16_t* XN, int lane) {
    f32x4 v[4][4]; float s[4];
#pragma unroll
    for (int q = 0; q < 4; ++q) { const int m = mb + q; const float* xr = (m < MP) ? x_p + (size_t)m * DM : x_s + (size_t)(m - MP) * DM;
#pragma unroll
        for (int j = 0; j < 4; ++j) v[q][j] = __builtin_nontemporal_load((const f32x4*)(xr + 4 * lane + 256 * j)); }
#pragma unroll
    for (int q = 0; q < 4; ++q) { s[q] = 0.f;
#pragma unroll
        for (int j = 0; j < 4; ++j) s[q] += (v[q][j][0] * v[q][j][0] + v[q][j][1] * v[q][j][1]) + (v[q][j][2] * v[q][j][2] + v[q][j][3] * v[q][j][3]);
        s[q] = 1.0f / sqrtf(wave_sum(s[q]) * (1.0f / DM) + EPS); }
#pragma unroll
    for (int j = 0; j < 4; ++j) { const f32x4 g = *(const f32x4*)(g_mix + 4 * lane + 256 * j);
#pragma unroll
        for (int q = 0; q < 4; ++q) { const f32x4 o = v[q][j] * s[q] * g; u32x2 w; w.x = pk_bf16(o[0], o[1]); w.y = pk_bf16(o[2], o[3]); *(u32x2*)(XN + (size_t)(mb + q) * DM + 4 * lane + 256 * j) = w; } }
}
__device__ __forceinline__ void rope_entry(float* rope, int pos, int f) {
    const double inv = exp2(-(double)f * (13.287712379549449 / 16.0));
    float s, c; sincos_d((double)pos * inv, s, c); rope[pos * 32 + f] = c; rope[pos * 32 + 16 + f] = s;
}

__device__ __forceinline__ void grid_bar(unsigned* cnt, unsigned target) {
    asm volatile("s_waitcnt vmcnt(0)" ::: "memory");
    __syncthreads();
    if (threadIdx.x == 0) {
        __builtin_amdgcn_fence(__ATOMIC_RELEASE, "agent");
        asm volatile("s_waitcnt vmcnt(0)" ::: "memory");
        __hip_atomic_fetch_add(cnt, 1u, __ATOMIC_RELAXED, __HIP_MEMORY_SCOPE_AGENT);
        unsigned spins = 0;
        while (__hip_atomic_load(cnt, __ATOMIC_RELAXED, __HIP_MEMORY_SCOPE_AGENT) < target) { __builtin_amdgcn_s_sleep(2); if (++spins > (1u << 22)) break; }
        __builtin_amdgcn_fence(__ATOMIC_ACQUIRE, "agent");
        asm volatile("s_waitcnt vmcnt(0)" ::: "memory");
    }
    __syncthreads();
}
#define XB_TMO      128
#define XB_XCNT(j)  (256  + 64 * (j))
#define XB_XSUB(j)  (1280 + 64 * (j))
#define XB_XGEN(j)  (2304 + 64 * (j))
#define XB_TOP      3328
#define XB_TOPGEN   3392
#define XCD_BAR_WORDS 3456
#define XB_SPIN_CAP (1u << 18)

__device__ __forceinline__ unsigned xb_ld(unsigned* p)              { return __hip_atomic_load(p, __ATOMIC_RELAXED, __HIP_MEMORY_SCOPE_AGENT); }
__device__ __forceinline__ unsigned xb_add(unsigned* p, unsigned v) { return __hip_atomic_fetch_add(p, v, __ATOMIC_RELAXED, __HIP_MEMORY_SCOPE_AGENT); }
__device__ __forceinline__ unsigned xb_xcc_id() { return (unsigned)__builtin_amdgcn_s_getreg((3 << 11) | 20) & 0xFu; }
#define XB_SPIN(cond, bar) do { unsigned _sp = 0; while (cond) { __builtin_amdgcn_s_sleep(1); \
    if ((++_sp & 255u) == 0u) { if (xb_ld(&(bar)[XB_TMO])) break; if (_sp > XB_SPIN_CAP) { atomicAdd(&(bar)[XB_TMO], 1u); break; } } } } while (0)

struct XcdBarrier {
    unsigned* bar; unsigned x;
    volatile LAS unsigned* st;
};

__device__ __forceinline__ XcdBarrier xcd_barrier_post(unsigned* bar, volatile LAS unsigned* st) {
    XcdBarrier b; b.bar = bar; b.x = xb_xcc_id(); b.st = st;
    if (threadIdx.x == 0) (void)xb_add(&bar[XB_XCNT(b.x)], 1u);
    return b;
}
__device__ __forceinline__ void xcd_barrier_complete(unsigned* bar, unsigned x, unsigned& nloc, unsigned& nx) {
    const unsigned G = gridDim.x * gridDim.y * gridDim.z;
    unsigned sum, cnt, mine, sp = 0u;
    for (;;) {
        sum = 0u; cnt = 0u; mine = 0u;
#pragma unroll
        for (unsigned j = 0; j < 16; ++j) { const unsigned c = xb_ld(&bar[XB_XCNT(j)]); sum += c; cnt += (c > 0u) ? 1u : 0u; mine = (j == x) ? c : mine; }
        if (sum == G) break;
        __builtin_amdgcn_s_sleep(1);
        if ((++sp & 255u) == 0u) { if (xb_ld(&bar[XB_TMO])) break; if (sp > XB_SPIN_CAP) { atomicAdd(&bar[XB_TMO], 1u); break; } }
    }
    nloc = mine > 0u ? mine : 1u; nx = cnt > 0u ? cnt : 1u;
}

__device__ __forceinline__ void xcd_barrier(const XcdBarrier& b) {
    asm volatile("s_waitcnt vmcnt(0)" ::: "memory");
    __syncthreads();
    if (threadIdx.x == 0) {
        unsigned* bar = b.bar;
        __builtin_amdgcn_s_waitcnt(0);
        unsigned nloc = b.st[0], nx = b.st[1];
        if (nloc == 0u) { xcd_barrier_complete(bar, b.x, nloc, nx); b.st[0] = nloc; b.st[1] = nx; }
        const unsigned old = xb_add(&bar[XB_XSUB(b.x)], 1u);
        const unsigned gen = old / nloc;
        if (old + 1u == (gen + 1u) * nloc) {
            __builtin_amdgcn_fence(__ATOMIC_RELEASE, "agent");
            asm volatile("s_waitcnt vmcnt(0)" ::: "memory");
            const unsigned og = xb_add(&bar[XB_TOP], 1u);
            const unsigned tg = og / nx;
            if (og + 1u == (tg + 1u) * nx) xb_add(&bar[XB_TOPGEN], 1u);
            else XB_SPIN(xb_ld(&bar[XB_TOPGEN]) == tg, bar);
            __builtin_amdgcn_fence(__ATOMIC_ACQUIRE, "agent");
            xb_add(&bar[XB_XGEN(b.x)], 1u);
            asm volatile("s_waitcnt vmcnt(0)" ::: "memory");
        } else {
            XB_SPIN(xb_ld(&bar[XB_XGEN(b.x)]) == gen, bar);
            __builtin_amdgcn_fence(__ATOMIC_ACQUIRE, "agent");
            asm volatile("s_waitcnt vmcnt(0)" ::: "memory");
        }
    }
    __syncthreads();
}

struct Params { const float* in[16]; float* out; unsigned char* ws; int lo, hi, coop, pad; };

__global__ void __launch_bounds__(512, 2) mk_fwd(Params P) {
    extern __shared__ __attribute__((aligned(16))) unsigned char lds_raw[];
    LAS unsigned char* lds = (LAS unsigned char*)lds_raw;
    const int G = gridDim.x, NGW = G * 8;
#define PHASE_IDS() int tid_l = threadIdx.x; asm volatile("" : "+v"(tid_l)); const int tid = tid_l, lane = tid & 63; const int wave = __builtin_amdgcn_readfirstlane(tid >> 6); const int gw = blockIdx.x * 8 + wave; (void)lane; (void)gw
    unsigned char* ws = P.ws; float* out = P.out;
    const float *x_p = P.in[0], *x_s = P.in[1], *c_ckv = P.in[2], *c_kpe = P.in[3], *c_kb = P.in[4], *c_vb = P.in[5], *w_in = P.in[6], *g_mix = P.in[7], *g_cq = P.in[8],
                *w_uq = P.in[9], *g_ckv = P.in[10], *w_uk = P.in[11], *w_uv = P.in[12], *relb = P.in[13], *w_out = P.in[14], *g_fin = P.in[15];
    unsigned* ctl = (unsigned*)(ws + WS_CTL); float* rope = (float*)(ws + WS_ROPE);
    bf16_t *Win = (bf16_t*)(ws + WS_WIN), *Wuq = (bf16_t*)(ws + WS_WUQ), *Wukv = (bf16_t*)(ws + WS_WUKV), *Wout = (bf16_t*)(ws + WS_WOUT), *XN = (bf16_t*)(ws + WS_XN),
           *ZCQ = (bf16_t*)(ws + WS_ZCQ), *CQ = (bf16_t*)(ws + WS_CQ), *CKV = (bf16_t*)(ws + WS_CKV), *KPE = (bf16_t*)(ws + WS_KPE), *SG = (bf16_t*)(ws + WS_SG),
           *QB = (bf16_t*)(ws + WS_QB), *KVB = (bf16_t*)(ws + WS_KVB), *QM = (bf16_t*)(ws + WS_QM), *KVM = (bf16_t*)(ws + WS_KVM), *Y = (bf16_t*)(ws + WS_Y);
    float* ZCKV = (float*)(ws + WS_ZCKV);
    const int lo = P.lo, hi = P.hi;
#ifndef MK_PHMASK
#define MK_PHMASK 0xff
#endif
#define PH(k) (((MK_PHMASK >> (k)) & 1) && lo <= (k) && (k) < hi)
#ifndef MK_REP
#define MK_REP -1
#endif
#define REP(k) for (int rep_ = 0; rep_ < ((MK_REP) == (k) ? 2 : 1); ++rep_)
    { volatile LAS unsigned* misc = (volatile LAS unsigned*)(lds + LDS_RING + 32); if (threadIdx.x < 2) misc[threadIdx.x] = 0u; __syncthreads(); }
    const XcdBarrier xbar = xcd_barrier_post(ctl + 1024, (volatile LAS unsigned*)(lds + LDS_RING + 32));
#define SEAM(k) do { if (PH(k) && PH((k) + 1)) { if (P.coop == 2) cg::this_grid().sync(); else xcd_barrier(xbar); } } while (0)

    if (PH(0)) REP(0) {
        PHASE_IDS();
        LAS float* scr = (LAS float*)(lds + wave * 8448);
        for (int it = gw; it < 96 * 16; it += NGW) { const int ng = it / 16, kb = it % 16; tr_item(w_in, IN_W, win_src(ng), 1024, Win, 32 * ng, 64 * kb, scr, lane); }
        for (int mb = gw * 4; mb < M1; mb += NGW * 4) xn_rows4(mb, x_p, x_s, g_mix, XN, lane);
        const int gt = blockIdx.x * 512 + tid, NGT = G * 512;
        for (int i = gt; i < (PAST + TS) * 16; i += NGT) rope_entry(rope, i >> 4, i & 15);
    }
    SEAM(0);
#ifdef MK_XSYNC
    for (int i_ = 0; i_ < MK_XSYNC; ++i_) xcd_barrier(xbar);
#endif
    if (PH(1)) REP(1) {
        pg8::Gemm g{XN, Win, M1, NIN, 1024}; pg8::StaticOrder S; S.init(M1, NIN, G, (int)blockIdx.x);
        EpiG1 E{ZCQ, KPE, SG, QB, KVB, ZCKV, out, rope};
        pg8::gemm_phase<EpiG1, pg8::StaticOrder, true, true>(lds, g, S, E);
        {   PHASE_IDS();
            const int nlast = (M1 / 256 * (NIN / 256)) % G;
            const int nsb = (nlast > 0 && nlast * 2 < G) ? nlast : 0;
            if ((int)blockIdx.x >= nsb) {
                LAS float* scr = (LAS float*)(lds + wave * 8448);
                const int gwp = ((int)blockIdx.x - nsb) * 8 + wave, NGWP = (G - nsb) * 8;
                constexpr int I_UQ = 24 * 4, I_UKV = 32 * 2, I_OUT = 32 * 16, I_TOT = I_UQ + I_UKV + I_OUT;
                for (int it = gwp; it < I_TOT; it += NGWP) {
                    int r = it;
                    if (r < I_UQ) { const int ng = r / 4, kb = r % 4; const int src = ng < 16 ? (ng >> 1) * 96 + 32 * (ng & 1) : (ng - 16) * 96 + 64; tr_item(w_uq, 768, src, 256, Wuq, 32 * ng, 64 * kb, scr, lane); continue; } r -= I_UQ;
                    if (r < I_UKV) { const int ng = r / 2, kb = r % 2; tr_item(ng < 16 ? w_uk : w_uv, 512, 32 * (ng & 15), 128, Wukv, 32 * ng, 64 * kb, scr, lane); continue; } r -= I_UKV;
                    { const int ng = r / 16, kb = r % 16; tr_item(w_out, 1024, 32 * ng, 1024, Wout, 32 * ng, 64 * kb, scr, lane); }
                }
                const int gt = ((int)blockIdx.x - nsb) * 512 + tid, NGT = (G - nsb) * 512;
#pragma unroll 4
        for (int i = gt; i < NB * PAST * 32; i += NGT) { const int r = i >> 5, c = (i & 31) * 4; const int bb = r >> 12, p = r & 4095;
            const f32x4 v = __builtin_nontemporal_load((const f32x4*)(c_ckv + (size_t)r * 128 + c)); u32x2 w; w.x = pk_bf16(v[0], v[1]); w.y = pk_bf16(v[2], v[3]);
            *(u32x2*)(CKV + (size_t)(MP + bb * KVS + p) * 128 + c) = w; }
        for (int i = gt; i < NB * PAST * 8; i += NGT) { const int r = i >> 3, c = (i & 7) * 4; const int bb = r >> 12, p = r & 4095;
            const f32x4 v = __builtin_nontemporal_load((const f32x4*)(c_kpe + (size_t)r * 32 + c)); u32x2 w; w.x = pk_bf16(v[0], v[1]); w.y = pk_bf16(v[2], v[3]);
            *(u32x2*)(KPE + (size_t)(MP + bb * KVS + p) * 32 + c) = w; }
#pragma unroll 2
        for (int i = gt; i < NB * 512 * 128; i += NGT) { const int r = i >> 7, c = (i & 127) * 4; const int bb = r >> 9, p = r & 511;
            const f32x4 kv = __builtin_nontemporal_load((const f32x4*)(c_kb + (size_t)r * 512 + c)), vv = __builtin_nontemporal_load((const f32x4*)(c_vb + (size_t)r * 512 + c));
            u32x2 w; w.x = pk_bf16(kv[0], kv[1]); w.y = pk_bf16(kv[2], kv[3]); bf16_t* d = KVB + (size_t)(MP + bb * BVS + p) * 1024 + c; *(u32x2*)d = w;
            w.x = pk_bf16(vv[0], vv[1]); w.y = pk_bf16(vv[2], vv[3]); *(u32x2*)(d + 512) = w; }
        for (int i = gt; i < NB * 32 * 32; i += NGT) { const int r = i >> 5, c = (i & 31) * 4; *(u32x2*)(CKV + (size_t)(MP + (r >> 5) * KVS + PAST + 32 + (r & 31)) * 128 + c) = (u32x2){0u, 0u}; }
        for (int i = gt; i < NB * 32 * 8; i += NGT) { const int r = i >> 3, c = (i & 7) * 4; *(u32x2*)(KPE + (size_t)(MP + (r >> 5) * KVS + PAST + 32 + (r & 31)) * 32 + c) = (u32x2){0u, 0u}; }
        for (int i = gt; i < NB * 32 * 256; i += NGT) { const int r = i >> 8, c = (i & 255) * 4; *(u32x2*)(KVB + (size_t)(MP + (r >> 5) * BVS + 512 + 32 + (r & 31)) * 1024 + c) = (u32x2){0u, 0u}; }
            }
        }
    }
    SEAM(1);
    if (PH(2)) REP(2) {
        PHASE_IDS();
        for (int mb = gw * 4; mb < M1; mb += NGW * 4) {
            u32x2 wq[4]; f32x2 vk[4];
#pragma unroll
            for (int q = 0; q < 4; ++q) { wq[q] = __builtin_nontemporal_load((const u32x2*)(ZCQ + (size_t)(mb + q) * 256 + 4 * lane)); vk[q] = __builtin_nontemporal_load((const f32x2*)(ZCKV + (size_t)(mb + q) * 128 + 2 * lane)); }
            const f32x4 gq = *(const f32x4*)(g_cq + 4 * lane); const f32x2 gk = *(const f32x2*)(g_ckv + 2 * lane);
#pragma unroll
            for (int q = 0; q < 4; ++q) { const int m = mb + q;
                f32x4 v = {bf_lo(wq[q].x), bf_hi(wq[q].x), bf_lo(wq[q].y), bf_hi(wq[q].y)};
                const float rq = 1.0f / sqrtf(wave_sum((v[0] * v[0] + v[1] * v[1]) + (v[2] * v[2] + v[3] * v[3])) * (1.0f / 256.0f) + EPS);
                v = v * rq * gq; u32x2 o; o.x = pk_bf16(v[0], v[1]); o.y = pk_bf16(v[2], v[3]); *(u32x2*)(CQ + (size_t)m * 256 + 4 * lane) = o;
                f32x2 k = vk[q];
                const float rk = 1.0f / sqrtf(wave_sum(k[0] * k[0] + k[1] * k[1]) * (1.0f / 128.0f) + EPS);
                k = k * rk * gk;
                float* po = (m < MP) ? out + O_CKVP + (size_t)m * 128 : out + O_CKVS + (size_t)(m - MP) * 128; *(f32x2*)(po + 2 * lane) = k;
                *(unsigned*)(CKV + (size_t)kvrow_m(m) * 128 + 2 * lane) = pk_bf16(k[0], k[1]); }
        }
    }
    SEAM(2);
    if (PH(3)) REP(3) {
        { pg8::Gemm g{CQ, Wuq, M1, 768, 256}; pg8::StaticOrder S; S.init(M1, 768, G, (int)blockIdx.x); EpiG2 E{QM, rope};
          pg8::gemm_phase<EpiG2, pg8::StaticOrder, true, true>(lds, g, S, E); }
    }
    if (PH(4)) REP(4) {
        { pg8::Gemm g{CKV, Wukv, KVR, 1024, 128}; SkewOrder S; S.init(KVR, 1024, G, (int)blockIdx.x, (KVR / 256 * 4) / G, (M1 / 256 * 3) % G);
          EpiPlain E{KVM, 1024};
          pg8::gemm_phase<EpiPlain, SkewOrder, true, true>(lds, g, S, E); }
    }
    SEAM(4);
    if (PH(5)) REP(5) {
        PHASE_IDS();
        const at::Tens T{QM, QB, KVM, KVB, KPE, SG, Y, relb};
        LAS volatile unsigned* sidx = (LAS volatile unsigned*)(lds + at::L_IDX);
        unsigned nxt = 0; if (tid == 0) nxt = atomicAdd(ctl + rep_, 1u);
        for (;;) {
            if (tid == 0) sidx[0] = nxt;
            __syncthreads();
            const int idx = (int)sidx[0];
            if (idx >= at::NU_TOT) break;
            if (tid == 0) nxt = atomicAdd(ctl + rep_, 1u);
            if (idx >= at::IDX_G4S && idx < at::IDX_G4S + at::NU_G4S) {
                if (tid == 0) { unsigned sp = 0; while (__hip_atomic_load(ctl + 2, __ATOMIC_RELAXED, __HIP_MEMORY_SCOPE_AGENT) < 128u) { __builtin_amdgcn_s_sleep(4); if (++sp > (1u << 22)) break; }
                    __builtin_amdgcn_fence(__ATOMIC_ACQUIRE, "agent"); asm volatile("s_waitcnt vmcnt(0)" ::: "memory"); }
                __syncthreads();
                pg8::Gemm g{Y, Wout, M1, 1024, 1024}; OneUnit S1{MP / 256, idx - at::IDX_G4S}; EpiG4 E{x_p, x_s, out, (bf16_t*)(ws + WS_X1), (float*)(ws + WS_SSQ)};
                pg8::gemm_phase<EpiG4, OneUnit, false, true>(lds, g, S1, E);
                continue;
            }
            at::run_unit(T, idx, lds);
            if (idx < at::NU_MS + at::NU_BS) {
                asm volatile("s_waitcnt vmcnt(0)" ::: "memory"); __syncthreads();
                if (tid == 0) { __builtin_amdgcn_fence(__ATOMIC_RELEASE, "agent"); asm volatile("s_waitcnt vmcnt(0)" ::: "memory"); __hip_atomic_fetch_add(ctl + 2, 1u, __ATOMIC_RELAXED, __HIP_MEMORY_SCOPE_AGENT); }
            }
        }
    }
    SEAM(5);
    if (PH(6)) REP(6) {
        pg8::Gemm g{Y, Wout, MP, 1024, 1024}; pg8::StaticOrder S; S.init(MP, 1024, G, (int)blockIdx.x); EpiG4 E{x_p, x_s, out, (bf16_t*)(ws + WS_X1), (float*)(ws + WS_SSQ)};
        pg8::gemm_phase<EpiG4, pg8::StaticOrder, true, true>(lds, g, S, E);
    }
    SEAM(6);
    if (PH(7)) {
        PHASE_IDS();
        const bf16_t* X1 = (const bf16_t*)(ws + WS_X1); const float* SSQ = (const float*)(ws + WS_SSQ);
        for (int mb = gw * 4; mb < MP; mb += NGW * 4) {
            float sp[4]; u32x4 w[4][2];
#pragma unroll
            for (int q = 0; q < 4; ++q) { sp[q] = lane < 16 ? SSQ[(size_t)(mb + q) * 16 + lane] : 0.f;
#pragma unroll
                for (int j = 0; j < 2; ++j) w[q][j] = __builtin_nontemporal_load((const u32x4*)(X1 + (size_t)(mb + q) * DM + 8 * lane + 512 * j)); }
#pragma unroll
            for (int q = 0; q < 4; ++q) sp[q] = 1.0f / sqrtf(wave_sum(sp[q]) * (1.0f / DM) + EPS);
#pragma unroll
            for (int j = 0; j < 2; ++j) { const int c = 8 * lane + 512 * j; const f32x4 g0 = *(const f32x4*)(g_fin + c), g1 = *(const f32x4*)(g_fin + c + 4);
#pragma unroll
                for (int q = 0; q < 4; ++q) { const u32x4 ww = w[q][j];
                    const f32x4 a = {bf_lo(ww.x), bf_hi(ww.x), bf_lo(ww.y), bf_hi(ww.y)}, b = {bf_lo(ww.z), bf_hi(ww.z), bf_lo(ww.w), bf_hi(ww.w)};
                    *(f32x4*)(out + (size_t)(mb + q) * DM + c) = a * sp[q] * g0; *(f32x4*)(out + (size_t)(mb + q) * DM + c + 4) = b * sp[q] * g1; } }
        }
        for (int m = MP + gw; m < M1; m += NGW) {
            float* xr = out + (size_t)m * DM; f32x4 v[4]; float s = 0.f;
#pragma unroll
            for (int j = 0; j < 4; ++j) { v[j] = *(const f32x4*)(xr + 4 * lane + 256 * j); s += (v[j][0] * v[j][0] + v[j][1] * v[j][1]) + (v[j][2] * v[j][2] + v[j][3] * v[j][3]); }
            const float rstd = 1.0f / sqrtf(wave_sum(s) * (1.0f / DM) + EPS);
#pragma unroll
            for (int j = 0; j < 4; ++j) { const f32x4 g = *(const f32x4*)(g_fin + 4 * lane + 256 * j); *(f32x4*)(xr + 4 * lane + 256 * j) = v[j] * rstd * g; }
        }
    }
#undef PH
#undef SEAM
}

constexpr int NPH = 8;
extern "C" void kernel_launch(void* const* d_in, const int* in_sizes, int n_in, void* d_out, int out_size, void* d_ws, size_t ws_size, hipStream_t stream) {
    static int grid = 0;
    if (grid == 0) {
        if (n_in != 16 || (size_t)out_size != O_END || ws_size < WS_END) { fprintf(stderr, "kernel_launch: unexpected shapes (n_in %d out %d ws %zu need %zu)\n", n_in, out_size, ws_size, (size_t)WS_END); grid = -1; return; }
        int dev = 0, cus = 0, per_cu = 0;
        hipGetDevice(&dev); hipDeviceGetAttribute(&cus, hipDeviceAttributeMultiprocessorCount, dev);
        hipFuncSetAttribute((const void*)mk_fwd, hipFuncAttributeMaxDynamicSharedMemorySize, LDS_TOTAL);
        hipOccupancyMaxActiveBlocksPerMultiprocessor(&per_cu, (const void*)mk_fwd, 512, LDS_TOTAL);
        (void)hipGetLastError();
        if (per_cu < 1) per_cu = 1;
        grid = cus * per_cu;
        if (grid > 256) grid = 256;
    }
    if (grid < 0) return;
    if (hipMemsetAsync(d_ws, 0, 32768, stream) != hipSuccess) { fprintf(stderr, "memset failed\n"); return; }
    Params p{};
    for (int i = 0; i < 16; ++i) p.in[i] = (const float*)d_in[i];
    p.out = (float*)d_out; p.ws = (unsigned char*)d_ws;
#if MK_COOP
    p.lo = 0; p.hi = NPH; p.coop = 1;
    void* args[] = {&p};
    hipError_t e = hipLaunchCooperativeKernel((const void*)mk_fwd, dim3(grid), dim3(512), args, LDS_TOTAL, stream);
    if (e != hipSuccess) fprintf(stderr, "cooperative launch failed: %s (grid %d)\n", hipGetErrorString(e), grid);
#else
    for (int ph = 0; ph < NPH; ++ph) { p.lo = ph; p.hi = ph + 1; p.coop = 0; hipLaunchKernelGGL(mk_fwd, dim3(grid), dim3(512), LDS_TOTAL, stream, p); }
#endif
}
```

```cpp
#include <hip/hip_runtime.h>
#include <hip/hip_bf16.h>
#include <hip/hip_cooperative_groups.h>
#include <cstdio>
#include <cstdint>
#include <type_traits>
namespace cg = cooperative_groups;
#ifndef MK_COOP
#define MK_COOP 1
#endif

namespace pg8 {
#define PG8_LAS __attribute__((address_space(3)))
typedef unsigned short bf16_t;
typedef short bf16x8 __attribute__((ext_vector_type(8)));
typedef float f32x4 __attribute__((ext_vector_type(4)));
typedef unsigned u32x4 __attribute__((ext_vector_type(4)));
constexpr int BM = 256, BK = 64, HALF = 128, HTB = HALF * BK * 2  , STAGE_BYTES = 8 * HTB, NXCD = 8, WGM = 8;

__host__ __device__ __forceinline__ int lds_byte(int r, int c) { const int st = (r >> 4) * 2 + (c >> 5), rr = r & 15, cc = c & 31, ob = rr * 64 + cc * 2; return st * 1024 + (ob ^ (((ob >> 9) & 1) << 5)); }
__host__ __device__ __forceinline__ void stage_rc(int b, int& R, int& C) { const int st = b / 1024, sb = b % 1024, swz = sb ^ (((sb >> 9) & 1) << 5); R = (st >> 1) * 16 + swz / 64; C = (st & 1) * 32 + (swz % 64) / 2; }
__host__ __device__ __forceinline__ int perm32(int rho) { const int n = rho >> 4, i = rho & 15; return 8 * (i >> 2) + 4 * n + (i & 3); }

struct Unit { int pm, pn; };
struct Gemm { const bf16_t* A; const bf16_t* Bt; int M, N, K; };

struct StaticOrder {
    int nM, nN, nwg, G, c;
    __host__ __device__ void init(int M, int N, int G_, int c_) { nM = M / BM; nN = N / BM; nwg = nM * nN; G = G_; c = c_; }
    __host__ __device__ bool next(int i, Unit& u) const {
        const long L = (long)i * G + c; if (L >= nwg) return false;
        int wgid = (int)L; { const int q = nwg / NXCD, r = nwg % NXCD, xcd = wgid % NXCD, off = wgid / NXCD; wgid = (xcd < r ? xcd * (q + 1) : r * (q + 1) + (xcd - r) * q) + off; }
        const int nig = WGM * nN, gid = wgid / nig, fm = gid * WGM, gsz = (nM - fm) < WGM ? (nM - fm) : WGM;
        u.pm = fm + ((wgid % nig) % gsz); u.pn = (wgid % nig) / gsz; return true;
    }
    __device__ __forceinline__ void a_ready(const Unit&) const {}
    __device__ __forceinline__ void done(const Unit&) const {}
};

__device__ __forceinline__ unsigned cvt_pk_bf16(float lo, float hi) { unsigned r; asm volatile("v_cvt_pk_bf16_f32 %0, %1, %2" : "=v"(r) : "v"(lo), "v"(hi)); return r; }
typedef float f32x2 __attribute__((ext_vector_type(2)));
template <class Epi, class Sched, bool ALIGN_EPI = false, bool SP2 = false>
__device__ __forceinline__ void gemm_phase(PG8_LAS unsigned char* lds, const Gemm g, const Sched& S, const Epi& E) {
    int tid_l = threadIdx.x; asm volatile("" : "+v"(tid_l));
    const int tid = tid_l, wid = __builtin_amdgcn_readfirstlane(tid >> 6), lane = tid & 63, wr = wid >> 2, wc = wid & 3, fr = lane & 15, fq = lane >> 4;
    int K_l = g.K; asm volatile("" : "+s"(K_l));
    const int K = K_l, nt = K / BK;
    unsigned voffA[2], voffB[2];
#pragma unroll
    for (int i = 0; i < 2; ++i) { int R, C; stage_rc(tid * 16 + i * 8192, R, C); const int Rb = Epi::PERM ? ((R & ~31) + perm32(R & 31)) : R;
        voffA[i] = (unsigned)(R * K + C) * 2u; voffB[i] = (unsigned)(Rb * K + C) * 2u; }
    const size_t kstep = (size_t)(BK * 2);
    const size_t hstep = (size_t)HALF * K * 2;
    const size_t tstep = 2 * hstep;
    const unsigned ldsw = (unsigned)wid * 1024u;
    const int aoff = lds_byte(wr * 64 + fr, fq * 8), boff = lds_byte(wc * 32 + fr, fq * 8);
#define PG8_SA(b, h) (((b) * 2 + (h)) * HTB)
#define PG8_SB(b, h) ((4 + (b) * 2 + (h)) * HTB)
#define PG8_STAGE(bufoff, gbase, voff) do { _Pragma("unroll") for (int _i = 0; _i < 2; ++_i) \
        __builtin_amdgcn_global_load_lds((const unsigned*)((const char*)(gbase) + (voff)[_i]), (PG8_LAS unsigned*)(lds + (bufoff) + ldsw + _i * 8192), 16, 0, 0); } while (0)
#define PG8_LDA(dst, b, h) do { _Pragma("unroll") for (int m = 0; m < 4; ++m) _Pragma("unroll") for (int k = 0; k < 2; ++k) dst[m][k] = *(const PG8_LAS bf16x8*)(lds + PG8_SA(b, h) + aoff + m * 2048 + k * 1024); } while (0)
#define PG8_LDB(dst, b, h) do { _Pragma("unroll") for (int n = 0; n < 2; ++n) _Pragma("unroll") for (int k = 0; k < 2; ++k) dst[n][k] = *(const PG8_LAS bf16x8*)(lds + PG8_SB(b, h) + boff + n * 2048 + k * 1024); } while (0)
#define PG8_MMA(ai, bj, At, Bt) do { __builtin_amdgcn_s_setprio(1); _Pragma("unroll") for (int m = 0; m < 4; ++m) _Pragma("unroll") for (int n = 0; n < 2; ++n) _Pragma("unroll") for (int k = 0; k < 2; ++k) \
        acc[ai][bj][m][n] = __builtin_amdgcn_mfma_f32_16x16x32_bf16(Bt[n][k], At[m][k], acc[ai][bj][m][n], 0, 0, 0); __builtin_amdgcn_s_setprio(0); } while (0)
#define PG8_WAIT_V(n) asm volatile("s_waitcnt vmcnt(" #n ")" ::: "memory")
#define PG8_WAIT_L(n) asm volatile("s_waitcnt lgkmcnt(" #n ")" ::: "memory")
#define PG8_BAR __builtin_amdgcn_s_barrier()
#define PG8_SCHED __builtin_amdgcn_sched_barrier(0)
    Unit cur, nxt; int ui = 0;
    if (!S.next(0, cur)) return;
    f32x4 acc[2][2][4][2];
#pragma unroll
    for (int a = 0; a < 2; ++a)
#pragma unroll
        for (int b = 0; b < 2; ++b)
#pragma unroll
            for (int m = 0; m < 4; ++m)
#pragma unroll
                for (int n = 0; n < 2; ++n) acc[a][b][m][n] = (f32x4){0.f, 0.f, 0.f, 0.f};
    bf16x8 At[4][2], B0[2][2], B1[2][2];
    const char* cA = (const char*)g.A + (size_t)cur.pm * tstep; const char* cB = (const char*)g.Bt + (size_t)cur.pn * tstep;
    S.a_ready(cur);
    if constexpr (SP2) {
        PG8_STAGE(PG8_SB(0, 0), cB, voffB); PG8_STAGE(PG8_SB(0, 1), cB + hstep, voffB); PG8_STAGE(PG8_SA(0, 0), cA, voffA); PG8_STAGE(PG8_SA(0, 1), cA + hstep, voffA);
        if (wr == 1) PG8_BAR;
        PG8_WAIT_V(2); PG8_BAR;
        PG8_STAGE(PG8_SB(1, 0), cB + kstep, voffB); PG8_STAGE(PG8_SA(1, 0), cA + kstep, voffA); PG8_STAGE(PG8_SB(1, 1), cB + hstep + kstep, voffB);
        PG8_WAIT_V(6); PG8_BAR;
    } else {
        PG8_STAGE(PG8_SB(0, 0), cB, voffB); PG8_STAGE(PG8_SA(0, 0), cA, voffA); PG8_STAGE(PG8_SB(0, 1), cB + hstep, voffB); PG8_STAGE(PG8_SA(0, 1), cA + hstep, voffA);
        if (wr == 1) PG8_BAR;
        PG8_WAIT_V(4); PG8_BAR;
        PG8_STAGE(PG8_SB(1, 0), cB + kstep, voffB); PG8_STAGE(PG8_SA(1, 0), cA + kstep, voffA); PG8_STAGE(PG8_SB(1, 1), cB + hstep + kstep, voffB);
        PG8_WAIT_V(6); PG8_BAR;
    }
    for (;;) {
        const bool has_next = S.next(ui + 1, nxt);
        const char* nA = has_next ? (const char*)g.A + (size_t)nxt.pm * tstep : cA; const char* nB = has_next ? (const char*)g.Bt + (size_t)nxt.pn * tstep : cB;
        for (int t = 0; t < nt; t += 2) {
            const bool last = (t == nt - 2);
            const char* a1 = cA + (size_t)(t + 1) * kstep;
            const char* a2 = last ? nA : cA + (size_t)(t + 2) * kstep; const char* b2 = last ? nB : cB + (size_t)(t + 2) * kstep;
            const char* a3 = a2 + kstep; const char* b3 = b2 + kstep;
            if (last && has_next) S.a_ready(nxt);
            if constexpr (SP2) {
            PG8_LDB(B0, 0, 0); PG8_LDB(B1, 0, 1); PG8_SCHED; PG8_LDA(At, 0, 0); PG8_STAGE(PG8_SA(1, 1), a1 + hstep, voffA);
            PG8_WAIT_V(8); PG8_WAIT_L(0); PG8_BAR; PG8_MMA(0, 0, At, B0); PG8_MMA(0, 1, At, B1); PG8_BAR; PG8_SCHED;
            PG8_LDA(At, 0, 1); PG8_STAGE(PG8_SB(0, 0), b2, voffB); PG8_STAGE(PG8_SB(0, 1), b2 + hstep, voffB); PG8_STAGE(PG8_SA(0, 0), a2, voffA);
            PG8_WAIT_V(8); PG8_WAIT_L(0); PG8_BAR; PG8_MMA(1, 0, At, B0); PG8_MMA(1, 1, At, B1); PG8_BAR; PG8_SCHED;
            PG8_LDB(B0, 1, 0); PG8_LDB(B1, 1, 1); PG8_SCHED; PG8_LDA(At, 1, 0); PG8_STAGE(PG8_SA(0, 1), a2 + hstep, voffA);
            PG8_WAIT_V(8); PG8_WAIT_L(0); PG8_BAR; PG8_MMA(0, 0, At, B0); PG8_MMA(0, 1, At, B1); PG8_BAR; PG8_SCHED;
            PG8_LDA(At, 1, 1); PG8_STAGE(PG8_SB(1, 0), b3, voffB); PG8_STAGE(PG8_SB(1, 1), b3 + hstep, voffB); PG8_STAGE(PG8_SA(1, 0), a3, voffA);
            PG8_WAIT_V(8); PG8_WAIT_L(0); PG8_BAR; PG8_MMA(1, 0, At, B0); PG8_MMA(1, 1, At, B1); PG8_BAR; PG8_SCHED;
            } else {
            PG8_LDB(B0, 0, 0); PG8_SCHED; PG8_LDA(At, 0, 0); PG8_STAGE(PG8_SA(1, 1), a1 + hstep, voffA);
            PG8_WAIT_L(8); PG8_BAR; PG8_WAIT_L(0); PG8_MMA(0, 0, At, B0); PG8_BAR; PG8_SCHED;
            PG8_LDB(B1, 0, 1); PG8_STAGE(PG8_SB(0, 0), b2, voffB);
            PG8_BAR; PG8_WAIT_L(0); PG8_MMA(0, 1, At, B1); PG8_BAR;
            PG8_LDA(At, 0, 1); PG8_STAGE(PG8_SA(0, 0), a2, voffA);
            PG8_BAR; PG8_WAIT_L(0); PG8_MMA(1, 0, At, B0); PG8_BAR; PG8_SCHED;
            PG8_STAGE(PG8_SB(0, 1), b2 + hstep, voffB);
            PG8_WAIT_V(6); PG8_BAR; PG8_MMA(1, 1, At, B1); PG8_BAR;
            PG8_LDB(B0, 1, 0); PG8_SCHED; PG8_LDA(At, 1, 0); PG8_STAGE(PG8_SA(0, 1), a2 + hstep, voffA);
            PG8_WAIT_L(8); PG8_BAR; PG8_WAIT_L(0); PG8_MMA(0, 0, At, B0); PG8_BAR; PG8_SCHED;
            PG8_LDB(B1, 1, 1); PG8_STAGE(PG8_SB(1, 0), b3, voffB);
            PG8_BAR; PG8_WAIT_L(0); PG8_MMA(0, 1, At, B1); PG8_BAR;
            PG8_LDA(At, 1, 1); PG8_STAGE(PG8_SA(1, 0), a3, voffA);
            PG8_BAR; PG8_WAIT_L(0); PG8_MMA(1, 0, At, B0); PG8_BAR; PG8_SCHED;
            PG8_STAGE(PG8_SB(1, 1), b3 + hstep, voffB);
            PG8_WAIT_V(6); PG8_BAR; PG8_MMA(1, 1, At, B1); PG8_BAR;
            }
        }
        if constexpr (ALIGN_EPI) { if (wr == 0) PG8_BAR; }
        if constexpr (!Epi::AFTER_DRAIN) { E(acc, cur, wr, wc, fr, fq); S.done(cur); }
        if (!has_next) break;
#pragma unroll
        for (int a = 0; a < 2; ++a)
#pragma unroll
            for (int b = 0; b < 2; ++b)
#pragma unroll
                for (int m = 0; m < 4; ++m)
#pragma unroll
                    for (int n = 0; n < 2; ++n) acc[a][b][m][n] = (f32x4){0.f, 0.f, 0.f, 0.f};
        cur = nxt; cA = nA; cB = nB; ++ui;
        if constexpr (ALIGN_EPI) { if (wr == 1) PG8_BAR; }
    }
    PG8_WAIT_V(0);
    if constexpr (!ALIGN_EPI) { if (wr == 0) PG8_BAR; }
    PG8_BAR;
    if constexpr (Epi::AFTER_DRAIN) { E.fused(acc, cur, wr, wc, fr, fq, lds, wid, lane); S.done(cur); }
#undef PG8_SA
#undef PG8_SB
#undef PG8_STAGE
#undef PG8_LDA
#undef PG8_LDB
#undef PG8_MMA
#undef PG8_WAIT_V
#undef PG8_WAIT_L
#undef PG8_BAR
#undef PG8_SCHED
}
}

#define LAS __attribute__((address_space(3)))
typedef unsigned short bf16_t;
typedef short bf16x8 __attribute__((ext_vector_type(8)));
typedef short s16x4 __attribute__((ext_vector_type(4)));
typedef float f32x4 __attribute__((ext_vector_type(4)));
typedef float f32x2 __attribute__((ext_vector_type(2)));
typedef float f32x16 __attribute__((ext_vector_type(16)));
typedef unsigned u32x4 __attribute__((ext_vector_type(4)));
typedef unsigned u32x2 __attribute__((ext_vector_type(2)));

constexpr int DM = 1024, SEQ = 4096, NB = 8, TS = 32, PAST = 4096;
constexpr int MP = NB * SEQ, MS = NB * TS, M1 = MP + MS;
constexpr int KVS = PAST + 64, KVR = MP + NB * KVS;
constexpr int BVS = 512 + 64, BVR = MP + NB * BVS;
constexpr int NIN = 3072;
constexpr float EPS = 1e-6f, LOG2E = 1.4426950408889634f;
constexpr float QS_MLA = 0.10206207261596575f * LOG2E;
constexpr float QS_B = 0.125f * LOG2E;
constexpr int OFF_CQ = 0, OFF_CKV = 256, OFF_KR = 384, OFF_GA = 416, OFF_QB = 928, OFF_KB = 1440, OFF_VB = 1952, OFF_GB = 2464, IN_W = 2976;
constexpr size_t O_YP = 0, O_YS = O_YP + (size_t)MP * DM, O_CKVP = O_YS + (size_t)MS * DM, O_KPEP = O_CKVP + (size_t)MP * 128,
                 O_KBP = O_KPEP + (size_t)MP * 32, O_VBP = O_KBP + (size_t)NB * 512 * 512, O_CKVS = O_VBP + (size_t)NB * 512 * 512,
                 O_KPES = O_CKVS + (size_t)MS * 128, O_KBS = O_KPES + (size_t)MS * 32, O_VBS = O_KBS + (size_t)MS * 512, O_END = O_VBS + (size_t)MS * 512;
constexpr size_t al256(size_t x) { return (x + 255) & ~(size_t)255; }
constexpr size_t WS_CTL = 0, WS_ROPE = 32768, WS_WIN = al256(WS_ROPE + (size_t)(PAST + TS) * 32 * 4), WS_WUQ = WS_WIN + (size_t)NIN * 1024 * 2,
                 WS_WUKV = WS_WUQ + (size_t)768 * 256 * 2, WS_WOUT = WS_WUKV + (size_t)1024 * 128 * 2, WS_XN = WS_WOUT + (size_t)1024 * 1024 * 2,
                 WS_CQ = WS_XN + (size_t)M1 * 1024 * 2, WS_CKV = WS_CQ + (size_t)M1 * 256 * 2, WS_KPE = WS_CKV + (size_t)KVR * 128 * 2,
                 WS_SG = WS_KPE + (size_t)KVR * 32 * 2, WS_QB = WS_SG + (size_t)M1 * 1024 * 2, WS_KVB = WS_QB + (size_t)M1 * 512 * 2,
                 WS_QM = WS_KVB + (size_t)BVR * 1024 * 2, WS_KVM = WS_QM + (size_t)M1 * 768 * 2, WS_END = WS_KVM + (size_t)KVR * 1024 * 2;
constexpr size_t WS_Y = WS_XN;
constexpr size_t WS_ZCQ = WS_QM, WS_ZCKV = WS_QM + (size_t)M1 * 256 * 2;
static_assert(WS_ZCKV + (size_t)M1 * 128 * 4 <= WS_KVM, "overlay");
constexpr size_t WS_X1 = WS_KVM, WS_SSQ = WS_QM;

constexpr int LDS_RING = 131072, LDS_TOTAL = LDS_RING + 1024;

__device__ __forceinline__ unsigned pk_bf16(float lo, float hi) { f32x2 v = {lo, hi}; typedef __bf16 bf2 __attribute__((ext_vector_type(2))); bf2 b = __builtin_convertvector(v, bf2); return __builtin_bit_cast(unsigned, b); }
__device__ __forceinline__ float bf_lo(unsigned w) { return __builtin_bit_cast(float, w << 16); }
__device__ __forceinline__ float bf_hi(unsigned w) { return __builtin_bit_cast(float, w & 0xffff0000u); }
__device__ __forceinline__ u32x4 pk8(const f32x4 a, const f32x4 b) { u32x4 w; w.x = pk_bf16(a[0], a[1]); w.y = pk_bf16(a[2], a[3]); w.z = pk_bf16(b[0], b[1]); w.w = pk_bf16(b[2], b[3]); return w; }
__device__ __forceinline__ float wave_sum(float v) {
#pragma unroll
    for (int o = 1; o < 64; o <<= 1) v += __shfl_xor(v, o);
    return v;
}
__device__ __forceinline__ int kvrow_m(int row) { if (row < MP) return row; const int r = row - MP; return MP + (r >> 5) * KVS + PAST + (r & 31); }
__device__ __forceinline__ int kvrow_b(int row) { if (row < MP) return row; const int r = row - MP; return MP + (r >> 5) * BVS + 512 + (r & 31); }
__device__ __forceinline__ int pos_of(int row) { if (row < MP) return row & (SEQ - 1); return PAST + ((row - MP) & 31); }

__device__ __forceinline__ void rope8(f32x4& v0, f32x4& v1, const float* rp  , int fq) {
    const int i0 = 8 * (fq & 1);
    const f32x4 c0 = *(const f32x4*)(rp + i0), c1 = *(const f32x4*)(rp + i0 + 4), s0 = *(const f32x4*)(rp + 16 + i0), s1 = *(const f32x4*)(rp + 16 + i0 + 4);
    f32x4 p0, p1;
#pragma unroll
    for (int j = 0; j < 4; ++j) { p0[j] = __shfl_xor(v0[j], 32); p1[j] = __shfl_xor(v1[j], 32); }
    if (fq < 2) { v0 = v0 * c0 - p0 * s0; v1 = v1 * c1 - p1 * s1; }
    else        { v0 = p0 * s0 + v0 * c0; v1 = p1 * s1 + v1 * c1; }
}
__device__ __forceinline__ float silu_f(float g) { return g * __builtin_amdgcn_rcpf(1.0f + __builtin_amdgcn_exp2f(-g * LOG2E)); }

struct EpiG1 {
    static constexpr bool PERM = true, AFTER_DRAIN = false;
    bf16_t *zcq, *kpe, *sg, *qb, *kvb; float* zckv; float* out; const float* rope;
    __device__ __forceinline__ void operator()(const f32x4 (&acc)[2][2][4][2], const pg8::Unit& u, int wr, int wc, int fr, int fq) const {
        const int pn = u.pn, row0 = u.pm * 256 + wr * 64 + fr, cl = wc * 32 + 8 * fq;
        if (pn == 0) {
#pragma unroll
            for (int ai = 0; ai < 2; ++ai)
#pragma unroll
                for (int m = 0; m < 4; ++m) { const int row = row0 + ai * 128 + m * 16;
#pragma unroll
                    for (int bj = 0; bj < 2; ++bj) *(u32x4*)(zcq + (size_t)row * 256 + bj * 128 + cl) = pk8(acc[ai][bj][m][0], acc[ai][bj][m][1]); }
        } else if (pn == 1) {
#pragma unroll
            for (int ai = 0; ai < 2; ++ai)
#pragma unroll
                for (int m = 0; m < 4; ++m) { const int row = row0 + ai * 128 + m * 16; float* p = zckv + (size_t)row * 128 + cl;
                    *(f32x4*)p = acc[ai][0][m][0]; *(f32x4*)(p + 4) = acc[ai][0][m][1]; }
            if (wc == 0) {
#pragma unroll
                for (int ai = 0; ai < 2; ++ai)
#pragma unroll
                    for (int m = 0; m < 4; ++m) { const int row = row0 + ai * 128 + m * 16; f32x4 v0 = acc[ai][1][m][0], v1 = acc[ai][1][m][1];
                        rope8(v0, v1, rope + (size_t)pos_of(row) * 32, fq);
                        float* po = (row < MP) ? out + O_KPEP + (size_t)row * 32 + 8 * fq : out + O_KPES + (size_t)(row - MP) * 32 + 8 * fq;
                        *(f32x4*)po = v0; *(f32x4*)(po + 4) = v1;
                        *(u32x4*)(kpe + (size_t)kvrow_m(row) * 32 + 8 * fq) = pk8(v0, v1); asm volatile("" ::: "memory"); }
            }
        } else if (pn < 6) {
            const int cb = (pn - 2) * 256 + cl;
#pragma unroll
            for (int ai = 0; ai < 2; ++ai)
#pragma unroll
                for (int m = 0; m < 4; ++m) { const int row = row0 + ai * 128 + m * 16;
#pragma unroll
                    for (int bj = 0; bj < 2; ++bj) { f32x4 a = acc[ai][bj][m][0], b = acc[ai][bj][m][1];
#pragma unroll
                        for (int j = 0; j < 4; ++j) { a[j] = silu_f(a[j]); b[j] = silu_f(b[j]); }
                        __builtin_nontemporal_store(pk8(a, b), (u32x4*)(sg + (size_t)row * 1024 + cb + bj * 128)); } }
        } else if (pn < 8) {
            const int cb = (pn - 6) * 256 + cl;
#pragma unroll
            for (int ai = 0; ai < 2; ++ai)
#pragma unroll
                for (int m = 0; m < 4; ++m) { const int row = row0 + ai * 128 + m * 16;
#pragma unroll
                    for (int bj = 0; bj < 2; ++bj) __builtin_nontemporal_store(pk8(acc[ai][bj][m][0] * QS_B, acc[ai][bj][m][1] * QS_B), (u32x4*)(qb + (size_t)row * 512 + cb + bj * 128)); }
        } else if (pn < 12) {
            const int cb = (pn - 8) * 256 + cl;
            const bool isv = pn >= 10; const int co = cb - (isv ? 512 : 0);
#pragma unroll
            for (int ai = 0; ai < 2; ++ai)
#pragma unroll
                for (int m = 0; m < 4; ++m) { const int row = row0 + ai * 128 + m * 16;
                    float* po = nullptr;
                    if (row < MP) { const int s = row & (SEQ - 1); if (s >= SEQ - 512) po = out + (isv ? O_VBP : O_KBP) + ((size_t)(row >> 12) * 512 + (s - (SEQ - 512))) * 512 + co; }
                    else po = out + (isv ? O_VBS : O_KBS) + (size_t)(row - MP) * 512 + co;
                    bf16_t* pk = kvb + (size_t)kvrow_b(row) * 1024 + cb;
#pragma unroll
                    for (int bj = 0; bj < 2; ++bj) { *(u32x4*)(pk + bj * 128) = pk8(acc[ai][bj][m][0], acc[ai][bj][m][1]);
                        if (po) { *(f32x4*)(po + bj * 128) = acc[ai][bj][m][0]; *(f32x4*)(po + bj * 128 + 4) = acc[ai][bj][m][1]; } } }
        }
    }
};
__device__ __forceinline__ void rope8t(f32x4& v0, f32x4& v1, const f32x4 c0, const f32x4 c1, const f32x4 s0, const f32x4 s1, int fq) {
    f32x4 p0, p1;
#pragma unroll
    for (int j = 0; j < 4; ++j) { p0[j] = __shfl_xor(v0[j], 32); p1[j] = __shfl_xor(v1[j], 32); }
    if (fq < 2) { v0 = v0 * c0 - p0 * s0; v1 = v1 * c1 - p1 * s1; }
    else        { v0 = p0 * s0 + v0 * c0; v1 = p1 * s1 + v1 * c1; }
}
struct EpiG2 {
    static constexpr bool PERM = true, AFTER_DRAIN = false;
    bf16_t* qm; const float* rope;
    __device__ __forceinline__ void operator()(const f32x4 (&acc)[2][2][4][2], const pg8::Unit& u, int wr, int wc, int fr, int fq) const {
        const int pn = u.pn, row0 = u.pm * 256 + wr * 64 + fr;
        if (pn < 2) {
#pragma unroll
            for (int ai = 0; ai < 2; ++ai)
#pragma unroll
                for (int m = 0; m < 4; ++m) { const int row = row0 + ai * 128 + m * 16;
#pragma unroll
                    for (int bj = 0; bj < 2; ++bj) { const int n = pn * 256 + bj * 128 + wc * 32 + 8 * fq; const int dc = (n >> 6) * 96 + (n & 63);
                        __builtin_nontemporal_store(pk8(acc[ai][bj][m][0] * QS_MLA, acc[ai][bj][m][1] * QS_MLA), (u32x4*)(qm + (size_t)row * 768 + dc)); } }
        } else {
            const int i0 = 8 * (fq & 1);
#pragma unroll
            for (int ai = 0; ai < 2; ++ai)
#pragma unroll
                for (int mp = 0; mp < 4; mp += 2) {
                    f32x4 c0[2], c1[2], s0[2], s1[2];
#pragma unroll
                    for (int q = 0; q < 2; ++q) { const float* rp = rope + (size_t)pos_of(row0 + ai * 128 + (mp + q) * 16) * 32 + i0;
                        c0[q] = *(const f32x4*)rp; c1[q] = *(const f32x4*)(rp + 4); s0[q] = *(const f32x4*)(rp + 16); s1[q] = *(const f32x4*)(rp + 20); }
#pragma unroll
                    for (int q = 0; q < 2; ++q) { const int m = mp + q, row = row0 + ai * 128 + m * 16;
#pragma unroll
                        for (int bj = 0; bj < 2; ++bj) { f32x4 v0 = acc[ai][bj][m][0], v1 = acc[ai][bj][m][1];
                            rope8t(v0, v1, c0[q], c1[q], s0[q], s1[q], fq);
                            __builtin_nontemporal_store(pk8(v0 * QS_MLA, v1 * QS_MLA), (u32x4*)(qm + (size_t)row * 768 + (bj * 4 + wc) * 96 + 64 + 8 * fq)); } }
                    asm volatile("" ::: "memory");
                }
        }
    }
};
struct EpiPlain {
    static constexpr bool PERM = true, AFTER_DRAIN = false;
    bf16_t* O; int ldc;
    __device__ __forceinline__ void operator()(const f32x4 (&acc)[2][2][4][2], const pg8::Unit& u, int wr, int wc, int fr, int fq) const {
        const int row0 = u.pm * 256 + wr * 64 + fr, col0 = u.pn * 256 + wc * 32 + 8 * fq;
#pragma unroll
        for (int ai = 0; ai < 2; ++ai)
#pragma unroll
            for (int m = 0; m < 4; ++m) { bf16_t* p = O + (size_t)(row0 + ai * 128 + m * 16) * ldc + col0;
#pragma unroll
                for (int bj = 0; bj < 2; ++bj) *(u32x4*)(p + bj * 128) = pk8(acc[ai][bj][m][0], acc[ai][bj][m][1]); }
    }
};
struct EpiG4 {
    static constexpr bool PERM = true, AFTER_DRAIN = false;
    const float *xp, *xs; float* out; bf16_t* x1; float* ssq;
    __device__ __forceinline__ void operator()(const f32x4 (&acc)[2][2][4][2], const pg8::Unit& u, int wr, int wc, int fr, int fq) const {
        const int row0 = u.pm * 256 + wr * 64 + fr, col0 = u.pn * 256 + wc * 32 + 8 * fq;
        if (u.pm < MP / 256) {
#pragma unroll
            for (int ai = 0; ai < 2; ++ai) {
                f32x4 xr[4][2][2];
#pragma unroll
                for (int m = 0; m < 4; ++m) { const float* px = xp + (size_t)(row0 + ai * 128 + m * 16) * 1024 + col0;
#pragma unroll
                    for (int bj = 0; bj < 2; ++bj) { xr[m][bj][0] = __builtin_nontemporal_load((const f32x4*)(px + bj * 128)); xr[m][bj][1] = __builtin_nontemporal_load((const f32x4*)(px + bj * 128 + 4)); } }
#pragma unroll
                for (int m = 0; m < 4; ++m) { const int row = row0 + ai * 128 + m * 16; bf16_t* po = x1 + (size_t)row * 1024 + col0; float s = 0.f;
#pragma unroll
                    for (int bj = 0; bj < 2; ++bj) { const f32x4 a = xr[m][bj][0] + acc[ai][bj][m][0], b = xr[m][bj][1] + acc[ai][bj][m][1];
                        s += (a[0] * a[0] + a[1] * a[1]) + (a[2] * a[2] + a[3] * a[3]) + (b[0] * b[0] + b[1] * b[1]) + (b[2] * b[2] + b[3] * b[3]);
                        *(u32x4*)(po + bj * 128) = pk8(a, b); }
                    s += __shfl_xor(s, 16); s += __shfl_xor(s, 32);
                    if (fq == 0) ssq[(size_t)row * 16 + u.pn * 4 + wc] = s; }
                asm volatile("" ::: "memory");
            }
        } else {
#pragma unroll
            for (int ai = 0; ai < 2; ++ai)
#pragma unroll
                for (int m = 0; m < 4; ++m) { const int row = row0 + ai * 128 + m * 16;
                    const float* px = xs + (size_t)(row - MP) * 1024 + col0; float* po = out + (size_t)row * 1024 + col0;
#pragma unroll
                    for (int bj = 0; bj < 2; ++bj) { const f32x4 a = *(const f32x4*)(px + bj * 128), b = *(const f32x4*)(px + bj * 128 + 4);
                        *(f32x4*)(po + bj * 128) = a + acc[ai][bj][m][0]; *(f32x4*)(po + bj * 128 + 4) = b + acc[ai][bj][m][1]; } }
        }
    }
};

struct SkewOrder {
    int nM, nN, nwg, G, c, base_rounds, c0;
    __device__ void init(int M, int N, int G_, int c_, int br, int c0_) { nM = M / 256; nN = N / 256; nwg = nM * nN; G = G_; c = c_; base_rounds = br; c0 = c0_; }
    __device__ bool next(int i, pg8::Unit& u) const {
        long L;
        if (i < base_rounds) L = (long)i * G + c;
        else { if (c < c0) return false; L = (long)base_rounds * G + (long)(i - base_rounds) * (G - c0) + (c - c0); }
        if (L >= nwg) return false;
        int wgid = (int)L; { const int q = nwg / 8, r = nwg % 8, xcd = wgid % 8, off = wgid / 8; wgid = (xcd < r ? xcd * (q + 1) : r * (q + 1) + (xcd - r) * q) + off; }
        const int nig = 8 * nN, gid = wgid / nig, fm = gid * 8, gsz = (nM - fm) < 8 ? (nM - fm) : 8;
        u.pm = fm + ((wgid % nig) % gsz); u.pn = (wgid % nig) / gsz; return true;
    }
    __device__ __forceinline__ void a_ready(const pg8::Unit&) const {}
    __device__ __forceinline__ void done(const pg8::Unit&) const {}
};
struct OneUnit {
    int pm, pn;
    __device__ __forceinline__ bool next(int i, pg8::Unit& u) const { if (i > 0) return false; u.pm = pm; u.pn = pn; return true; }
    __device__ __forceinline__ void a_ready(const pg8::Unit&) const {}
    __device__ __forceinline__ void done(const pg8::Unit&) const {}
};
#ifndef MK_E1
#define MK_E1 0
#endif
#ifndef MK_E2
#define MK_E2 0
#endif
#ifndef MK_GRP_ODD
#define MK_GRP_ODD 0
#endif
namespace at {
constexpr int KSLOT = 12288, VSLOT = 8192;
constexpr int L_K = 0, L_V = 4 * KSLOT, L_WS = L_V + 4 * VSLOT, L_OST = L_WS + 8 * 256, L_TAB = L_OST + 8 * 4096, L_IDX = L_TAB + 1296, L_END = L_IDX + 16;
static_assert(L_END <= LDS_RING, "attention LDS");
__device__ __forceinline__ int crow(int r, int hi) { return (r & 3) + 8 * (r >> 2) + 4 * hi; }
__device__ __forceinline__ void glds16(const void* gsrc, unsigned lds_dst) { unsigned keep;
    asm volatile("s_mov_b32 %0, m0\n\ts_mov_b32 m0, %2\n\ts_nop 0\n\tglobal_load_lds_dwordx4 %1, off\n\ts_mov_b32 m0, %0" : "=&s"(keep) : "v"(gsrc), "s"(lds_dst) : "memory"); }
#define AT_WAITBAR() asm volatile("s_waitcnt vmcnt(0) lgkmcnt(0)\n\ts_barrier" ::: "memory")
#define AT_BAR() asm volatile("s_waitcnt lgkmcnt(0)\n\ts_barrier" ::: "memory")
#define AT_MFMA(a, b, c) __builtin_amdgcn_mfma_f32_32x32x16_bf16(a, b, c, 0, 0, 0)

template <int NQ> __device__ __forceinline__ void kload(bf16x8* kf, LAS const char* kslot, int r32, int hi) {
    LAS const char* kb = kslot + hi * 1024 + r32 * 16;
#pragma unroll
    for (int d0 = 0; d0 < NQ; ++d0) { kf[2 * d0] = *(LAS const bf16x8*)(kb + d0 * 2048); kf[2 * d0 + 1] = *(LAS const bf16x8*)(kb + d0 * 2048 + 512); }
}
template <int NQ> __device__ __forceinline__ void qkmm(f32x16& p0, f32x16& p1, const bf16x8* kf, const bf16x8* qr, const f32x16& cinit) {
#pragma unroll
    for (int d0 = 0; d0 < NQ; ++d0) {
        if (d0 == 0) { p0 = AT_MFMA(kf[0], qr[0], cinit); p1 = AT_MFMA(kf[1], qr[0], cinit); }
        else { p0 = AT_MFMA(kf[2 * d0], qr[d0], p0); p1 = AT_MFMA(kf[2 * d0 + 1], qr[d0], p1); }
    }
}
__device__ __forceinline__ float max3f(float a, float b, float c) { float r; asm("v_max3_f32 %0, %1, %2, %3" : "=v"(r) : "v"(a), "v"(b), "v"(c)); return r; }
__device__ __forceinline__ float max2f(float a, float b) { float r; asm("v_max_f32_e32 %0, %1, %2" : "=v"(r) : "v"(a), "v"(b)); return r; }
__device__ __forceinline__ float rowmax3(const f32x16& p0, const f32x16& p1) {
    float a = max3f(p0[0], p0[1], p1[0]), b = max3f(p0[2], p0[3], p1[1]); a = max3f(a, p1[2], p1[3]);
#pragma unroll
    for (int r = 4; r < 16; r += 4) { a = max3f(a, p0[r], p0[r + 1]); b = max3f(b, p0[r + 2], p0[r + 3]); a = max3f(a, p1[r], p1[r + 1]); b = max3f(b, p1[r + 2], p1[r + 3]); }
    const float m = max2f(a, b);
    auto rr = __builtin_amdgcn_permlane32_swap(__float_as_uint(m), __float_as_uint(m), false, false);
    return max2f(__uint_as_float(rr[0]), __uint_as_float(rr[1]));
}
__device__ __forceinline__ float rowmax(const f32x16& p0, const f32x16& p1) {
    float a = fmaxf(p0[0], p1[0]);
#pragma unroll
    for (int r = 1; r < 16; ++r) a = fmaxf(a, fmaxf(p0[r], p1[r]));
    auto rr = __builtin_amdgcn_permlane32_swap(__float_as_uint(a), __float_as_uint(a), false, false);
    return fmaxf(__uint_as_float(rr[0]), __uint_as_float(rr[1]));
}
typedef short v4i16_t __attribute__((ext_vector_type(4)));
__device__ __forceinline__ s16x4 vtr(LAS const char* p) { return __builtin_bit_cast(s16x4, __builtin_amdgcn_ds_read_tr16_b64_v4i16((LAS v4i16_t*)p)); }
__device__ __forceinline__ void vload(s16x4* vf, LAS const char* vp) {
#pragma unroll
    for (int d0 = 0; d0 < 2; ++d0)
#pragma unroll
        for (int ks = 0; ks < 4; ++ks) { vf[d0 * 8 + 2 * ks] = vtr(vp + d0 * 4096 + ks * 1024); vf[d0 * 8 + 2 * ks + 1] = vtr(vp + d0 * 4096 + ks * 1024 + 512); }
}
__device__ __forceinline__ void pvm(f32x16* o, const s16x4* vf, bf16x8 pa0, bf16x8 pa1, bf16x8 pa2, bf16x8 pa3) {
#define AT_PK(d, k) (bf16x8){vf[d * 8 + 2 * k][0], vf[d * 8 + 2 * k][1], vf[d * 8 + 2 * k][2], vf[d * 8 + 2 * k][3], vf[d * 8 + 2 * k + 1][0], vf[d * 8 + 2 * k + 1][1], vf[d * 8 + 2 * k + 1][2], vf[d * 8 + 2 * k + 1][3]}
    o[0] = AT_MFMA(pa0, AT_PK(0, 0), o[0]); o[1] = AT_MFMA(pa0, AT_PK(1, 0), o[1]);
    o[0] = AT_MFMA(pa1, AT_PK(0, 1), o[0]); o[1] = AT_MFMA(pa1, AT_PK(1, 1), o[1]);
    o[0] = AT_MFMA(pa2, AT_PK(0, 2), o[0]); o[1] = AT_MFMA(pa2, AT_PK(1, 2), o[1]);
    o[0] = AT_MFMA(pa3, AT_PK(0, 3), o[0]); o[1] = AT_MFMA(pa3, AT_PK(1, 3), o[1]);
#undef AT_PK
}

struct Tens { const bf16_t *qm, *qb, *kvm, *kvb, *kpe, *sg; bf16_t* y; const float* relb; };

template <int KIND> __device__ __forceinline__ void unit(const Tens& T, int seq, int h, int u, LAS unsigned char* lds) {
    constexpr int NQ = KIND == 0 ? 6 : 4;
    int tid_l = threadIdx.x; asm volatile("" : "+v"(tid_l));
    const int tid = tid_l, lane = tid & 63, r32 = lane & 31, hi = lane >> 5; const int wid = __builtin_amdgcn_readfirstlane(tid >> 6);
    const bool samp = seq >= NB; const int b = seq & 7;
    const unsigned lds0 = (unsigned)(uintptr_t)lds;
    int qrow, T0, T1, vlo, vhi, cq; size_t kvbase; bool active = true;
    if (KIND == 0) {
        if (!samp) { qrow = b * SEQ + 256 * u + 32 * wid; kvbase = (size_t)b * SEQ; T0 = 0; T1 = 4 * u + 4; vlo = 0; vhi = 4 * u + (wid >> 1); cq = vhi; }
        else { qrow = MP + b * TS; kvbase = (size_t)MP + (size_t)b * KVS; T0 = 0; T1 = 65; vlo = 0; vhi = 64; cq = 64; active = (wid == 0); }
    } else {
        if (!samp) { qrow = b * SEQ + 256 * u + 32 * wid; kvbase = (size_t)b * SEQ; T0 = 4 * u - 8 < 0 ? 0 : 4 * u - 8; T1 = 4 * u + 4; cq = 4 * u + (wid >> 1); vlo = cq - 8 < 0 ? 0 : cq - 8; vhi = cq; }
        else { qrow = MP + b * TS; kvbase = (size_t)MP + (size_t)b * BVS; T0 = 0; T1 = 9; vlo = 0; vhi = 8; cq = 8; active = (wid == 0); }
    }
    const bf16_t* KV = (KIND == 0 ? T.kvm : T.kvb) + kvbase * 1024 + h * 64;
    const bf16_t* ksrc = KV + (size_t)lane * 1024 + wid * 8;
    const bf16_t* k2src = T.kpe + (kvbase + lane) * 32 + (wid & 3) * 8;
    const bf16_t* vsrc = KV + 512 + (size_t)(16 * (wid & 3) + (lane >> 2)) * 1024 + (wid >> 2) * 32 + (lane & 3) * 8;
    const unsigned kdst = lds0 + L_K + wid * 1024, k2dst = lds0 + L_K + (8 + (wid & 3)) * 1024, vdst = lds0 + L_V + wid * 1024;
#define AT_DMA(t, s) do { AT_DMA1(t, s); if (MK_E1) AT_DMA1(t, s); } while (0)
#define AT_DMA1(t, s) do { glds16(ksrc + (size_t)(t) * 64 * 1024, (unsigned)__builtin_amdgcn_readfirstlane(kdst + (s) * KSLOT)); \
        if (KIND == 0 && wid < 4) glds16(k2src + (size_t)(t) * 64 * 32, (unsigned)__builtin_amdgcn_readfirstlane(k2dst + (s) * KSLOT)); \
        glds16(vsrc + (size_t)(t) * 64 * 1024, (unsigned)__builtin_amdgcn_readfirstlane(vdst + (s) * VSLOT)); } while (0)
    const int grp = (MK_GRP_ODD) ? (wid & 1) : (wid >> 2);
#define AT_DMA_K(t, s) glds16(ksrc + (size_t)(t) * 64 * 1024, (unsigned)__builtin_amdgcn_readfirstlane(kdst + (s) * KSLOT))
#define AT_DMA_K2(t, s) do { if (KIND == 0 && wid < 4) glds16(k2src + (size_t)(t) * 64 * 32, (unsigned)__builtin_amdgcn_readfirstlane(k2dst + (s) * KSLOT)); } while (0)
#define AT_DMA_V(t, s) glds16(vsrc + (size_t)(t) * 64 * 1024, (unsigned)__builtin_amdgcn_readfirstlane(vdst + (s) * VSLOT))
    AT_DMA(T0, 0);
    LAS float* tab = (LAS float*)(lds + L_TAB);
    if (KIND == 1) { if (tid < 320) tab[tid] = T.relb[h * 257 + (tid > 256 ? 256 : tid)] * LOG2E; }
    bf16x8 qr[NQ];
    {   const bf16_t* Qw = (KIND == 0 ? T.qm + (size_t)qrow * 768 + h * 96 : T.qb + (size_t)qrow * 512 + h * 64) + (size_t)r32 * (KIND == 0 ? 768 : 512) + hi * 8;
#pragma unroll
        for (int d0 = 0; d0 < NQ; ++d0) qr[d0] = active ? *(const bf16x8*)(Qw + d0 * 16) : (bf16x8){0, 0, 0, 0, 0, 0, 0, 0}; }
#pragma unroll
    for (int d0 = 0; d0 < NQ; ++d0) asm volatile("" : "+v"(qr[d0]));
    AT_DMA(T0 + 1, 1); AT_DMA(T0 + 2, 2);
#define AT_WAIT_TILES(n) do { if ((n) == 2) asm volatile("s_waitcnt vmcnt(4)" ::: "memory"); else if ((n) == 1) asm volatile("s_waitcnt vmcnt(2)" ::: "memory"); else asm volatile("s_waitcnt vmcnt(0)" ::: "memory"); } while (0)
    AT_WAIT_TILES(2);
    AT_BAR();
    LAS float* wsf = (LAS float*)(lds + L_WS) + wid * 64;
    const int vboff = ((lane >> 4) & 1) * 32 + (lane & 3) * 8 + (4 * hi + ((lane & 15) >> 2)) * 64;
    float m_ref = 0.f, l_run = 0.f; bool first = true; f32x16 o[2]; o[0] = f32x16{}; o[1] = f32x16{};
    const float cbfar = (KIND == 1) ? tab[256] : 0.f;
    f32x16 negn = f32x16{}, negf;
#pragma unroll
    for (int r = 0; r < 16; ++r) negf[r] = cbfar;
    const int aq = 32 * (wid & 1) + r32;
    bf16x8 kf[2 * NQ]; s16x4 vf[16];
    f32x16 p0, p1;
    if (grp == 1) { AT_WAIT_TILES(1); AT_DMA(T0 + 3, 3); }
    if (active && T0 >= vlo) kload<NQ>(kf, (LAS const char*)(lds + L_K), r32, hi);
    if (grp == 1) AT_BAR();
#define AT_PK(d, k) (bf16x8){vf[d * 8 + 2 * k][0], vf[d * 8 + 2 * k][1], vf[d * 8 + 2 * k][2], vf[d * 8 + 2 * k][3], vf[d * 8 + 2 * k + 1][0], vf[d * 8 + 2 * k + 1][1], vf[d * 8 + 2 * k + 1][2], vf[d * 8 + 2 * k + 1][3]}
#define AT_TILE(ST, j, GR) do { \
        const int sc = (j - T0) & 3; \
        const bool vis = ST || (active && j >= vlo && j <= vhi); \
        const bool visn = ST || (active && j + 1 >= vlo && j + 1 <= vhi && j + 1 < T1); \
        const bool issA = ((GR) == 0) && (ST || j + 3 < T1), issB = ((GR) == 1) && (ST || j + 4 < T1); \
        if ((GR) == 0) { if (ST || j + 2 < T1) AT_WAIT_TILES(1); else AT_WAIT_TILES(0); if (issA && !vis) AT_DMA(j + 3, (sc + 3) & 3); } \
        if (vis) { \
            const int jd = cq - j; \
            vload(vf, (LAS const char*)(lds + L_V + sc * VSLOT) + vboff); \
            __builtin_amdgcn_sched_barrier(0); \
            if (KIND == 1 && (ST || jd >= 3)) { p0 = AT_MFMA(kf[0], qr[0], negf); p1 = AT_MFMA(kf[1], qr[0], negf); asm volatile("" ::: "memory"); } \
            else { p0 = AT_MFMA(kf[0], qr[0], negn); p1 = AT_MFMA(kf[1], qr[0], negn); asm volatile("" ::: "memory"); } \
            __builtin_amdgcn_sched_barrier(0); if (issA) AT_DMA_K(j + 3, (sc + 3) & 3); __builtin_amdgcn_sched_barrier(0); \
            p0 = AT_MFMA(kf[2], qr[1], p0); p1 = AT_MFMA(kf[3], qr[1], p1); \
            __builtin_amdgcn_sched_barrier(0); if (issA) AT_DMA_V(j + 3, (sc + 3) & 3); __builtin_amdgcn_sched_barrier(0); \
            p0 = AT_MFMA(kf[4], qr[2], p0); p1 = AT_MFMA(kf[5], qr[2], p1); \
            __builtin_amdgcn_sched_barrier(0); if (issA) AT_DMA_K2(j + 3, (sc + 3) & 3); __builtin_amdgcn_sched_barrier(0); \
_Pragma("unroll") \
            for (int d0 = 3; d0 < NQ; ++d0) { p0 = AT_MFMA(kf[2 * d0], qr[d0], p0); p1 = AT_MFMA(kf[2 * d0 + 1], qr[d0], p1); } \
            if (KIND == 1 && !ST && jd < 3) { LAS const float* tb = tab + (64 * jd + aq + 128 - 4 * hi - 27 - 32); \
_Pragma("unroll") \
                for (int r = 0; r < 16; ++r) { const int c = 27 - ((r & 3) + 8 * (r >> 2)); p0[r] += tb[32 + c]; p1[r] += tb[c]; } } \
            if (!ST && samp && j == T1 - 1) { \
_Pragma("unroll") \
                for (int r = 0; r < 16; ++r) p1[r] = -INFINITY; \
                asm volatile("" : "+v"(p1)); } \
            asm volatile("s_nop 15\n\ts_nop 7" : "+v"(p0), "+v"(p1)); \
            const float rm = rowmax3(p0, p1); \
            const bool fst = !ST && first; \
            if (fst || __any(rm > 8.0f)) { \
                const float dl = fst ? rm : fmaxf(rm, 0.f); \
                m_ref += dl; \
_Pragma("unroll") \
                for (int r = 0; r < 16; ++r) { p0[r] -= dl; p1[r] -= dl; } \
_Pragma("unroll") \
                for (int r = 0; r < 16; ++r) { negn[r] = -m_ref; negf[r] = cbfar - m_ref; } \
                asm volatile("" : "+v"(negn), "+v"(negf)); \
                if (!fst) { \
                    const float alpha = __builtin_amdgcn_exp2f(-dl); l_run *= alpha; \
                    if (hi == 0) wsf[r32] = alpha; \
_Pragma("unroll") \
                    for (int r = 0; r < 16; ++r) { const float a = wsf[crow(r, hi)]; o[0][r] *= a; o[1][r] *= a; } \
                } \
                first = false; \
            } \
        } \
        AT_BAR(); \
        if ((GR) == 1) { if (ST || j + 3 < T1) AT_WAIT_TILES(1); else AT_WAIT_TILES(0); if (issB && !vis) AT_DMA(j + 4, sc); } \
        if (visn) kload<NQ>(kf, (LAS const char*)(lds + L_K + ((sc + 1) & 3) * KSLOT), r32, hi); \
        __builtin_amdgcn_sched_barrier(0); \
        if (vis) { \
            float sacc = 0.f; \
_Pragma("unroll") \
            for (int r = 0; r < 16; ++r) { p0[r] = __builtin_amdgcn_exp2f(p0[r]); p1[r] = __builtin_amdgcn_exp2f(p1[r]); sacc += p0[r] + p1[r]; } \
            l_run += sacc; \
            u32x4 w0, w1, w2, w3; \
            w0 = (u32x4){pk_bf16(p0[0], p0[1]), pk_bf16(p0[2], p0[3]), pk_bf16(p0[4], p0[5]), pk_bf16(p0[6], p0[7])}; \
            w1 = (u32x4){pk_bf16(p0[8], p0[9]), pk_bf16(p0[10], p0[11]), pk_bf16(p0[12], p0[13]), pk_bf16(p0[14], p0[15])}; \
            w2 = (u32x4){pk_bf16(p1[0], p1[1]), pk_bf16(p1[2], p1[3]), pk_bf16(p1[4], p1[5]), pk_bf16(p1[6], p1[7])}; \
            w3 = (u32x4){pk_bf16(p1[8], p1[9]), pk_bf16(p1[10], p1[11]), pk_bf16(p1[12], p1[13]), pk_bf16(p1[14], p1[15])}; \
            __builtin_amdgcn_sched_barrier(0); \
            {   const bf16x8 pa0 = __builtin_bit_cast(bf16x8, w0), pa1 = __builtin_bit_cast(bf16x8, w1), pa2 = __builtin_bit_cast(bf16x8, w2), pa3 = __builtin_bit_cast(bf16x8, w3); \
                o[0] = AT_MFMA(pa0, AT_PK(0, 0), o[0]); o[1] = AT_MFMA(pa0, AT_PK(1, 0), o[1]); \
                __builtin_amdgcn_sched_barrier(0); if (issB) AT_DMA_K(j + 4, sc); __builtin_amdgcn_sched_barrier(0); \
                o[0] = AT_MFMA(pa1, AT_PK(0, 1), o[0]); o[1] = AT_MFMA(pa1, AT_PK(1, 1), o[1]); \
                __builtin_amdgcn_sched_barrier(0); if (issB) AT_DMA_V(j + 4, sc); __builtin_amdgcn_sched_barrier(0); \
                o[0] = AT_MFMA(pa2, AT_PK(0, 2), o[0]); o[1] = AT_MFMA(pa2, AT_PK(1, 2), o[1]); \
                __builtin_amdgcn_sched_barrier(0); if (issB) AT_DMA_K2(j + 4, sc); __builtin_amdgcn_sched_barrier(0); \
                o[0] = AT_MFMA(pa3, AT_PK(0, 3), o[0]); o[1] = AT_MFMA(pa3, AT_PK(1, 3), o[1]); \
            } \
        } \
        AT_BAR(); \
    } while (0)
    int js = T1, je = T1;
    if (active) { js = vlo + 1; int jl = vhi - 1; if (T1 - 5 < jl) jl = T1 - 5; if (KIND == 1 && cq - 3 < jl) jl = cq - 3; je = jl + 1; if (js > T1) js = T1; if (je < js) je = js; }
    int j = T0;
    for (; j < js; ++j) AT_TILE(false, j, grp);
    const int jeA = (grp == 0) ? je : js;
    for (; j < jeA; ++j) AT_TILE(true, j, 0);
    for (; j < je; ++j) AT_TILE(true, j, 1);
    for (; j < T1; ++j) AT_TILE(false, j, grp);
#undef AT_TILE
#undef AT_PK
    const int colb = KIND * 512 + h * 64;
    u32x4 gpre[4];
    if (active) {
#pragma unroll
        for (int i = 0; i < 4; ++i) gpre[i] = __builtin_nontemporal_load((const u32x4*)(T.sg + (size_t)(qrow + i * 8 + (lane >> 3)) * 1024 + colb + (lane & 7) * 8)); }
    if (grp == 0) AT_BAR();
    if (active) {
        { auto rr = __builtin_amdgcn_permlane32_swap(__float_as_uint(l_run), __float_as_uint(l_run), false, false); l_run = __uint_as_float(rr[0]) + __uint_as_float(rr[1]); }
        if (hi == 0) wsf[32 + r32] = l_run;
        LAS bf16_t* stg = (LAS bf16_t*)(lds + L_OST) + wid * 2048;
#pragma unroll
        for (int r = 0; r < 16; ++r) { const int orow = crow(r, hi); const float rl = __builtin_amdgcn_rcpf(wsf[32 + orow]);
#pragma unroll
            for (int d0 = 0; d0 < 2; ++d0) stg[orow * 64 + d0 * 32 + r32] = (bf16_t)(pk_bf16(o[d0][r] * rl, 0.f) & 0xffffu); }
#pragma unroll
        for (int i = 0; i < 4; ++i) { const int row = i * 8 + (lane >> 3), ch = lane & 7;
            const u32x4 v = *(LAS const u32x4*)(stg + row * 64 + ch * 8);
            const size_t gi = (size_t)(qrow + row) * 1024 + colb + ch * 8;
            const u32x4 g = gpre[i]; u32x4 w;
            w.x = pk_bf16(bf_lo(v.x) * bf_lo(g.x), bf_hi(v.x) * bf_hi(g.x)); w.y = pk_bf16(bf_lo(v.y) * bf_lo(g.y), bf_hi(v.y) * bf_hi(g.y));
            w.z = pk_bf16(bf_lo(v.z) * bf_lo(g.z), bf_hi(v.z) * bf_hi(g.z)); w.w = pk_bf16(bf_lo(v.w) * bf_lo(g.w), bf_hi(v.w) * bf_hi(g.w));
            *(u32x4*)(T.y + gi) = w; }
    }
#undef AT_DMA
#undef AT_DMA_K
#undef AT_DMA_K2
#undef AT_DMA_V
#undef AT_WAIT_TILES
#undef AT_DMA1
}
constexpr int NU_MS = 64, NU_MP = 1024, NU_BP = 1024, NU_BS = 64, NU_G4S = 4, NU_TOT = NU_MS + NU_MP + NU_BP + NU_BS + NU_G4S;
constexpr int IDX_G4S = NU_MS + NU_BS + 13 * 64;
__device__ __forceinline__ void run_unit(const Tens& T, int idx, LAS unsigned char* lds) {
    int kind, seq, h, u;
    if (idx < NU_MS) { kind = 0; seq = 8 + (idx >> 3); h = idx & 7; u = 0; }
    else if (idx < NU_MS + NU_BS) { const int i = idx - NU_MS; kind = 1; seq = 8 + (i >> 3); h = i & 7; u = 0; }
    else if (idx < IDX_G4S) { const int i = idx - NU_MS - NU_BS; kind = 0; u = 15 - i / 64; seq = (i % 64) >> 3; h = i & 7; }
    else if (idx < IDX_G4S + NU_G4S + NU_BP) { const int i = idx - IDX_G4S - NU_G4S; kind = 1; u = 15 - i / 64; seq = (i % 64) >> 3; h = i & 7; }
    else { const int i = idx - IDX_G4S - NU_G4S - NU_BP; kind = 0; u = 2 - i / 64; seq = (i % 64) >> 3; h = i & 7; }
    if (kind == 0) unit<0>(T, seq, h, u, lds); else unit<1>(T, seq, h, u, lds);
}
}

__device__ __forceinline__ void tr_item(const float* W, int N, int srccol0, int K, bf16_t* WT, int destrow0, int k0, LAS float* scr, int lane) {
    float tv[32];
#pragma unroll
    for (int i = 0; i < 32; ++i) { const int kk = 2 * i + (lane >> 5); tv[i] = srccol0 >= 0 ? __builtin_nontemporal_load(W + (size_t)(k0 + kk) * N + srccol0 + (lane & 31)) : 0.f; }
#pragma unroll
    for (int i = 0; i < 32; ++i) { const int kk = 2 * i + (lane >> 5); scr[kk * 33 + (lane & 31)] = tv[i]; }
    const int c = lane & 7;
#pragma unroll
    for (int j = 0; j < 4; ++j) { const int n = (lane >> 3) + 8 * j; const LAS float* s = scr + (8 * c) * 33 + n;
        u32x4 o; o.x = pk_bf16(s[0 * 33], s[1 * 33]); o.y = pk_bf16(s[2 * 33], s[3 * 33]); o.z = pk_bf16(s[4 * 33], s[5 * 33]); o.w = pk_bf16(s[6 * 33], s[7 * 33]);
        *(u32x4*)(WT + (size_t)(destrow0 + n) * K + k0 + 8 * c) = o; }
}
__device__ __forceinline__ int win_src(int ng) {
    if (ng < 8) return OFF_CQ + 32 * ng;
    if (ng < 12) return OFF_CKV + 32 * (ng - 8);
    if (ng == 12) return OFF_KR;
    if (ng < 16) return -1;
    if (ng < 32) return OFF_GA + 32 * (ng - 16);
    if (ng < 48) return OFF_GB + 32 * (ng - 32);
    if (ng < 64) return OFF_QB + 32 * (ng - 48);
    if (ng < 80) return OFF_KB + 32 * (ng - 64);
    return OFF_VB + 32 * (ng - 80);
}
__device__ __forceinline__ void sincos_d(double a, float& s, float& c) {
    const double twopi = 6.283185307179586476925286766559;
    const double k = __builtin_rint(a / twopi); const double r = a - k * twopi; const double r2 = r * r;
    double ts = 1.0, tc = 1.0;
#pragma unroll 1
    for (int n = 29; n >= 3; n -= 2) { ts = 1.0 - ts * r2 / (double)(n * (n - 1)); tc = 1.0 - tc * r2 / (double)(n * (n + 1)); }
    s = (float)(r * ts); c = (float)(1.0 - tc * r2 * 0.5);
}


__device__ __forceinline__ void xn_rows4(int mb, const float* x_p, const float* x_s, const float* g_mix, bf16_t* XN, int lane) {
    f32x4 v[4][4]; float s[4];
#pragma unroll
    for (int q = 0; q < 4; ++q) { const int m = mb + q; const float* xr = (m < MP) ? x_p + (size_t)m * DM : x_s + (size_t)(m - MP) * DM;
#pragma unroll
        for (int j = 0; j < 4; ++j) v[q][j] = __builtin_nontemporal_load((const f32x4*)(xr + 4 * lane + 256 * j)); }
#pragma unroll
    for (int q = 0; q < 4; ++q) { s[q] = 0.f;
#pragma unroll
        for (int j = 0; j < 4; ++j) s[q] += (v[q][j][0] * v[q][j][0] + v[q][j][1] * v[q][j][1]) + (v[q][j][2] * v[q][j][2] + v[q][j][3] * v[q][j][3]);
        s[q] = 1.0f / sqrtf(wave_sum(s[q]) * (1.0f / DM) + EPS); }
#pragma unroll
    for (int j = 0; j < 4; ++j) { const f32x4 g = *(const f32x4*)(g_mix + 4 * lane + 256 * j);
#pragma unroll
        for (int q = 0; q < 4; ++q) { const f32x4 o = v[q][j] * s[q] * g; u32x2 w; w.x = pk_bf16(o[0], o[1]); w.y = pk_bf16(o[2], o[3]); *(u32x2*)(XN + (size_t)(mb + q) * DM + 4 * lane + 256 * j) = w; } }
}
__device__ __forceinline__ void rope_entry(float* rope, int pos, int f) {
    const double inv = exp2(-(double)f * (13.287712379549449 / 16.0));
    float s, c; sincos_d((double)pos * inv, s, c); rope[pos * 32 + f] = c; rope[pos * 32 + 16 + f] = s;
}

__device__ __forceinline__ void grid_bar(unsigned* cnt, unsigned target) {
    asm volatile("s_waitcnt vmcnt(0)" ::: "memory");
    __syncthreads();
    if (threadIdx.x == 0) {
        __builtin_amdgcn_fence(__ATOMIC_RELEASE, "agent");
        asm volatile("s_waitcnt vmcnt(0)" ::: "memory");
        __hip_atomic_fetch_add(cnt, 1u, __ATOMIC_RELAXED, __HIP_MEMORY_SCOPE_AGENT);
        unsigned spins = 0;
        while (__hip_atomic_load(cnt, __ATOMIC_RELAXED, __HIP_MEMORY_SCOPE_AGENT) < target) { __builtin_amdgcn_s_sleep(2); if (++spins > (1u << 22)) break; }
        __builtin_amdgcn_fence(__ATOMIC_ACQUIRE, "agent");
        asm volatile("s_waitcnt vmcnt(0)" ::: "memory");
    }
    __syncthreads();
}
#define XB_TMO      128
#define XB_XCNT(j)  (256  + 64 * (j))
#define XB_XSUB(j)  (1280 + 64 * (j))
#define XB_XGEN(j)  (2304 + 64 * (j))
#define XB_TOP      3328
#define XB_TOPGEN   3392
#define XCD_BAR_WORDS 3456
#define XB_SPIN_CAP (1u << 18)

__device__ __forceinline__ unsigned xb_ld(unsigned* p)              { return __hip_atomic_load(p, __ATOMIC_RELAXED, __HIP_MEMORY_SCOPE_AGENT); }
__device__ __forceinline__ unsigned xb_add(unsigned* p, unsigned v) { return __hip_atomic_fetch_add(p, v, __ATOMIC_RELAXED, __HIP_MEMORY_SCOPE_AGENT); }
__device__ __forceinline__ unsigned xb_xcc_id() { return (unsigned)__builtin_amdgcn_s_getreg((3 << 11) | 20) & 0xFu; }
#define XB_SPIN(cond, bar) do { unsigned _sp = 0; while (cond) { __builtin_amdgcn_s_sleep(1); \
    if ((++_sp & 255u) == 0u) { if (xb_ld(&(bar)[XB_TMO])) break; if (_sp > XB_SPIN_CAP) { atomicAdd(&(bar)[XB_TMO], 1u); break; } } } } while (0)

struct XcdBarrier {
    unsigned* bar; unsigned x;
    volatile LAS unsigned* st;
};

__device__ __forceinline__ XcdBarrier xcd_barrier_post(unsigned* bar, volatile LAS unsigned* st) {
    XcdBarrier b; b.bar = bar; b.x = xb_xcc_id(); b.st = st;
    if (threadIdx.x == 0) (void)xb_add(&bar[XB_XCNT(b.x)], 1u);
    return b;
}
__device__ __forceinline__ void xcd_barrier_complete(unsigned* bar, unsigned x, unsigned& nloc, unsigned& nx) {
    const unsigned G = gridDim.x * gridDim.y * gridDim.z;
    unsigned sum, cnt, mine, sp = 0u;
    for (;;) {
        sum = 0u; cnt = 0u; mine = 0u;
#pragma unroll
        for (unsigned j = 0; j < 16; ++j) { const unsigned c = xb_ld(&bar[XB_XCNT(j)]); sum += c; cnt += (c > 0u) ? 1u : 0u; mine = (j == x) ? c : mine; }
        if (sum == G) break;
        __builtin_amdgcn_s_sleep(1);
        if ((++sp & 255u) == 0u) { if (xb_ld(&bar[XB_TMO])) break; if (sp > XB_SPIN_CAP) { atomicAdd(&bar[XB_TMO], 1u); break; } }
    }
    nloc = mine > 0u ? mine : 1u; nx = cnt > 0u ? cnt : 1u;
}

__device__ __forceinline__ void xcd_barrier(const XcdBarrier& b) {
    asm volatile("s_waitcnt vmcnt(0)" ::: "memory");
    __syncthreads();
    if (threadIdx.x == 0) {
        unsigned* bar = b.bar;
        __builtin_amdgcn_s_waitcnt(0);
        unsigned nloc = b.st[0], nx = b.st[1];
        if (nloc == 0u) { xcd_barrier_complete(bar, b.x, nloc, nx); b.st[0] = nloc; b.st[1] = nx; }
        const unsigned old = xb_add(&bar[XB_XSUB(b.x)], 1u);
        const unsigned gen = old / nloc;
        if (old + 1u == (gen + 1u) * nloc) {
            __builtin_amdgcn_fence(__ATOMIC_RELEASE, "agent");
            asm volatile("s_waitcnt vmcnt(0)" ::: "memory");
            const unsigned og = xb_add(&bar[XB_TOP], 1u);
            const unsigned tg = og / nx;
            if (og + 1u == (tg + 1u) * nx) xb_add(&bar[XB_TOPGEN], 1u);
            else XB_SPIN(xb_ld(&bar[XB_TOPGEN]) == tg, bar);
            __builtin_amdgcn_fence(__ATOMIC_ACQUIRE, "agent");
            xb_add(&bar[XB_XGEN(b.x)], 1u);
            asm volatile("s_waitcnt vmcnt(0)" ::: "memory");
        } else {
            XB_SPIN(xb_ld(&bar[XB_XGEN(b.x)]) == gen, bar);
            __builtin_amdgcn_fence(__ATOMIC_ACQUIRE, "agent");
            asm volatile("s_waitcnt vmcnt(0)" ::: "memory");
        }
    }
    __syncthreads();
}

struct Params { const float* in[16]; float* out; unsigned char* ws; int lo, hi, coop, pad; };

__global__ void __launch_bounds__(512, 2) mk_fwd(Params P) {
    extern __shared__ __attribute__((aligned(16))) unsigned char lds_raw[];
    LAS unsigned char* lds = (LAS unsigned char*)lds_raw;
    const int G = gridDim.x, NGW = G * 8;
#define PHASE_IDS() int tid_l = threadIdx.x; asm volatile("" : "+v"(tid_l)); const int tid = tid_l, lane = tid & 63; const int wave = __builtin_amdgcn_readfirstlane(tid >> 6); const int gw = blockIdx.x * 8 + wave; (void)lane; (void)gw
    unsigned char* ws = P.ws; float* out = P.out;
    const float *x_p = P.in[0], *x_s = P.in[1], *c_ckv = P.in[2], *c_kpe = P.in[3], *c_kb = P.in[4], *c_vb = P.in[5], *w_in = P.in[6], *g_mix = P.in[7], *g_cq = P.in[8],
                *w_uq = P.in[9], *g_ckv = P.in[10], *w_uk = P.in[11], *w_uv = P.in[12], *relb = P.in[13], *w_out = P.in[14], *g_fin = P.in[15];
    unsigned* ctl = (unsigned*)(ws + WS_CTL); float* rope = (float*)(ws + WS_ROPE);
    bf16_t *Win = (bf16_t*)(ws + WS_WIN), *Wuq = (bf16_t*)(ws + WS_WUQ), *Wukv = (bf16_t*)(ws + WS_WUKV), *Wout = (bf16_t*)(ws + WS_WOUT), *XN = (bf16_t*)(ws + WS_XN),
           *ZCQ = (bf16_t*)(ws + WS_ZCQ), *CQ = (bf16_t*)(ws + WS_CQ), *CKV = (bf16_t*)(ws + WS_CKV), *KPE = (bf16_t*)(ws + WS_KPE), *SG = (bf16_t*)(ws + WS_SG),
           *QB = (bf16_t*)(ws + WS_QB), *KVB = (bf16_t*)(ws + WS_KVB), *QM = (bf16_t*)(ws + WS_QM), *KVM = (bf16_t*)(ws + WS_KVM), *Y = (bf16_t*)(ws + WS_Y);
    float* ZCKV = (float*)(ws + WS_ZCKV);
    const int lo = P.lo, hi = P.hi;
#ifndef MK_PHMASK
#define MK_PHMASK 0xff
#endif
#define PH(k) (((MK_PHMASK >> (k)) & 1) && lo <= (k) && (k) < hi)
#ifndef MK_REP
#define MK_REP -1
#endif
#define REP(k) for (int rep_ = 0; rep_ < ((MK_REP) == (k) ? 2 : 1); ++rep_)
    { volatile LAS unsigned* misc = (volatile LAS unsigned*)(lds + LDS_RING + 32); if (threadIdx.x < 2) misc[threadIdx.x] = 0u; __syncthreads(); }
    const XcdBarrier xbar = xcd_barrier_post(ctl + 1024, (volatile LAS unsigned*)(lds + LDS_RING + 32));
#define SEAM(k) do { if (PH(k) && PH((k) + 1)) { if (P.coop == 2) cg::this_grid().sync(); else xcd_barrier(xbar); } } while (0)

    if (PH(0)) REP(0) {
        PHASE_IDS();
        LAS float* scr = (LAS float*)(lds + wave * 8448);
        for (int it = gw; it < 96 * 16; it += NGW) { const int ng = it / 16, kb = it % 16; tr_item(w_in, IN_W, win_src(ng), 1024, Win, 32 * ng, 64 * kb, scr, lane); }
        for (int mb = gw * 4; mb < M1; mb += NGW * 4) xn_rows4(mb, x_p, x_s, g_mix, XN, lane);
        const int gt = blockIdx.x * 512 + tid, NGT = G * 512;
        for (int i = gt; i < (PAST + TS) * 16; i += NGT) rope_entry(rope, i >> 4, i & 15);
    }
    SEAM(0);
#ifdef MK_XSYNC
    for (int i_ = 0; i_ < MK_XSYNC; ++i_) xcd_barrier(xbar);
#endif
    if (PH(1)) REP(1) {
        pg8::Gemm g{XN, Win, M1, NIN, 1024}; pg8::StaticOrder S; S.init(M1, NIN, G, (int)blockIdx.x);
        EpiG1 E{ZCQ, KPE, SG, QB, KVB, ZCKV, out, rope};
        pg8::gemm_phase<EpiG1, pg8::StaticOrder, true, true>(lds, g, S, E);
        {   PHASE_IDS();
            const int nlast = (M1 / 256 * (NIN / 256)) % G;
            const int nsb = (nlast > 0 && nlast * 2 < G) ? nlast : 0;
            if ((int)blockIdx.x >= nsb) {
                LAS float* scr = (LAS float*)(lds + wave * 8448);
                const int gwp = ((int)blockIdx.x - nsb) * 8 + wave, NGWP = (G - nsb) * 8;
                constexpr int I_UQ = 24 * 4, I_UKV = 32 * 2, I_OUT = 32 * 16, I_TOT = I_UQ + I_UKV + I_OUT;
                for (int it = gwp; it < I_TOT; it += NGWP) {
                    int r = it;
                    if (r < I_UQ) { const int ng = r / 4, kb = r % 4; const int src = ng < 16 ? (ng >> 1) * 96 + 32 * (ng & 1) : (ng - 16) * 96 + 64; tr_item(w_uq, 768, src, 256, Wuq, 32 * ng, 64 * kb, scr, lane); continue; } r -= I_UQ;
                    if (r < I_UKV) { const int ng = r / 2, kb = r % 2; tr_item(ng < 16 ? w_uk : w_uv, 512, 32 * (ng & 15), 128, Wukv, 32 * ng, 64 * kb, scr, lane); continue; } r -= I_UKV;
                    { const int ng = r / 16, kb = r % 16; tr_item(w_out, 1024, 32 * ng, 1024, Wout, 32 * ng, 64 * kb, scr, lane); }
                }
                const int gt = ((int)blockIdx.x - nsb) * 512 + tid, NGT = (G - nsb) * 512;
#pragma unroll 4
        for (int i = gt; i < NB * PAST * 32; i += NGT) { const int r = i >> 5, c = (i & 31) * 4; const int bb = r >> 12, p = r & 4095;
            const f32x4 v = __builtin_nontemporal_load((const f32x4*)(c_ckv + (size_t)r * 128 + c)); u32x2 w; w.x = pk_bf16(v[0], v[1]); w.y = pk_bf16(v[2], v[3]);
            *(u32x2*)(CKV + (size_t)(MP + bb * KVS + p) * 128 + c) = w; }
        for (int i = gt; i < NB * PAST * 8; i += NGT) { const int r = i >> 3, c = (i & 7) * 4; const int bb = r >> 12, p = r & 4095;
            const f32x4 v = __builtin_nontemporal_load((const f32x4*)(c_kpe + (size_t)r * 32 + c)); u32x2 w; w.x = pk_bf16(v[0], v[1]); w.y = pk_bf16(v[2], v[3]);
            *(u32x2*)(KPE + (size_t)(MP + bb * KVS + p) * 32 + c) = w; }
#pragma unroll 2
        for (int i = gt; i < NB * 512 * 128; i += NGT) { const int r = i >> 7, c = (i & 127) * 4; const int bb = r >> 9, p = r & 511;
            const f32x4 kv = __builtin_nontemporal_load((const f32x4*)(c_kb + (size_t)r * 512 + c)), vv = __builtin_nontemporal_load((const f32x4*)(c_vb + (size_t)r * 512 + c));
            u32x2 w; w.x = pk_bf16(kv[0], kv[1]); w.y = pk_bf16(kv[2], kv[3]); bf16_t* d = KVB + (size_t)(MP + bb * BVS + p) * 1024 + c; *(u32x2*)d = w;
            w.x = pk_bf16(vv[0], vv[1]); w.y = pk_bf16(vv[2], vv[3]); *(u32x2*)(d + 512) = w; }
        for (int i = gt; i < NB * 32 * 32; i += NGT) { const int r = i >> 5, c = (i & 31) * 4; *(u32x2*)(CKV + (size_t)(MP + (r >> 5) * KVS + PAST + 32 + (r & 31)) * 128 + c) = (u32x2){0u, 0u}; }
        for (int i = gt; i < NB * 32 * 8; i += NGT) { const int r = i >> 3, c = (i & 7) * 4; *(u32x2*)(KPE + (size_t)(MP + (r >> 5) * KVS + PAST + 32 + (r & 31)) * 32 + c) = (u32x2){0u, 0u}; }
        for (int i = gt; i < NB * 32 * 256; i += NGT) { const int r = i >> 8, c = (i & 255) * 4; *(u32x2*)(KVB + (size_t)(MP + (r >> 5) * BVS + 512 + 32 + (r & 31)) * 1024 + c) = (u32x2){0u, 0u}; }
            }
        }
    }
    SEAM(1);
    if (PH(2)) REP(2) {
        PHASE_IDS();
        for (int mb = gw * 4; mb < M1; mb += NGW * 4) {
            u32x2 wq[4]; f32x2 vk[4];
#pragma unroll
            for (int q = 0; q < 4; ++q) { wq[q] = __builtin_nontemporal_load((const u32x2*)(ZCQ + (size_t)(mb + q) * 256 + 4 * lane)); vk[q] = __builtin_nontemporal_load((const f32x2*)(ZCKV + (size_t)(mb + q) * 128 + 2 * lane)); }
            const f32x4 gq = *(const f32x4*)(g_cq + 4 * lane); const f32x2 gk = *(const f32x2*)(g_ckv + 2 * lane);
#pragma unroll
            for (int q = 0; q < 4; ++q) { const int m = mb + q;
                f32x4 v = {bf_lo(wq[q].x), bf_hi(wq[q].x), bf_lo(wq[q].y), bf_hi(wq[q].y)};
                const float rq = 1.0f / sqrtf(wave_sum((v[0] * v[0] + v[1] * v[1]) + (v[2] * v[2] + v[3] * v[3])) * (1.0f / 256.0f) + EPS);
                v = v * rq * gq; u32x2 o; o.x = pk_bf16(v[0], v[1]); o.y = pk_bf16(v[2], v[3]); *(u32x2*)(CQ + (size_t)m * 256 + 4 * lane) = o;
                f32x2 k = vk[q];
                const float rk = 1.0f / sqrtf(wave_sum(k[0] * k[0] + k[1] * k[1]) * (1.0f / 128.0f) + EPS);
                k = k * rk * gk;
                float* po = (m < MP) ? out + O_CKVP + (size_t)m * 128 : out + O_CKVS + (size_t)(m - MP) * 128; *(f32x2*)(po + 2 * lane) = k;
                *(unsigned*)(CKV + (size_t)kvrow_m(m) * 128 + 2 * lane) = pk_bf16(k[0], k[1]); }
        }
    }
    SEAM(2);
    if (PH(3)) REP(3) {
        { pg8::Gemm g{CQ, Wuq, M1, 768, 256}; pg8::StaticOrder S; S.init(M1, 768, G, (int)blockIdx.x); EpiG2 E{QM, rope};
          pg8::gemm_phase<EpiG2, pg8::StaticOrder, true, true>(lds, g, S, E); }
    }
    if (PH(4)) REP(4) {
        { pg8::Gemm g{CKV, Wukv, KVR, 1024, 128}; SkewOrder S; S.init(KVR, 1024, G, (int)blockIdx.x, (KVR / 256 * 4) / G, (M1 / 256 * 3) % G);
          EpiPlain E{KVM, 1024};
          pg8::gemm_phase<EpiPlain, SkewOrder, true, true>(lds, g, S, E); }
    }
    SEAM(4);
    if (PH(5)) REP(5) {
        PHASE_IDS();
        const at::Tens T{QM, QB, KVM, KVB, KPE, SG, Y, relb};
        LAS volatile unsigned* sidx = (LAS volatile unsigned*)(lds + at::L_IDX);
        unsigned nxt = 0; if (tid == 0) nxt = atomicAdd(ctl + rep_, 1u);
        for (;;) {
            if (tid == 0) sidx[0] = nxt;
            __syncthreads();
            const int idx = (int)sidx[0];
            if (idx >= at::NU_TOT) break;
            if (tid == 0) nxt = atomicAdd(ctl + rep_, 1u);
            if (idx >= at::IDX_G4S && idx < at::IDX_G4S + at::NU_G4S) {
                if (tid == 0) { unsigned sp = 0; while (__hip_atomic_load(ctl + 2, __ATOMIC_RELAXED, __HIP_MEMORY_SCOPE_AGENT) < 128u) { __builtin_amdgcn_s_sleep(4); if (++sp > (1u << 22)) break; }
                    __builtin_amdgcn_fence(__ATOMIC_ACQUIRE, "agent"); asm volatile("s_waitcnt vmcnt(0)" ::: "memory"); }
                __syncthreads();
                pg8::Gemm g{Y, Wout, M1, 1024, 1024}; OneUnit S1{MP / 256, idx - at::IDX_G4S}; EpiG4 E{x_p, x_s, out, (bf16_t*)(ws + WS_X1), (float*)(ws + WS_SSQ)};
                pg8::gemm_phase<EpiG4, OneUnit, false, true>(lds, g, S1, E);
                continue;
            }
            at::run_unit(T, idx, lds);
            if (idx < at::NU_MS + at::NU_BS) {
                asm volatile("s_waitcnt vmcnt(0)" ::: "memory"); __syncthreads();
                if (tid == 0) { __builtin_amdgcn_fence(__ATOMIC_RELEASE, "agent"); asm volatile("s_waitcnt vmcnt(0)" ::: "memory"); __hip_atomic_fetch_add(ctl + 2, 1u, __ATOMIC_RELAXED, __HIP_MEMORY_SCOPE_AGENT); }
            }
        }
    }
    SEAM(5);
    if (PH(6)) REP(6) {
        pg8::Gemm g{Y, Wout, MP, 1024, 1024}; pg8::StaticOrder S; S.init(MP, 1024, G, (int)blockIdx.x); EpiG4 E{x_p, x_s, out, (bf16_t*)(ws + WS_X1), (float*)(ws + WS_SSQ)};
        pg8::gemm_phase<EpiG4, pg8::StaticOrder, true, true>(lds, g, S, E);
    }
    SEAM(6);
    if (PH(7)) {
        PHASE_IDS();
        const bf16_t* X1 = (const bf16_t*)(ws + WS_X1); const float* SSQ = (const float*)(ws + WS_SSQ);
        for (int mb = gw * 4; mb < MP; mb += NGW * 4) {
            float sp[4]; u32x4 w[4][2];
#pragma unroll
            for (int q = 0; q < 4; ++q) { sp[q] = lane < 16 ? SSQ[(size_t)(mb + q) * 16 + lane] : 0.f;
#pragma unroll
                for (int j = 0; j < 2; ++j) w[q][j] = __builtin_nontemporal_load((const u32x4*)(X1 + (size_t)(mb + q) * DM + 8 * lane + 512 * j)); }
#pragma unroll
            for (int q = 0; q < 4; ++q) sp[q] = 1.0f / sqrtf(wave_sum(sp[q]) * (1.0f / DM) + EPS);
#pragma unroll
            for (int j = 0; j < 2; ++j) { const int c = 8 * lane + 512 * j; const f32x4 g0 = *(const f32x4*)(g_fin + c), g1 = *(const f32x4*)(g_fin + c + 4);
#pragma unroll
                for (int q = 0; q < 4; ++q) { const u32x4 ww = w[q][j];
                    const f32x4 a = {bf_lo(ww.x), bf_hi(ww.x), bf_lo(ww.y), bf_hi(ww.y)}, b = {bf_lo(ww.z), bf_hi(ww.z), bf_lo(ww.w), bf_hi(ww.w)};
                    *(f32x4*)(out + (size_t)(mb + q) * DM + c) = a * sp[q] * g0; *(f32x4*)(out + (size_t)(mb + q) * DM + c + 4) = b * sp[q] * g1; } }
        }
        for (int m = MP + gw; m < M1; m += NGW) {
            float* xr = out + (size_t)m * DM; f32x4 v[4]; float s = 0.f;
#pragma unroll
            for (int j = 0; j < 4; ++j) { v[j] = *(const f32x4*)(xr + 4 * lane + 256 * j); s += (v[j][0] * v[j][0] + v[j][1] * v[j][1]) + (v[j][2] * v[j][2] + v[j][3] * v[j][3]); }
            const float rstd = 1.0f / sqrtf(wave_sum(s) * (1.0f / DM) + EPS);
#pragma unroll
            for (int j = 0; j < 4; ++j) { const f32x4 g = *(const f32x4*)(g_fin + 4 * lane + 256 * j); *(f32x4*)(xr + 4 * lane + 256 * j) = v[j] * rstd * g; }
        }
    }
#undef PH
#undef SEAM
}

constexpr int NPH = 8;
extern "C" void kernel_launch(void* const* d_in, const int* in_sizes, int n_in, void* d_out, int out_size, void* d_ws, size_t ws_size, hipStream_t stream) {
    static int grid = 0;
    if (grid == 0) {
        if (n_in != 16 || (size_t)out_size != O_END || ws_size < WS_END) { fprintf(stderr, "kernel_launch: unexpected shapes (n_in %d out %d ws %zu need %zu)\n", n_in, out_size, ws_size, (size_t)WS_END); grid = -1; return; }
        int dev = 0, cus = 0, per_cu = 0;
        hipGetDevice(&dev); hipDeviceGetAttribute(&cus, hipDeviceAttributeMultiprocessorCount, dev);
        hipFuncSetAttribute((const void*)mk_fwd, hipFuncAttributeMaxDynamicSharedMemorySize, LDS_TOTAL);
        hipOccupancyMaxActiveBlocksPerMultiprocessor(&per_cu, (const void*)mk_fwd, 512, LDS_TOTAL);
        (void)hipGetLastError();
        if (per_cu < 1) per_cu = 1;
        grid = cus * per_cu;
        if (grid > 256) grid = 256;
    }
    if (grid < 0) return;
    if (hipMemsetAsync(d_ws, 0, 32768, stream) != hipSuccess) { fprintf(stderr, "memset failed\n"); return; }
    Params p{};
    for (int i = 0; i < 16; ++i) p.in[i] = (const float*)d_in[i];
    p.out = (float*)d_out; p.ws = (unsigned char*)d_ws;
#if MK_COOP
    p.lo = 0; p.hi = NPH; p.coop = 1;
    void* args[] = {&p};
    hipError_t e = hipLaunchCooperativeKernel((const void*)mk_fwd, dim3(grid), dim3(512), args, LDS_TOTAL, stream);
    if (e != hipSuccess) fprintf(stderr, "cooperative launch failed: %s (grid %d)\n", hipGetErrorString(e), grid);
#else
    for (int ph = 0; ph < NPH; ++ph) { p.lo = ph; p.hi = ph + 1; p.coop = 0; hipLaunchKernelGGL(mk_fwd, dim3(grid), dim3(512), LDS_TOTAL, stream, p); }
#endif
}
```
